# Optimizing an MI355X kernel written in HIP

```python
import math
import jax, jax.numpy as jnp
from jax import lax
import numpy as np

D_MODEL = 2048
BATCH = 8
SEQ = 2048
DEPTH = 4

N_META = 16
EXPAND = 2
MIX_WIDTH = EXPAND * D_MODEL
A_HEADS = 16
A_DK = 128
A_DV = 128
A_WIDTH = A_HEADS * A_DV
A_CHUNK = 64
B_HEADS = 16
B_KV_HEADS = 4
B_GROUP = B_HEADS // B_KV_HEADS
B_HEAD_DIM = 128
B_WIDTH = B_HEADS * B_HEAD_DIM
WINDOW = 128
C_HEAD_DIM = 128
C_HEADS = MIX_WIDTH // (2 * C_HEAD_DIM)
C_WIDTH = C_HEADS * 2 * C_HEAD_DIM
Q_BLOCK = 128

N_EVEN = (DEPTH + 1) // 2
N_ODD = DEPTH // 2
EVEN_SIZES = (A_HEADS * A_DK, A_HEADS * A_DK, A_HEADS * A_DK, A_WIDTH, A_WIDTH,
              B_WIDTH, B_KV_HEADS * B_HEAD_DIM, B_KV_HEADS * B_HEAD_DIM, B_WIDTH)
EVEN_IN = 3 * A_HEADS * A_DK + 2 * A_WIDTH + 2 * B_WIDTH + 2 * B_KV_HEADS * B_HEAD_DIM
ODD_IN = 4 * C_WIDTH
EPS = 1e-6
NEG = -1e30

kernel_name = "hybrid_hgrn2_swa_diffattn_encoder"


def rms_norm(t, g):
    tf = t.astype(jnp.float32)
    y = tf * lax.rsqrt(jnp.mean(tf * tf, axis=-1, keepdims=True) + EPS) * g.astype(jnp.float32)
    return y.astype(t.dtype)


def alibi_slopes(n):
    return jnp.exp2(-8.0 * jnp.arange(1, n + 1, dtype=jnp.float32) / n)


def split_cols(z, sizes):
    out, start = [], 0
    for s in sizes:
        out.append(z[..., start:start + s])
        start += s
    return out


def hgrn2_chunk_scan(q, logf, v):
    Bn, H, Lp, dk = q.shape
    dv = v.shape[-1]
    n = Lp // A_CHUNK
    k = -jnp.expm1(logf)

    def chunks(t):
        return t.reshape(Bn, H, n, A_CHUNK, t.shape[-1]).transpose(2, 0, 1, 3, 4)

    tril = jnp.tril(jnp.ones((A_CHUNK, A_CHUNK), dtype=bool))

    def step(S, blk):
        qc, lc, kc, vc = blk
        b = jnp.cumsum(lc, axis=2)
        o = jnp.einsum('bhtk,bhkv->bhtv', qc * jnp.exp(b), S)
        decay = jnp.exp(jnp.minimum(b[:, :, :, None, :] - b[:, :, None, :, :], 0.0))
        scores = jnp.einsum('bhtk,bhsk,bhtsk->bhts', qc, kc, decay)
        scores = jnp.where(tril, scores, 0.0)
        o = o + jnp.einsum('bhts,bhsv->bhtv', scores, vc)
        b_last = b[:, :, -1:, :]
        S = S * jnp.exp(b_last).transpose(0, 1, 3, 2)
        S = S + jnp.einsum('bhsk,bhsv->bhkv', kc * jnp.exp(b_last - b), vc)
        return S, o

    S0 = jnp.zeros((Bn, H, dk, dv), jnp.float32)
    _, o = lax.scan(step, S0, (chunks(q), chunks(logf), chunks(k), chunks(v)))
    return o.transpose(1, 2, 0, 3, 4).reshape(Bn, H, Lp, dv)


def hgrn2_bidir(q, zf, zb, v, lb):
    pad = (-N_META) % A_CHUNK
    lb = lb.astype(jnp.float32)

    def log_forget(z, lbd):
        lbd = lbd[None, :, None, :]
        return jnp.logaddexp(jnp.log(lbd), jnp.log1p(-lbd) + jax.nn.log_sigmoid(z.astype(jnp.float32)))

    def padt(t):
        return jnp.pad(t, ((0, 0), (0, 0), (pad, 0), (0, 0)))

    def flip(t):
        return jnp.flip(t, axis=2)

    qp, vp = padt(q), padt(v)
    lf, lbk = padt(log_forget(zf, lb[0])), padt(log_forget(zb, lb[1]))
    o_f = hgrn2_chunk_scan(qp, lf, vp)
    o_b = flip(hgrn2_chunk_scan(flip(qp), flip(lbk), flip(vp)))
    return (o_f + o_b)[:, :, pad:]


def window_attention(q, k, v, sink):
    Bn, Hk, G, L, d = q.shape
    nb = -(-L // WINDOW)
    Lq = nb * WINDOW
    scale = d ** -0.5
    slopes = alibi_slopes(B_HEADS).reshape(1, Hk, G, 1, 1, 1)
    qb = jnp.pad(q, ((0, 0), (0, 0), (0, 0), (0, Lq - L), (0, 0))).reshape(Bn, Hk, G, nb, WINDOW, d)

    def band(t):
        tp = jnp.pad(t, ((0, 0), (0, 0), (WINDOW, Lq - L + WINDOW), (0, 0)))
        tp = tp.reshape(Bn, Hk, nb + 2, WINDOW, t.shape[-1])
        return jnp.concatenate([tp[:, :, :-2], tp[:, :, 1:-1], tp[:, :, 2:]], axis=3)

    kw, vw = band(k), band(v)
    tq = jnp.arange(Lq).reshape(nb, WINDOW)
    ts = (jnp.arange(nb)[:, None] - 1) * WINDOW + jnp.arange(3 * WINDOW)[None, :]
    dist = jnp.abs(tq[:, :, None] - ts[:, None, :])
    valid = (dist <= WINDOW) & (ts[:, None, :] >= N_META) & (ts[:, None, :] < L)
    s_w = jnp.einsum('bhgnqd,bhnkd->bhgnqk', qb, kw).astype(jnp.float32) * scale - slopes * dist
    s_w = jnp.where(valid, s_w, NEG)
    dist_m = jnp.minimum(jnp.abs(tq[:, :, None] - jnp.arange(N_META)[None, None, :]), WINDOW)
    km, vm = k[:, :, :N_META], v[:, :, :N_META]
    s_m = jnp.einsum('bhgnqd,bhmd->bhgnqm', qb, km).astype(jnp.float32) * scale - slopes * dist_m
    s_sink = jnp.broadcast_to(sink.astype(jnp.float32).reshape(1, Hk, G, 1, 1, 1), s_m.shape[:-1] + (1,))
    p = jax.nn.softmax(jnp.concatenate([s_sink, s_m, s_w], axis=-1), axis=-1)
    p_m = p[..., 1:1 + N_META].astype(v.dtype)
    p_w = p[..., 1 + N_META:].astype(v.dtype)
    o = jnp.einsum('bhgnqm,bhmd->bhgnqd', p_m, vm) + jnp.einsum('bhgnqk,bhnkd->bhgnqd', p_w, vw)
    return o.reshape(Bn, Hk, G, Lq, d)[:, :, :, :L]


def diff_attention(q, k, v, lam):
    Bn, H, _, L, d = q.shape
    nb = -(-L // Q_BLOCK)
    Lq = nb * Q_BLOCK
    scale = d ** -0.5
    slopes = alibi_slopes(H).reshape(1, H, 1, 1, 1)
    qb = jnp.pad(q, ((0, 0), (0, 0), (0, 0), (0, Lq - L), (0, 0)))
    qb = qb.reshape(Bn, H, 2, nb, Q_BLOCK, d).transpose(3, 0, 1, 2, 4, 5)
    tq = jnp.arange(Lq).reshape(nb, Q_BLOCK)
    ts = jnp.arange(L)

    def block(args):
        qblk, tblk = args
        s = jnp.einsum('bhjqd,bhjkd->bhjqk', qblk, k).astype(jnp.float32) * scale
        s = s - slopes * jnp.abs(tblk[:, None] - ts[None, :])
        p = jax.nn.softmax(s, axis=-1)
        w = (p[:, :, 0] - lam * p[:, :, 1]).astype(v.dtype)
        return jnp.einsum('bhqk,bhkv->bhqv', w, v)

    o = lax.map(block, (qb, tq))
    return o.transpose(1, 2, 0, 3, 4).reshape(Bn, H, Lq, v.shape[-1])[:, :, :L]


def even_mixer(h, w_in, w_out, lb, a_norm, sink):
    Bn, L, _ = h.shape
    z = jnp.einsum('bld,de->ble', h, w_in)
    aq, afw, abw, ai, ag, bq, bk, bv, bg = split_cols(z, EVEN_SIZES)

    def heads(t, n):
        return t.reshape(Bn, L, n, -1).transpose(0, 2, 1, 3)

    a = hgrn2_bidir(heads(aq, A_HEADS), heads(afw, A_HEADS), heads(abw, A_HEADS), heads(ai, A_HEADS), lb)
    a = rms_norm(a, a_norm)
    a = a.transpose(0, 2, 1, 3).reshape(Bn, L, A_WIDTH).astype(h.dtype) * jax.nn.silu(ag)
    q = bq.reshape(Bn, L, B_KV_HEADS, B_GROUP, B_HEAD_DIM).transpose(0, 2, 3, 1, 4)
    o = window_attention(q, heads(bk, B_KV_HEADS), heads(bv, B_KV_HEADS), sink)
    o = o.transpose(0, 3, 1, 2, 4).reshape(Bn, L, B_WIDTH) * jax.nn.silu(bg)
    return jnp.einsum('ble,ed->bld', jnp.concatenate([a, o], axis=-1), w_out)


def odd_mixer(h, w_in, w_out, lam_vecs, c_norm, layer_idx):
    Bn, L, _ = h.shape
    z = jnp.einsum('bld,de->ble', h, w_in)
    cq, ck, cv, cg = split_cols(z, (C_WIDTH, C_WIDTH, C_WIDTH, C_WIDTH))
    q = cq.reshape(Bn, L, C_HEADS, 2, C_HEAD_DIM).transpose(0, 2, 3, 1, 4)
    k = ck.reshape(Bn, L, C_HEADS, 2, C_HEAD_DIM).transpose(0, 2, 3, 1, 4)
    v = cv.reshape(Bn, L, C_HEADS, 2 * C_HEAD_DIM).transpose(0, 2, 1, 3)
    lam_init = 0.8 - 0.6 * math.exp(-0.3 * layer_idx)
    lv = lam_vecs.astype(jnp.float32)
    lam = jnp.exp(jnp.sum(lv[0] * lv[1])) - jnp.exp(jnp.sum(lv[2] * lv[3])) + lam_init
    o = diff_attention(q, k, v, lam)
    o = rms_norm(o, c_norm) * (1.0 - lam_init)
    o = o.transpose(0, 2, 1, 3).reshape(Bn, L, C_WIDTH) * jax.nn.silu(cg)
    return jnp.einsum('ble,ed->bld', o, w_out)


def setup_inputs(seed: int = 0) -> dict:
    key = jax.random.key(seed)
    ks = jax.random.split(key, 16)
    f32 = jnp.float32
    nrm = lambda k, s: jax.random.normal(k, s, f32)
    return {
        "x": nrm(ks[0], (BATCH, SEQ, D_MODEL)),
        "meta_tokens": nrm(ks[1], (N_META, D_MODEL)),
        "norm_a": 1.0 + 0.02 * nrm(ks[2], (N_EVEN, D_MODEL)),
        "w_in_a": nrm(ks[3], (N_EVEN, D_MODEL, EVEN_IN)) * D_MODEL ** -0.5,
        "w_out_a": nrm(ks[4], (N_EVEN, MIX_WIDTH, D_MODEL)) * MIX_WIDTH ** -0.5,
        "hgrn_lb": nrm(ks[5], (2, N_EVEN, A_HEADS * A_DK)),
        "hgrn_norm": 1.0 + 0.02 * nrm(ks[6], (N_EVEN, A_DV)),
        "sink_logits": nrm(ks[7], (N_EVEN, B_HEADS)),
        "norm_c": 1.0 + 0.02 * nrm(ks[8], (N_ODD, D_MODEL)),
        "w_in_c": nrm(ks[9], (N_ODD, D_MODEL, ODD_IN)) * D_MODEL ** -0.5,
        "w_out_c": nrm(ks[10], (N_ODD, MIX_WIDTH, D_MODEL)) * MIX_WIDTH ** -0.5,
        "diff_lambda": 0.1 * nrm(ks[11], (N_ODD, 4, C_HEAD_DIM)),
        "diff_norm": 1.0 + 0.02 * nrm(ks[12], (N_ODD, 2 * C_HEAD_DIM)),
        "final_norm": 1.0 + 0.02 * nrm(ks[13], (D_MODEL,)),
    }


def reference(x, meta_tokens, norm_a, w_in_a, w_out_a, hgrn_lb, hgrn_norm, sink_logits,
              norm_c, w_in_c, w_out_c, diff_lambda, diff_norm, final_norm):
    Bn = x.shape[0]
    meta = jnp.broadcast_to(meta_tokens.astype(x.dtype)[None], (Bn, N_META, D_MODEL))
    h = jnp.concatenate([meta, x], axis=1)
    lbs = jnp.cumsum(jax.nn.softmax(hgrn_lb.astype(jnp.float32), axis=1), axis=1)
    lbs = lbs - lbs[:, :1]
    for layer in range(DEPTH):
        i = layer // 2
        if layer % 2 == 0:
            h = h + even_mixer(rms_norm(h, norm_a[i]), w_in_a[i], w_out_a[i],
                               lbs[:, i].reshape(2, A_HEADS, A_DK), hgrn_norm[i], sink_logits[i])
        else:
            h = h + odd_mixer(rms_norm(h, norm_c[i]), w_in_c[i], w_out_c[i],
                              diff_lambda[i], diff_norm[i], layer)
    return rms_norm(h, final_norm)[:, N_META:]
```

```cpp
#include <hip/hip_runtime.h>
#include <hip/hip_cooperative_groups.h>
#include <cstdio>
namespace cg = cooperative_groups;
__device__ __forceinline__ int ltid() { int t = threadIdx.x; asm volatile("" : "+v"(t)); return t; }
namespace pg8 {
#define PG8_LAS __attribute__((address_space(3)))
typedef unsigned short bf16_t;
typedef short bf16x8 __attribute__((ext_vector_type(8)));
typedef float f32x4 __attribute__((ext_vector_type(4)));
typedef unsigned u32x4 __attribute__((ext_vector_type(4)));
constexpr int BM = 256, BK = 64, HALF = 128, HTB = HALF * BK * 2  , STAGE_BYTES = 8 * HTB, NXCD = 8, WGM = 8;

__host__ __device__ __forceinline__ int lds_byte(int r, int c) { const int st = (r >> 4) * 2 + (c >> 5), rr = r & 15, cc = c & 31, ob = rr * 64 + cc * 2; return st * 1024 + (ob ^ (((ob >> 9) & 1) << 5)); }
__host__ __device__ __forceinline__ void stage_rc(int b, int& R, int& C) { const int st = b / 1024, sb = b % 1024, swz = sb ^ (((sb >> 9) & 1) << 5); R = (st >> 1) * 16 + swz / 64; C = (st & 1) * 32 + (swz % 64) / 2; }
__host__ __device__ __forceinline__ int perm32(int rho) { const int n = rho >> 4, i = rho & 15; return 8 * (i >> 2) + 4 * n + (i & 3); }

struct Unit { int pm, pn; };
struct Gemm { const bf16_t* A; const bf16_t* Bt; int M, N, K; };

struct StaticOrder {
    int nM, nN, nwg, G, c;
    __host__ __device__ void init(int M, int N, int G_, int c_) { nM = M / BM; nN = N / BM; nwg = nM * nN; G = G_; c = c_; }
    __host__ __device__ bool next(int i, Unit& u) const {
        const long L = (long)i * G + c; if (L >= nwg) return false;
        int wgid = (int)L; { const int q = nwg / NXCD, r = nwg % NXCD, xcd = wgid % NXCD, off = wgid / NXCD; wgid = (xcd < r ? xcd * (q + 1) : r * (q + 1) + (xcd - r) * q) + off; }
        const int nig = WGM * nN, gid = wgid / nig, fm = gid * WGM, gsz = (nM - fm) < WGM ? (nM - fm) : WGM;
        u.pm = fm + ((wgid % nig) % gsz); u.pn = (wgid % nig) / gsz; return true;
    }
    __device__ __forceinline__ void a_ready(const Unit&) const {}
    __device__ __forceinline__ void done(const Unit&) const {}
};
struct CountedOrder : StaticOrder {
    const unsigned* ready; unsigned need; unsigned* tmo;
    __device__ __forceinline__ void a_ready(const Unit& u) const {
        if (ltid() < 64) {
            const unsigned long long t0 = __builtin_amdgcn_s_memrealtime(); unsigned polls = 0;
            while ((unsigned)__builtin_amdgcn_readfirstlane(__hip_atomic_load(ready + 64 * u.pm, __ATOMIC_RELAXED, __HIP_MEMORY_SCOPE_AGENT)) < need) {
                if ((++polls & 255u) == 0u && __builtin_amdgcn_readfirstlane(__hip_atomic_load(tmo, __ATOMIC_RELAXED, __HIP_MEMORY_SCOPE_AGENT)) != 0u) break;
                if (__builtin_amdgcn_s_memrealtime() - t0 > 2000000ull) {
                    if (ltid() == 0) { unsigned expect = 0u; __hip_atomic_compare_exchange_strong(tmo + 1, &expect, 0x600u | (unsigned)(u.pm & 0xff), __ATOMIC_RELAXED, __ATOMIC_RELAXED, __HIP_MEMORY_SCOPE_AGENT); __hip_atomic_store(tmo, 1u, __ATOMIC_RELAXED, __HIP_MEMORY_SCOPE_AGENT); }
                    break; }
                __builtin_amdgcn_s_sleep(2); }
            __builtin_amdgcn_fence(__ATOMIC_ACQUIRE, "agent");
            asm volatile("s_waitcnt vmcnt(0)" ::: "memory");
        }
#if !defined(BROKEN_HOOK_NO_BARRIER)
        asm volatile("" ::: "memory"); __builtin_amdgcn_s_barrier(); asm volatile("" ::: "memory");
#endif
    }
};

__device__ __forceinline__ unsigned cvt_pk_bf16(float lo, float hi) { unsigned r; asm volatile("v_cvt_pk_bf16_f32 %0, %1, %2" : "=v"(r) : "v"(lo), "v"(hi)); return r; }
typedef float f32x2 __attribute__((ext_vector_type(2)));
__device__ __forceinline__ f32x2 gelu_pk(f32x2 v) {
    const f32x2 av = __builtin_elementwise_abs(v), d = av * 0.2316418882f + 1.0f;
    f32x2 t; t.x = __builtin_amdgcn_rcpf(d.x); t.y = __builtin_amdgcn_rcpf(d.y);
    f32x2 q = t * 0.5307027145f + (-0.7265760135f); q = q * t + 0.7107068705f; q = q * t + (-0.142248368f); q = q * t + 0.127414796f; q = q * t;
    const f32x2 s = (v * v) * (-0.72134752044f);
    f32x2 e; e.x = __builtin_amdgcn_exp2f(s.x); e.y = __builtin_amdgcn_exp2f(s.y);
    const f32x2 m = v * (q * e), r = v - m;
    f32x2 o; o.x = v.x < 0.f ? m.x : r.x; o.y = v.y < 0.f ? m.y : r.y; return o;
}

struct EpiF32 {
    static constexpr bool PERM = false, AFTER_DRAIN = false;
    float* C; int ldc; const float* bias;
    __device__ __forceinline__ void operator()(const f32x4 (&acc)[2][2][4][2], const Unit& u, int wr, int wc, int fr, int fq) const {
        const int row0 = u.pm * BM + wr * 64 + fr, col0 = u.pn * BM + wc * 32 + 4 * fq;
        f32x4 bv[2][2];
#pragma unroll
        for (int bj = 0; bj < 2; ++bj)
#pragma unroll
            for (int n = 0; n < 2; ++n) bv[bj][n] = bias ? *(const f32x4*)(bias + col0 + bj * HALF + n * 16) : (f32x4){0.f, 0.f, 0.f, 0.f};
#pragma unroll
        for (int ai = 0; ai < 2; ++ai)
#pragma unroll
            for (int m = 0; m < 4; ++m) { float* rowp = C + (size_t)(row0 + ai * HALF + m * 16) * ldc + col0;
#pragma unroll
                for (int bj = 0; bj < 2; ++bj)
#pragma unroll
                    for (int n = 0; n < 2; ++n) *(f32x4*)(rowp + bj * HALF + n * 16) = acc[ai][bj][m][n] + bv[bj][n]; }
    }
};
template <int ACT  > struct EpiBf16 {
    static constexpr bool PERM = true, AFTER_DRAIN = false;
    bf16_t* O; int ldc; const float* bias; int split_cols; size_t split_stride;
    __device__ __forceinline__ void operator()(const f32x4 (&acc)[2][2][4][2], const Unit& u, int wr, int wc, int fr, int fq) const {
        const int row0 = u.pm * BM + wr * 64 + fr; int colt = u.pn * BM; bf16_t* base = O;
        if (split_cols) { const int t = colt / split_cols; base += (size_t)t * split_stride; colt -= t * split_cols; }
        const int col0 = colt + wc * 32 + 8 * fq, bcol0 = u.pn * BM + wc * 32 + 8 * fq;
        f32x4 bv[2][2];
#pragma unroll
        for (int bj = 0; bj < 2; ++bj)
#pragma unroll
            for (int n = 0; n < 2; ++n) bv[bj][n] = bias ? *(const f32x4*)(bias + bcol0 + bj * HALF + 4 * n) : (f32x4){0.f, 0.f, 0.f, 0.f};
#pragma unroll
        for (int ai = 0; ai < 2; ++ai)
#pragma unroll
            for (int m = 0; m < 4; ++m) { bf16_t* rowp = base + (size_t)(row0 + ai * HALF + m * 16) * ldc + col0;
#pragma unroll
                for (int bj = 0; bj < 2; ++bj) { f32x4 v0 = acc[ai][bj][m][0] + bv[bj][0], v1 = acc[ai][bj][m][1] + bv[bj][1];
                    if (ACT == 1) { f32x2 a = gelu_pk((f32x2){v0[0], v0[1]}), b = gelu_pk((f32x2){v0[2], v0[3]}), c = gelu_pk((f32x2){v1[0], v1[1]}), d = gelu_pk((f32x2){v1[2], v1[3]});
                        v0 = (f32x4){a.x, a.y, b.x, b.y}; v1 = (f32x4){c.x, c.y, d.x, d.y}; }
                    if (ACT == 2) {
#pragma unroll
                        for (int j = 0; j < 4; ++j) { v0[j] = 0.5f * v0[j] * (1.0f + erff(v0[j] * 0.70710678f)); v1[j] = 0.5f * v1[j] * (1.0f + erff(v1[j] * 0.70710678f)); } }
                    u32x4 w; w.x = cvt_pk_bf16(v0[0], v0[1]); w.y = cvt_pk_bf16(v0[2], v0[3]); w.z = cvt_pk_bf16(v1[0], v1[1]); w.w = cvt_pk_bf16(v1[2], v1[3]);
                    *(u32x4*)(rowp + bj * HALF) = w; } }
    }
};

template <class Epi, class Sched, bool STAMP = false>
__device__ __forceinline__ void gemm_phase(PG8_LAS unsigned char* lds, const Gemm g, const Sched& S, const Epi& E, unsigned long long* stamps) {
    const int tid = ltid(), wid = __builtin_amdgcn_readfirstlane(tid >> 6), lane = tid & 63, wr = wid >> 2, wc = wid & 3, fr = lane & 15, fq = lane >> 4;
    const int K = g.K, nt = K / BK;
    int ts_lo = 0, ts_hi = 0, nts = 0; const unsigned long long rt_entry = STAMP ? (unsigned long long)wall_clock64() : 0ull;
#define PG8_STAMP() do { if (STAMP && wid == 0 && nts < 64) { const unsigned long long _c = (unsigned long long)clock64(); \
        ts_lo = (lane == nts) ? (int)(unsigned)_c : ts_lo; ts_hi = (lane == nts) ? (int)(unsigned)(_c >> 32) : ts_hi; ++nts; } } while (0)
    PG8_STAMP();
    unsigned voffA[2], voffB[2];
#pragma unroll
    for (int i = 0; i < 2; ++i) { int R, C; stage_rc(tid * 16 + i * 8192, R, C); const int Rb = Epi::PERM ? ((R & ~31) + perm32(R & 31)) : R;
        voffA[i] = (unsigned)(R * K + C) * 2u; voffB[i] = (unsigned)(Rb * K + C) * 2u; }
    const size_t kstep = (size_t)(BK * 2);
    const size_t hstep = (size_t)HALF * K * 2;
    const size_t tstep = 2 * hstep;
    const unsigned ldsw = (unsigned)wid * 1024u;
    const int aoff = lds_byte(wr * 64 + fr, fq * 8), boff = lds_byte(wc * 32 + fr, fq * 8);
#define PG8_SA(b, h) (((b) * 2 + (h)) * HTB)
#define PG8_SB(b, h) ((4 + (b) * 2 + (h)) * HTB)
#define PG8_STAGE(bufoff, gbase, voff) do { _Pragma("unroll") for (int _i = 0; _i < 2; ++_i) \
        __builtin_amdgcn_global_load_lds((const unsigned*)((const char*)(gbase) + (voff)[_i]), (PG8_LAS unsigned*)(lds + (bufoff) + ldsw + _i * 8192), 16, 0, 0); } while (0)
#define PG8_LDA(dst, b, h) do { _Pragma("unroll") for (int m = 0; m < 4; ++m) _Pragma("unroll") for (int k = 0; k < 2; ++k) dst[m][k] = *(const PG8_LAS bf16x8*)(lds + PG8_SA(b, h) + aoff + m * 2048 + k * 1024); } while (0)
#define PG8_LDB(dst, b, h) do { _Pragma("unroll") for (int n = 0; n < 2; ++n) _Pragma("unroll") for (int k = 0; k < 2; ++k) dst[n][k] = *(const PG8_LAS bf16x8*)(lds + PG8_SB(b, h) + boff + n * 2048 + k * 1024); } while (0)
#define PG8_MMA(ai, bj, At, Bt) do { __builtin_amdgcn_s_setprio(1); _Pragma("unroll") for (int m = 0; m < 4; ++m) _Pragma("unroll") for (int n = 0; n < 2; ++n) _Pragma("unroll") for (int k = 0; k < 2; ++k) \
        acc[ai][bj][m][n] = __builtin_amdgcn_mfma_f32_16x16x32_bf16(Bt[n][k], At[m][k], acc[ai][bj][m][n], 0, 0, 0); __builtin_amdgcn_s_setprio(0); } while (0)
#define PG8_WAIT_V(n) asm volatile("s_waitcnt vmcnt(" #n ")" ::: "memory")
#define PG8_WAIT_L(n) asm volatile("s_waitcnt lgkmcnt(" #n ")" ::: "memory")
#define PG8_BAR __builtin_amdgcn_s_barrier()
#define PG8_SCHED __builtin_amdgcn_sched_barrier(0)
    Unit cur, nxt; int ui = 0;
    if (!S.next(0, cur)) return;
    f32x4 acc[2][2][4][2];
#pragma unroll
    for (int a = 0; a < 2; ++a)
#pragma unroll
        for (int b = 0; b < 2; ++b)
#pragma unroll
            for (int m = 0; m < 4; ++m)
#pragma unroll
                for (int n = 0; n < 2; ++n) acc[a][b][m][n] = (f32x4){0.f, 0.f, 0.f, 0.f};
    bf16x8 At[4][2], B0[2][2], B1[2][2];
    const char* cA = (const char*)g.A + (size_t)cur.pm * tstep; const char* cB = (const char*)g.Bt + (size_t)cur.pn * tstep;
    S.a_ready(cur);
    PG8_STAGE(PG8_SB(0, 0), cB, voffB); PG8_STAGE(PG8_SA(0, 0), cA, voffA); PG8_STAGE(PG8_SB(0, 1), cB + hstep, voffB); PG8_STAGE(PG8_SA(0, 1), cA + hstep, voffA);
    if (wr == 1) PG8_BAR;
    PG8_WAIT_V(4); PG8_BAR;
    PG8_STAGE(PG8_SB(1, 0), cB + kstep, voffB); PG8_STAGE(PG8_SA(1, 0), cA + kstep, voffA); PG8_STAGE(PG8_SB(1, 1), cB + hstep + kstep, voffB);
    PG8_WAIT_V(6); PG8_BAR;
    PG8_STAMP();
    for (;;) {
        const bool has_next = S.next(ui + 1, nxt);
        const char* nA = has_next ? (const char*)g.A + (size_t)nxt.pm * tstep : cA; const char* nB = has_next ? (const char*)g.Bt + (size_t)nxt.pn * tstep : cB;
        for (int t = 0; t < nt; t += 2) {
            const bool last = (t == nt - 2);
            const char* a1 = cA + (size_t)(t + 1) * kstep;
            const char* a2 = last ? nA : cA + (size_t)(t + 2) * kstep; const char* b2 = last ? nB : cB + (size_t)(t + 2) * kstep;
            const char* a3 = a2 + kstep; const char* b3 = b2 + kstep;
            if (last && has_next) S.a_ready(nxt);
            PG8_LDB(B0, 0, 0); PG8_SCHED; PG8_LDA(At, 0, 0); PG8_STAGE(PG8_SA(1, 1), a1 + hstep, voffA);
            PG8_WAIT_L(8); PG8_BAR; PG8_WAIT_L(0); PG8_MMA(0, 0, At, B0); PG8_BAR; PG8_SCHED;
            PG8_LDB(B1, 0, 1); PG8_STAGE(PG8_SB(0, 0), b2, voffB);
            PG8_BAR; PG8_WAIT_L(0); PG8_MMA(0, 1, At, B1); PG8_BAR;
            PG8_LDA(At, 0, 1); PG8_STAGE(PG8_SA(0, 0), a2, voffA);
            PG8_BAR; PG8_WAIT_L(0); PG8_MMA(1, 0, At, B0); PG8_BAR; PG8_SCHED;
            PG8_STAGE(PG8_SB(0, 1), b2 + hstep, voffB);
            PG8_WAIT_V(6); PG8_BAR; PG8_MMA(1, 1, At, B1); PG8_BAR;
            PG8_LDB(B0, 1, 0); PG8_SCHED; PG8_LDA(At, 1, 0); PG8_STAGE(PG8_SA(0, 1), a2 + hstep, voffA);
            PG8_WAIT_L(8); PG8_BAR; PG8_WAIT_L(0); PG8_MMA(0, 0, At, B0); PG8_BAR; PG8_SCHED;
            PG8_LDB(B1, 1, 1); PG8_STAGE(PG8_SB(1, 0), b3, voffB);
            PG8_BAR; PG8_WAIT_L(0); PG8_MMA(0, 1, At, B1); PG8_BAR;
            PG8_LDA(At, 1, 1); PG8_STAGE(PG8_SA(1, 0), a3, voffA);
            PG8_BAR; PG8_WAIT_L(0); PG8_MMA(1, 0, At, B0); PG8_BAR; PG8_SCHED;
            PG8_STAGE(PG8_SB(1, 1), b3 + hstep, voffB);
            PG8_WAIT_V(6); PG8_BAR; PG8_MMA(1, 1, At, B1); PG8_BAR;
        }
        PG8_STAMP();
        if constexpr (!Epi::AFTER_DRAIN) { E(acc, cur, wr, wc, fr, fq); S.done(cur); }
        PG8_STAMP();
        if (!has_next) break;
#pragma unroll
        for (int a = 0; a < 2; ++a)
#pragma unroll
            for (int b = 0; b < 2; ++b)
#pragma unroll
                for (int m = 0; m < 4; ++m)
#pragma unroll
                    for (int n = 0; n < 2; ++n) acc[a][b][m][n] = (f32x4){0.f, 0.f, 0.f, 0.f};
        cur = nxt; cA = nA; cB = nB; ++ui;
    }
    PG8_WAIT_V(0);
    if (wr == 0) PG8_BAR;
    PG8_BAR;
    if constexpr (Epi::AFTER_DRAIN) { E.fused(acc, cur, wr, wc, fr, fq, lds, wid, lane); S.done(cur); }
    PG8_STAMP();
    if (STAMP && wid == 0) { stamps[lane] = lane < nts ? (((unsigned long long)(unsigned)ts_hi << 32) | (unsigned)ts_lo) : 0ull;
        if (lane == 62) stamps[62] = rt_entry; if (lane == 63) stamps[63] = (unsigned long long)wall_clock64(); }
#undef PG8_STAMP
#undef PG8_SA
#undef PG8_SB
#undef PG8_STAGE
#undef PG8_LDA
#undef PG8_LDB
#undef PG8_MMA
#undef PG8_WAIT_V
#undef PG8_WAIT_L
#undef PG8_BAR
#undef PG8_SCHED
}
}

using pg8::bf16_t; using pg8::bf16x8; using pg8::f32x4; using pg8::u32x4;
typedef short s16x4 __attribute__((ext_vector_type(4)));
typedef float f32x16 __attribute__((ext_vector_type(16)));
typedef unsigned u32x2 __attribute__((ext_vector_type(2)));
#define LAS __attribute__((address_space(3)))
#define DI __device__ __forceinline__
#define MFMA32(a, b, c) __builtin_amdgcn_mfma_f32_32x32x16_bf16((a), (b), (c), 0, 0, 0)

constexpr int NB = 8, LL = 2064, NMETA = 16, DM = 2048, MTOK = NB * LL, MPAD = 16640;
constexpr int EVEN_IN = 15360, ODD_IN = 16384, MIXW = 4096;
constexpr int LDS_BYTES = 131072;
#ifndef PHM
#define PHM 255
#endif
constexpr float LOG2E = 1.4426950408889634f, LN2 = 0.6931471805599453f;

constexpr size_t OFF_H = 0;
constexpr size_t OFF_HN = OFF_H + (size_t)MPAD * DM * 4;
constexpr size_t OFF_Z = OFF_HN + (size_t)MPAD * DM * 2;
constexpr size_t OFF_MIX = OFF_Z + (size_t)MPAD * ODD_IN * 2;
constexpr size_t OFF_WIN = OFF_MIX + (size_t)MPAD * MIXW * 2;
constexpr size_t OFF_WOUT = OFF_WIN + (size_t)ODD_IN * DM * 2;
constexpr size_t WS_END = OFF_WOUT + (size_t)DM * MIXW * 2;

struct Params {
    const float *x, *meta, *norm_a, *w_in_a, *w_out_a, *hgrn_lb, *hgrn_norm, *sink, *norm_c, *w_in_c, *w_out_c, *dlam, *dnorm, *fnorm;
    float* out; unsigned char* ws; int ph_lo, ph_hi;
};

DI unsigned cvt_pk(float lo, float hi) { unsigned r; asm("v_cvt_pk_bf16_f32 %0, %1, %2" : "=v"(r) : "v"(lo), "v"(hi)); return r; }
DI float bf2f(bf16_t x) { return __uint_as_float(((unsigned)x) << 16); }
DI float bflo(unsigned u) { return __uint_as_float(u << 16); }
DI float bfhi(unsigned u) { return __uint_as_float(u & 0xffff0000u); }
DI float ex2(float x) { return __builtin_amdgcn_exp2f(x); }
DI float lg2(float x) { return __builtin_amdgcn_logf(x); }
DI float rcpf(float x) { return __builtin_amdgcn_rcpf(x); }
DI float siluf(float x) { return x * rcpf(1.f + ex2(-x * LOG2E)); }
DI float wave_sum(float v) {
#pragma unroll
    for (int o = 32; o; o >>= 1) v += __shfl_xor(v, o);
    return v; }
DI int crow(int reg, int h) { return (reg & 3) + 8 * (reg >> 2) + 4 * h; }
DI f32x16 zero16() { f32x16 z;
#pragma unroll
    for (int i = 0; i < 16; ++i) z[i] = 0.f;
    return z; }

template <int MODE>
DI void row_phase(const Params& p, const float* __restrict__ g) {
    const int wid = ltid() >> 6, lane = ltid() & 63;
    float* H = (float*)(p.ws + OFF_H); bf16_t* HN = (bf16_t*)(p.ws + OFF_HN);
    for (int r = blockIdx.x * 8 + wid; r < MPAD; r += gridDim.x * 8) {
        if (r >= MTOK) {
            if (MODE == 0) {
#pragma unroll
                for (int j = 0; j < 8; ++j) { *(f32x4*)(H + (size_t)r * DM + (j * 64 + lane) * 4) = (f32x4){0.f, 0.f, 0.f, 0.f}; }
            }
            if (MODE != 2) {
#pragma unroll
                for (int j = 0; j < 8; ++j) { u32x2 zz; zz.x = 0u; zz.y = 0u; *(u32x2*)(HN + (size_t)r * DM + (j * 64 + lane) * 4) = zz; }
            }
            continue;
        }
        const int b = r / LL, t = r - b * LL;
        const float* src;
        if (MODE == 0) src = (t < NMETA) ? (p.meta + (size_t)t * DM) : (p.x + ((size_t)b * 2048 + (t - NMETA)) * DM);
        else src = H + (size_t)r * DM;
        f32x4 v[8]; float ss = 0.f;
#pragma unroll
        for (int j = 0; j < 8; ++j) { v[j] = *(const f32x4*)(src + (j * 64 + lane) * 4); ss += v[j][0] * v[j][0] + v[j][1] * v[j][1] + v[j][2] * v[j][2] + v[j][3] * v[j][3]; }
        ss = wave_sum(ss);
        const float rstd = rsqrtf(ss * (1.f / DM) + 1e-6f);
        if (MODE == 0) {
#pragma unroll
            for (int j = 0; j < 8; ++j) *(f32x4*)(H + (size_t)r * DM + (j * 64 + lane) * 4) = v[j];
        }
        if (MODE == 2) {
            if (t >= NMETA) { float* op = p.out + ((size_t)b * 2048 + (t - NMETA)) * DM;
#pragma unroll
                for (int j = 0; j < 8; ++j) { const f32x4 gg = *(const f32x4*)(g + (j * 64 + lane) * 4); f32x4 o; o[0] = v[j][0] * rstd * gg[0]; o[1] = v[j][1] * rstd * gg[1]; o[2] = v[j][2] * rstd * gg[2]; o[3] = v[j][3] * rstd * gg[3];
                    *(f32x4*)(op + (j * 64 + lane) * 4) = o; } }
        } else {
#pragma unroll
            for (int j = 0; j < 8; ++j) { const f32x4 gg = *(const f32x4*)(g + (j * 64 + lane) * 4); u32x2 w; w.x = cvt_pk(v[j][0] * rstd * gg[0], v[j][1] * rstd * gg[1]); w.y = cvt_pk(v[j][2] * rstd * gg[2], v[j][3] * rstd * gg[3]);
                *(u32x2*)(HN + (size_t)r * DM + (j * 64 + lane) * 4) = w; }
        }
    }
}

DI void convert_T(LAS unsigned char* lds, const float* __restrict__ W, bf16_t* __restrict__ Wt, const int K, const int N) {
    LAS float* tile = (LAS float*)lds;
    const int tid = ltid(), nk = K >> 6, ntile = nk * (N >> 6);
    const int tx = tid & 63, ty = tid >> 6, wn = tid >> 3, wk = (tid & 7) * 8;
    for (int t = blockIdx.x; t < ntile; t += gridDim.x) {
        const int k0 = (t % nk) << 6, n0 = (t / nk) << 6;
        float r[8];
#pragma unroll
        for (int i = 0; i < 8; ++i) r[i] = W[(size_t)(k0 + ty * 8 + i) * N + n0 + tx];
#pragma unroll
        for (int i = 0; i < 8; ++i) tile[(ty * 8 + i) * 65 + tx] = r[i];
        __syncthreads();
        float e[8];
#pragma unroll
        for (int i = 0; i < 8; ++i) e[i] = tile[(wk + i) * 65 + wn];
        u32x4 w; w.x = cvt_pk(e[0], e[1]); w.y = cvt_pk(e[2], e[3]); w.z = cvt_pk(e[4], e[5]); w.w = cvt_pk(e[6], e[7]);
        *(u32x4*)(Wt + (size_t)(n0 + wn) * K + k0 + wk) = w;
        __syncthreads();
    }
}

struct EpiResAdd {
    static constexpr bool PERM = false, AFTER_DRAIN = false;
    float* H; int ldc;
    DI void operator()(const f32x4 (&acc)[2][2][4][2], const pg8::Unit& u, int wr, int wc, int fr, int fq) const {
        const int row0 = u.pm * pg8::BM + wr * 64 + fr, col0 = u.pn * pg8::BM + wc * 32 + 4 * fq;
#pragma unroll
        for (int ai = 0; ai < 2; ++ai)
#pragma unroll
            for (int m = 0; m < 4; ++m) { float* rowp = H + (size_t)(row0 + ai * pg8::HALF + m * 16) * ldc + col0;
#pragma unroll
                for (int bj = 0; bj < 2; ++bj)
#pragma unroll
                    for (int n = 0; n < 2; ++n) { f32x4* q = (f32x4*)(rowp + bj * pg8::HALF + n * 16); *q = *q + acc[ai][bj][m][n]; } }
    }
};

template <int NDV, int NK, bool WINM>
DI void attn_unit(LAS unsigned char* lds, const bf16_t* __restrict__ zb, const int ldz, const int qcol, const int kcol0, const int kcol1, const int vcol,
                  const int gcol, const int ocol, const float c2, const float sink2, const int t0, const int lo, const int nt,
                  bf16_t* __restrict__ mixb, const float lam, const float* __restrict__ normg, const float oscale) {
    constexpr int DV = NDV * 32, KSTR = 272, VSTR = 72, KB = 32 * KSTR, BUFB = NK * KB + DV * VSTR;
    const int tid = ltid(), wid = tid >> 6, lane = tid & 63, r32 = lane & 31, half = lane >> 5, j = wid >> 2, wq = wid & 3;
    const int tq = t0 + wq * 32 + r32;
    const float c1 = 0.08838834764831845f * LOG2E;
    bf16x8 qf[8];
    { const bf16_t* qp = zb + (size_t)tq * ldz + qcol + half * 8;
#pragma unroll
      for (int ks = 0; ks < 8; ++ks) qf[ks] = *(const bf16x8*)(qp + ks * 16); }
    f32x16 o[NDV];
#pragma unroll
    for (int n = 0; n < NDV; ++n) o[n] = zero16();
    float m = -1e30f, l = 0.f;
    u32x4 sr[4];
    const bool isV = tid < DV, isK = (!isV) && (tid < DV + NK * 128);
    const int kidx = tid - DV;
#define ATT_LOAD(key0_) do { const int key0__ = (key0_); \
        if (isV) { const int kg = tid & 7, dg = tid >> 3; const bf16_t* vp_ = zb + (size_t)(key0__ + kg * 4) * ldz + vcol + dg * 8; \
            _Pragma("unroll") for (int jj = 0; jj < 4; ++jj) sr[jj] = *(const u32x4*)(vp_ + (size_t)jj * ldz); } \
        else if (isK) { const int mp_ = kidx >> 7, rr_ = kidx & 127; const int kc_ = mp_ ? kcol1 : kcol0; \
            _Pragma("unroll") for (int jj = 0; jj < 4; ++jj) { const int c_ = rr_ + 128 * jj; sr[jj] = *(const u32x4*)(zb + (size_t)(key0__ + (c_ >> 4)) * ldz + kc_ + (c_ & 15) * 8); } } } while (0)
#define ATT_STORE(buf_) do { LAS unsigned char* B_ = lds + (buf_) * BUFB; \
        if (isV) { const int kg = tid & 7, dg = tid >> 3; LAS unsigned char* vt_ = B_ + NK * KB + (dg * 8) * VSTR + kg * 8; \
            _Pragma("unroll") for (int w_ = 0; w_ < 4; ++w_) { const unsigned a0 = sr[0][w_], a1 = sr[1][w_], a2 = sr[2][w_], a3 = sr[3][w_]; \
                u32x2 e0, e1; e0.x = (a0 & 0xffffu) | (a1 << 16); e0.y = (a2 & 0xffffu) | (a3 << 16); e1.x = (a0 >> 16) | (a1 & 0xffff0000u); e1.y = (a2 >> 16) | (a3 & 0xffff0000u); \
                *(LAS u32x2*)(vt_ + (2 * w_) * VSTR) = e0; *(LAS u32x2*)(vt_ + (2 * w_ + 1) * VSTR) = e1; } } \
        else if (isK) { const int mp_ = kidx >> 7, rr_ = kidx & 127; \
            _Pragma("unroll") for (int jj = 0; jj < 4; ++jj) { const int c_ = rr_ + 128 * jj; *(LAS u32x4*)(B_ + mp_ * KB + (c_ >> 4) * KSTR + (c_ & 15) * 16) = sr[jj]; } } } while (0)

    ATT_LOAD(0); ATT_STORE(0); __syncthreads();
    for (int it = 0; it < nt; ++it) {
        const int cur = it & 1;
        const int key0 = 32 * (WINM ? (it == 0 ? 0 : lo + it - 1) : it);
        if (it + 1 < nt) ATT_LOAD(32 * (WINM ? (lo + it) : (it + 1)));
        LAS unsigned char* B = lds + cur * BUFB;
        LAS unsigned char* kb = B + (NK == 2 ? j * KB : 0) + r32 * KSTR + half * 16;
        f32x16 st = zero16();
#pragma unroll
        for (int ks = 0; ks < 8; ++ks) { const bf16x8 a = *(LAS bf16x8*)(kb + ks * 32); st = MFMA32(a, qf[ks], st); }
        const float basef = (float)(tq - key0 - 4 * half);
        const bool tail = (key0 + 32 > LL);
        float x[16]; float mx = -INFINITY;
#pragma unroll
        for (int i = 0; i < 16; ++i) { const int off = 8 * (i >> 2) + (i & 3); float d = fabsf(basef - (float)off); bool valid;
            const int s = key0 + 4 * half + off;
            if (WINM) { const bool meta = s < NMETA; valid = meta || (d <= 128.f && s < LL); d = meta ? fminf(d, 128.f) : d; }
            else valid = (!tail) || (s < LL);
            float xv = fmaf(st[i], c1, -c2 * d); xv = valid ? xv : -INFINITY; x[i] = xv; mx = fmaxf(mx, xv); }
        mx = fmaxf(mx, __shfl_xor(mx, 32));
        const bool need = mx > m + 8.f;
        if (__any(need)) {
            const float mn = need ? mx : m; const float al = ex2(m - mn);
            l *= al;
#pragma unroll
            for (int n = 0; n < NDV; ++n)
#pragma unroll
                for (int i = 0; i < 16; ++i) o[n][i] *= al;
            m = mn;
        }
        float ps = 0.f;
#pragma unroll
        for (int i = 0; i < 16; ++i) { x[i] = ex2(x[i] - m); ps += x[i]; }
        l += ps;
#pragma unroll
        for (int s2 = 0; s2 < 2; ++s2) {
            u32x4 pk; pk.x = cvt_pk(x[8 * s2], x[8 * s2 + 1]); pk.y = cvt_pk(x[8 * s2 + 2], x[8 * s2 + 3]); pk.z = cvt_pk(x[8 * s2 + 4], x[8 * s2 + 5]); pk.w = cvt_pk(x[8 * s2 + 6], x[8 * s2 + 7]);
            const bf16x8 pb = __builtin_bit_cast(bf16x8, pk);
#pragma unroll
            for (int n = 0; n < NDV; ++n) { LAS unsigned char* vp = B + NK * KB + (n * 32 + r32) * VSTR + (16 * s2 + 4 * half) * 2;
                const s16x4 lo4 = *(LAS s16x4*)vp; const s16x4 hi4 = *(LAS s16x4*)(vp + 16);
                const bf16x8 a = __builtin_shufflevector(lo4, hi4, 0, 1, 2, 3, 4, 5, 6, 7);
                o[n] = MFMA32(a, pb, o[n]); }
        }
        if (it + 1 < nt) ATT_STORE(cur ^ 1);
        __syncthreads();
    }
#undef ATT_LOAD
#undef ATT_STORE
    float lt = l + __shfl_xor(l, 32);
    if (WINM) lt += ex2(sink2 - m);
    const float inv = 1.f / lt;
    const bool tval = tq < LL;
    if (WINM) {
        if (tval) { const bf16_t* gp = zb + (size_t)tq * ldz + gcol + 4 * half; bf16_t* op = mixb + (size_t)tq * MIXW + ocol + 4 * half;
#pragma unroll
            for (int n = 0; n < NDV; ++n)
#pragma unroll
                for (int g4 = 0; g4 < 4; ++g4) { const int dv = n * 32 + 8 * g4; const u32x2 gg = *(const u32x2*)(gp + dv);
                    u32x2 w; w.x = cvt_pk(o[n][4 * g4] * inv * siluf(bflo(gg.x)), o[n][4 * g4 + 1] * inv * siluf(bfhi(gg.x)));
                    w.y = cvt_pk(o[n][4 * g4 + 2] * inv * siluf(bflo(gg.y)), o[n][4 * g4 + 3] * inv * siluf(bfhi(gg.y)));
                    *(u32x2*)(op + dv) = w; } }
    } else {
        LAS float* xb = (LAS float*)lds + wq * (DV * 32) + 128 * half + r32;
        if (j == 1) { const float sc = inv * lam;
#pragma unroll
            for (int n = 0; n < NDV; ++n)
#pragma unroll
                for (int i = 0; i < 16; ++i) xb[(n * 32 + 8 * (i >> 2) + (i & 3)) * 32] = o[n][i] * sc; }
        __syncthreads();
        if (j == 0) { float ss = 0.f;
#pragma unroll
            for (int n = 0; n < NDV; ++n)
#pragma unroll
                for (int i = 0; i < 16; ++i) { const float v = o[n][i] * inv - xb[(n * 32 + 8 * (i >> 2) + (i & 3)) * 32]; o[n][i] = v; ss += v * v; }
            ss += __shfl_xor(ss, 32);
            const float rstd = rsqrtf(ss * (1.f / DV) + 1e-6f) * oscale;
            const float* ngp = normg; asm volatile("" : "+s"(ngp)); ngp += 4 * half;
            if (tval) { const bf16_t* gp = zb + (size_t)tq * ldz + gcol + 4 * half; bf16_t* op = mixb + (size_t)tq * MIXW + ocol + 4 * half;
#pragma unroll
                for (int n = 0; n < NDV; ++n)
#pragma unroll
                    for (int g4 = 0; g4 < 4; ++g4) { const int dv = n * 32 + 8 * g4; const u32x2 gg = *(const u32x2*)(gp + dv); const f32x4 ng = *(const f32x4*)(ngp + dv);
                        u32x2 w; w.x = cvt_pk(o[n][4 * g4] * rstd * ng[0] * siluf(bflo(gg.x)), o[n][4 * g4 + 1] * rstd * ng[1] * siluf(bfhi(gg.x)));
                        w.y = cvt_pk(o[n][4 * g4 + 2] * rstd * ng[2] * siluf(bflo(gg.y)), o[n][4 * g4 + 3] * rstd * ng[3] * siluf(bfhi(gg.y)));
                        *(u32x2*)(op + dv) = w; } }
        }
        __syncthreads();
    }
}

DI void hgrn_seq(LAS unsigned char* lds, const bf16_t* __restrict__ zb, const int ldz, const int h, const int dir, const float lbv, bf16_t* __restrict__ dst, const int ldd) {
    constexpr int QC = 0, KH = 17408, KT = 34816, VT = 53248, SL = 71680, SC = 106496, TOT = 115712, E1 = 117760, GM = 118272;
    const int tid = ltid(), wid = tid >> 6, lane = tid & 63, r32 = lane & 31, half = lane >> 5;
    const int k = tid & 127, tg = tid >> 7;
    const int fcol = dir ? 4096 : 2048;
    const int n = wid & 3, kt0 = 2 * (wid >> 2), ti = wid >> 2;
    LAS float* tot = (LAS float*)(lds + TOT); LAS float* e1p = (LAS float*)(lds + E1); LAS float* gmp = (LAS float*)(lds + GM);
    LAS float* e1l = e1p + kt0 * 32 + 4 * half; LAS float* gml = gmp + kt0 * 32 + 4 * half;
    f32x16 S[2]; S[0] = zero16(); S[1] = zero16();
    const float oml = 1.f - lbv;
    for (int c = 0; c < 33; ++c) {
        float qv[16], kk[16], bl[16]; unsigned vp[8]; float run = 0.f;
        {
            float vv[16];
#pragma unroll
            for (int e = 0; e < 16; ++e) {
                const int P = 64 * c + tg * 16 + e; const int pp = dir ? 2111 - P : P; const int t = pp - 48; const bool ok = t >= 0; const int tt = ok ? t : 0;
                const bf16_t* row = zb + (size_t)tt * ldz + h * 128 + k;
                const float q = bf2f(row[0]), zf = bf2f(row[fcol]), v = bf2f(row[6144]);
                const float ex = ex2(-zf * LOG2E), rden = rcpf(1.f + ex);
                const float lf = lg2((1.f + lbv * ex) * rden);
                run += ok ? lf : 0.f; bl[e] = run; qv[e] = ok ? q : 0.f; kk[e] = ok ? oml * ex * rden : 0.f; vv[e] = ok ? v : 0.f;
            }
#pragma unroll
            for (int e = 0; e < 8; ++e) vp[e] = cvt_pk(vv[2 * e], vv[2 * e + 1]);
        }
        tot[tg * 128 + k] = run;
        __syncthreads();
        {
            const float t0_ = tot[k], t1_ = tot[128 + k], t2_ = tot[256 + k], t3_ = tot[384 + k];
            const float off = (tg > 0 ? t0_ : 0.f) + (tg > 1 ? t1_ : 0.f) + (tg > 2 ? t2_ : 0.f);
            const float bmid = t0_ + t1_;
            if (tg == 0) { e1p[k] = ex2(bmid); gmp[k] = ex2(t2_ + t3_); }
            unsigned khp[8]; float khv[16];
#pragma unroll
            for (int e = 0; e < 16; ++e) { const float dq = off + bl[e] - bmid; const float qc = qv[e] * ex2(dq); khv[e] = kk[e] * ex2(-dq);
                const int i = tg * 16 + e;
                *(LAS bf16_t*)(lds + QC + i * 272 + k * 2) = (bf16_t)(cvt_pk(qc, qc) & 0xffffu);
                *(LAS bf16_t*)(lds + KH + i * 272 + k * 2) = (bf16_t)(cvt_pk(khv[e], khv[e]) & 0xffffu); }
#pragma unroll
            for (int e = 0; e < 8; ++e) khp[e] = cvt_pk(khv[2 * e], khv[2 * e + 1]);
            u32x4 w0, w1; w0.x = khp[0]; w0.y = khp[1]; w0.z = khp[2]; w0.w = khp[3]; w1.x = khp[4]; w1.y = khp[5]; w1.z = khp[6]; w1.w = khp[7];
            *(LAS u32x4*)(lds + KT + k * 144 + tg * 32) = w0; *(LAS u32x4*)(lds + KT + k * 144 + tg * 32 + 16) = w1;
            w0.x = vp[0]; w0.y = vp[1]; w0.z = vp[2]; w0.w = vp[3]; w1.x = vp[4]; w1.y = vp[5]; w1.z = vp[6]; w1.w = vp[7];
            *(LAS u32x4*)(lds + VT + k * 144 + tg * 32) = w0; *(LAS u32x4*)(lds + VT + k * 144 + tg * 32 + 16) = w1;
        }
        __syncthreads();
#pragma unroll
        for (int a = 0; a < 2; ++a) { const int kt = kt0 + a;
#pragma unroll
            for (int i = 0; i < 16; ++i) S[a][i] *= e1l[a * 32 + 8 * (i >> 2) + (i & 3)];
#pragma unroll
            for (int g4 = 0; g4 < 4; ++g4) { u32x2 w; w.x = cvt_pk(S[a][4 * g4], S[a][4 * g4 + 1]); w.y = cvt_pk(S[a][4 * g4 + 2], S[a][4 * g4 + 3]);
                *(LAS u32x2*)(lds + SL + (n * 32 + r32) * 272 + (kt * 32 + 8 * g4 + 4 * half) * 2) = w; } }
        if (wid < 4) { const int si = wid >> 1, tj = wid & 1;
            f32x16 acc = zero16();
            if (si <= tj) {
#pragma unroll
                for (int ks = 0; ks < 8; ++ks) { const bf16x8 a = *(LAS bf16x8*)(lds + KH + (si * 32 + r32) * 272 + ks * 32 + half * 16); const bf16x8 b = *(LAS bf16x8*)(lds + QC + (tj * 32 + r32) * 272 + ks * 32 + half * 16);
                    acc = MFMA32(a, b, acc); }
            }
            const int tt = tj * 32 + r32;
#pragma unroll
            for (int g4 = 0; g4 < 4; ++g4) { float v4[4];
#pragma unroll
                for (int q = 0; q < 4; ++q) { const int s = si * 32 + 8 * g4 + 4 * half + q; v4[q] = (s <= tt) ? acc[4 * g4 + q] : 0.f; }
                u32x2 w; w.x = cvt_pk(v4[0], v4[1]); w.y = cvt_pk(v4[2], v4[3]);
                *(LAS u32x2*)(lds + SC + tt * 144 + (si * 32 + 8 * g4 + 4 * half) * 2) = w; } }
        __syncthreads();
        { f32x16 acc = zero16();
#pragma unroll
          for (int ks = 0; ks < 8; ++ks) { const bf16x8 a = *(LAS bf16x8*)(lds + SL + (n * 32 + r32) * 272 + ks * 32 + half * 16); const bf16x8 b = *(LAS bf16x8*)(lds + QC + (ti * 32 + r32) * 272 + ks * 32 + half * 16);
              acc = MFMA32(a, b, acc); }
#pragma unroll
          for (int ss = 0; ss < 4; ++ss) { if (ss < 2 || ti == 1) { const bf16x8 a = *(LAS bf16x8*)(lds + VT + (n * 32 + r32) * 144 + ss * 32 + half * 16); const bf16x8 b = *(LAS bf16x8*)(lds + SC + (ti * 32 + r32) * 144 + ss * 32 + half * 16);
              acc = MFMA32(a, b, acc); } }
          const int P = 64 * c + ti * 32 + r32; const int pp = dir ? 2111 - P : P; const int t = pp - 48;
          if (t >= 0) { bf16_t* op = dst + (size_t)t * ldd + n * 32 + 4 * half;
#pragma unroll
              for (int g4 = 0; g4 < 4; ++g4) { u32x2 w; w.x = cvt_pk(acc[4 * g4], acc[4 * g4 + 1]); w.y = cvt_pk(acc[4 * g4 + 2], acc[4 * g4 + 3]); *(u32x2*)(op + 8 * g4) = w; } }
        }
#pragma unroll
        for (int a = 0; a < 2; ++a) { const int kt = kt0 + a;
#pragma unroll
            for (int ss = 0; ss < 4; ++ss) { const bf16x8 av = *(LAS bf16x8*)(lds + KT + (kt * 32 + r32) * 144 + ss * 32 + half * 16); const bf16x8 bv = *(LAS bf16x8*)(lds + VT + (n * 32 + r32) * 144 + ss * 32 + half * 16);
                S[a] = MFMA32(av, bv, S[a]); }
#pragma unroll
            for (int i = 0; i < 16; ++i) S[a][i] *= gml[a * 32 + 8 * (i >> 2) + (i & 3)]; }
    }
    __syncthreads();
}

DI int xcd_unit(int i) { const int G = gridDim.x, c = blockIdx.x; return (G & 7) ? (i * G + c) : ((i * 8 + (c & 7)) * (G >> 3) + (c >> 3)); }

DI void mix_even(const Params& p, LAS unsigned char* lds, const int li) {
    const bf16_t* Z = (const bf16_t*)(p.ws + OFF_Z); bf16_t* MIX = (bf16_t*)(p.ws + OFF_MIX); bf16_t* HN = (bf16_t*)(p.ws + OFF_HN);
    const int k = ltid() & 127, wid = ltid() >> 6;
    for (int u = blockIdx.x; u < 256; u += gridDim.x) {
        const int b = u >> 5, h = (u >> 1) & 15, dir = u & 1;
        float lbv = 0.f;
        if (li == 1) { const float a0 = p.hgrn_lb[(size_t)(dir * 2 + 0) * 2048 + h * 128 + k], a1 = p.hgrn_lb[(size_t)(dir * 2 + 1) * 2048 + h * 128 + k]; lbv = 1.f / (1.f + __expf(a0 - a1)); }
        hgrn_seq(lds, Z + (size_t)b * LL * EVEN_IN, EVEN_IN, h, dir, lbv, dir ? (MIX + (size_t)b * LL * MIXW + h * 128) : (HN + (size_t)b * LL * DM + h * 128), dir ? MIXW : DM);
    }
    const int j = wid >> 2;
    for (int i = 0;; ++i) {
        const int u = xcd_unit(i); if (u >= 1088) break;
        const int qb = u % 17, r = u / 17, pair = r & 1, kvh = (r >> 1) & 3, b = r >> 3;
        const int hq = kvh * 4 + pair * 2 + j;
        const float slope = exp2f(-0.5f * (float)(hq + 1));
        const int t0 = qb * 128;
        const int lo = (t0 - 128) < 32 ? 1 : ((t0 - 128) >> 5);
        const int hi = ((t0 + 255) >> 5) > 64 ? 64 : ((t0 + 255) >> 5);
        attn_unit<4, 1, true>(lds, Z + (size_t)b * LL * EVEN_IN, EVEN_IN, 10240 + hq * 128, 12288 + kvh * 128, 0, 12800 + kvh * 128, 13312 + hq * 128, 2048 + hq * 128,
                              slope * LOG2E, p.sink[li * 16 + hq] * LOG2E, t0, lo, 2 + hi - lo, MIX + (size_t)b * LL * MIXW, 0.f, nullptr, 0.f);
    }
}

DI void fin_even(const Params& p, const int li) {
    const bf16_t* Z = (const bf16_t*)(p.ws + OFF_Z); bf16_t* MIX = (bf16_t*)(p.ws + OFF_MIX); const bf16_t* OF = (const bf16_t*)(p.ws + OFF_HN);
    const int wid = ltid() >> 6, lane = ltid() & 63;
    const float* ng = p.hgrn_norm + li * 128 + (lane & 3) * 32;
    for (int r = blockIdx.x * 8 + wid; r < MTOK; r += gridDim.x * 8) {
        const bf16_t* f = OF + (size_t)r * DM + lane * 32; bf16_t* mb = MIX + (size_t)r * MIXW + lane * 32; const bf16_t* gp = Z + (size_t)r * EVEN_IN + 8192 + lane * 32;
        float v[32]; float ss = 0.f;
#pragma unroll
        for (int q = 0; q < 4; ++q) { const u32x4 a = *(const u32x4*)(f + q * 8), c = *(const u32x4*)(mb + q * 8);
#pragma unroll
            for (int w = 0; w < 4; ++w) { v[q * 8 + 2 * w] = bflo(a[w]) + bflo(c[w]); v[q * 8 + 2 * w + 1] = bfhi(a[w]) + bfhi(c[w]); } }
#pragma unroll
        for (int e = 0; e < 32; ++e) ss += v[e] * v[e];
        ss += __shfl_xor(ss, 1); ss += __shfl_xor(ss, 2);
        const float rstd = rsqrtf(ss * (1.f / 128) + 1e-6f);
#pragma unroll
        for (int q = 0; q < 4; ++q) { const u32x4 g = *(const u32x4*)(gp + q * 8); u32x4 w;
#pragma unroll
            for (int w_ = 0; w_ < 4; ++w_) { const int e = q * 8 + 2 * w_;
                w[w_] = cvt_pk(v[e] * rstd * ng[e] * siluf(bflo(g[w_])), v[e + 1] * rstd * ng[e + 1] * siluf(bfhi(g[w_]))); }
            *(u32x4*)(mb + q * 8) = w; }
    }
}

DI void mix_odd(const Params& p, LAS unsigned char* lds, const int li, const int layer) {
    const bf16_t* Z = (const bf16_t*)(p.ws + OFF_Z); bf16_t* MIX = (bf16_t*)(p.ws + OFF_MIX);
    const int lane = ltid() & 63, wid = ltid() >> 6, j = wid >> 2;
    const float* lv = p.dlam + li * 512;
    const float d1 = wave_sum(lv[lane] * lv[128 + lane] + lv[64 + lane] * lv[192 + lane]);
    const float d2 = wave_sum(lv[256 + lane] * lv[384 + lane] + lv[320 + lane] * lv[448 + lane]);
    const float lam_init = 0.8f - 0.6f * expf(-0.3f * (float)layer);
    const float lam = expf(d1) - expf(d2) + lam_init;
    for (int i = 0;; ++i) {
        const int u = xcd_unit(i); if (u >= 2176) break;
        const int qb = u % 17, r = u / 17, h = r & 15, b = r >> 4;
        const float slope = exp2f(-0.5f * (float)(h + 1));
        attn_unit<8, 2, false>(lds, Z + (size_t)b * LL * ODD_IN, ODD_IN, h * 256 + j * 128, 4096 + h * 256, 4096 + h * 256 + 128, 8192 + h * 256, 12288 + h * 256, h * 256,
                               slope * LOG2E, 0.f, qb * 128, 0, 65, MIX + (size_t)b * LL * MIXW, lam, p.dnorm + li * 256, 1.f - lam_init);
    }
}


template <bool EVEN>
DI void run_g1(const Params& p, LAS unsigned char* lds) {
    constexpr int nin = EVEN ? EVEN_IN : ODD_IN;
    pg8::Gemm g; g.A = (const bf16_t*)(p.ws + OFF_HN); g.Bt = (const bf16_t*)(p.ws + OFF_WIN); g.M = MPAD; g.N = nin; g.K = DM;
    pg8::StaticOrder S; S.init(MPAD, nin, (int)gridDim.x, (int)blockIdx.x);
    pg8::EpiBf16<0> E; E.O = (bf16_t*)(p.ws + OFF_Z); E.ldc = nin; E.bias = nullptr; E.split_cols = 0; E.split_stride = 0;
    pg8::gemm_phase<pg8::EpiBf16<0>, pg8::StaticOrder, false>(lds, g, S, E, nullptr);
}
DI void run_g2(const Params& p, LAS unsigned char* lds) {
    pg8::Gemm g; g.A = (const bf16_t*)(p.ws + OFF_MIX); g.Bt = (const bf16_t*)(p.ws + OFF_WOUT); g.M = MPAD; g.N = DM; g.K = MIXW;
    pg8::StaticOrder S; S.init(MPAD, DM, (int)gridDim.x, (int)blockIdx.x);
    EpiResAdd E; E.H = (float*)(p.ws + OFF_H); E.ldc = DM;
    pg8::gemm_phase<EpiResAdd, pg8::StaticOrder, false>(lds, g, S, E, nullptr);
}

#define PH_IN(k) (lo <= (k) && (k) < hi)
#define PH_SYNC(k) do { if (PH_IN(k) && PH_IN((k) + 1)) grid.sync(); } while (0)
DI void layer_pair(const Params& p, LAS unsigned char* lds, cg::grid_group& grid, const int lo, const int hi, const int pr) {
    bf16_t* WIN = (bf16_t*)(p.ws + OFF_WIN); bf16_t* WOUT = (bf16_t*)(p.ws + OFF_WOUT);

        const int k0 = 1 + 9 * pr;
        if (PH_IN(k0 + 0)) run_g1<true>(p, lds);
        PH_SYNC(k0 + 0);
        if (PH_IN(k0 + 1)) { mix_even(p, lds, pr); __syncthreads();
            convert_T(lds, p.w_out_a + (size_t)pr * MIXW * DM, WOUT, MIXW, DM);
            convert_T(lds, p.w_in_c + (size_t)pr * DM * ODD_IN, WIN, DM, ODD_IN); }
        PH_SYNC(k0 + 1);
        if (PH_IN(k0 + 2)) fin_even(p, pr);
        PH_SYNC(k0 + 2);
        if (PH_IN(k0 + 3)) run_g2(p, lds);
        PH_SYNC(k0 + 3);
        if (PH_IN(k0 + 4)) row_phase<1>(p, p.norm_c + (size_t)pr * DM);
        PH_SYNC(k0 + 4);
        if (PH_IN(k0 + 5)) run_g1<false>(p, lds);
        PH_SYNC(k0 + 5);
        if (PH_IN(k0 + 6)) { mix_odd(p, lds, pr, 2 * pr + 1); __syncthreads();
            convert_T(lds, p.w_out_c + (size_t)pr * MIXW * DM, WOUT, MIXW, DM);
            if (pr == 0) convert_T(lds, p.w_in_a + (size_t)DM * EVEN_IN, WIN, DM, EVEN_IN); }
        PH_SYNC(k0 + 6);
        if (PH_IN(k0 + 7)) run_g2(p, lds);
        PH_SYNC(k0 + 7);
        if (PH_IN(k0 + 8)) { if (pr == 1) row_phase<2>(p, p.fnorm); else row_phase<1>(p, p.norm_a + (size_t)DM); }
        PH_SYNC(k0 + 8);
}

__global__ void __launch_bounds__(512, 2) mega(Params p) {
    extern __shared__ __attribute__((aligned(16))) unsigned char lds_raw[];
    LAS unsigned char* lds = (LAS unsigned char*)lds_raw;
    cg::grid_group grid = cg::this_grid();
    const int lo = p.ph_lo, hi = p.ph_hi;
    bf16_t* WIN = (bf16_t*)(p.ws + OFF_WIN); bf16_t* WOUT = (bf16_t*)(p.ws + OFF_WOUT);
    if (PH_IN(0)) { row_phase<0>(p, p.norm_a); convert_T(lds, p.w_in_a, WIN, DM, EVEN_IN); }
    PH_SYNC(0);
    layer_pair(p, lds, grid, lo, hi, 0);
    layer_pair(p, lds, grid, lo, hi, 1);
}

constexpr int N_PHASES = 19;

extern "C" void kernel_launch(void* const* d_in, const int* in_sizes, int n_in, void* d_out, int out_size, void* d_ws, size_t ws_size, hipStream_t stream) {
    static int grid = 0;
    if (grid == 0) {
        if (n_in != 14 || ws_size < WS_END) { fprintf(stderr, "kernel_launch: need 14 inputs and %zu bytes of workspace; got %d, %zu\n", (size_t)WS_END, n_in, ws_size); grid = -1; return; }
        int dev = 0, cus = 0, per_cu = 0;
        hipGetDevice(&dev); hipDeviceGetAttribute(&cus, hipDeviceAttributeMultiprocessorCount, dev);
        if (hipFuncSetAttribute((const void*)mega, hipFuncAttributeMaxDynamicSharedMemorySize, LDS_BYTES) != hipSuccess) { fprintf(stderr, "kernel_launch: hipFuncSetAttribute failed\n"); grid = -1; return; }
        if (hipOccupancyMaxActiveBlocksPerMultiprocessor(&per_cu, (const void*)mega, 512, LDS_BYTES) != hipSuccess || per_cu < 1) { fprintf(stderr, "kernel_launch: occupancy query says %d\n", per_cu); per_cu = 1; }
        (void)hipGetLastError();
        grid = cus * 1;
    }
    if (grid < 0) return;
    Params p{};
    p.x = (const float*)d_in[0]; p.meta = (const float*)d_in[1]; p.norm_a = (const float*)d_in[2]; p.w_in_a = (const float*)d_in[3]; p.w_out_a = (const float*)d_in[4];
    p.hgrn_lb = (const float*)d_in[5]; p.hgrn_norm = (const float*)d_in[6]; p.sink = (const float*)d_in[7]; p.norm_c = (const float*)d_in[8]; p.w_in_c = (const float*)d_in[9];
    p.w_out_c = (const float*)d_in[10]; p.dlam = (const float*)d_in[11]; p.dnorm = (const float*)d_in[12]; p.fnorm = (const float*)d_in[13];
    p.out = (float*)d_out; p.ws = (unsigned char*)d_ws; p.ph_lo = 0; p.ph_hi = N_PHASES;
    void* args[] = {&p};
    hipError_t e = hipLaunchCooperativeKernel((const void*)mega, dim3(grid), dim3(512), args, LDS_BYTES, stream);
    if (e != hipSuccess) fprintf(stderr, "kernel_launch: cooperative launch failed: %s (grid %d)\n", hipGetErrorString(e), grid);
}
```

```cpp
#include <hip/hip_runtime.h>
#include <hip/hip_cooperative_groups.h>
#include <cstdio>
namespace cg = cooperative_groups;
__device__ __forceinline__ int ltid(int wave_s__) { int t = wave_s__ * 64 + (int)__lane_id(); asm volatile("" : "+v"(t)); return t; }
namespace pg8 {
#define PG8_LAS __attribute__((address_space(3)))
typedef unsigned short bf16_t;
typedef short bf16x8 __attribute__((ext_vector_type(8)));
typedef float f32x4 __attribute__((ext_vector_type(4)));
typedef unsigned u32x4 __attribute__((ext_vector_type(4)));
constexpr int BM = 256, BK = 64, HALF = 128, HTB = HALF * BK * 2  , STAGE_BYTES = 8 * HTB, NXCD = 8, WGM = 4;

__host__ __device__ __forceinline__ int lds_byte(int r, int c) { const int st = (r >> 4) * 2 + (c >> 5), rr = r & 15, cc = c & 31, ob = rr * 64 + cc * 2; return st * 1024 + (ob ^ (((ob >> 9) & 1) << 5)); }
__host__ __device__ __forceinline__ void stage_rc(int b, int& R, int& C) { const int st = b / 1024, sb = b % 1024, swz = sb ^ (((sb >> 9) & 1) << 5); R = (st >> 1) * 16 + swz / 64; C = (st & 1) * 32 + (swz % 64) / 2; }
__host__ __device__ __forceinline__ int perm32(int rho) { const int n = rho >> 4, i = rho & 15; return 8 * (i >> 2) + 4 * n + (i & 3); }

struct Unit { int pm, pn, kt0, nt; };
struct Gemm { const bf16_t* A; const bf16_t* Bt; int M, N, K; };

struct StaticOrder {
    int nM, nN, nwg, G, c, KT;
    __host__ __device__ void init(int M, int N, int G_, int c_, int K_ = 0) { nM = M / BM; nN = N / BM; nwg = nM * nN; G = G_; c = c_; KT = K_ / BK; }
    __host__ __device__ bool next(int i, Unit& u) const {
        const long L = (long)i * G + c; if (L >= nwg) return false;
        int wgid = (int)L; { const int q = nwg / NXCD, r = nwg % NXCD, xcd = wgid % NXCD, off = wgid / NXCD; wgid = (xcd < r ? xcd * (q + 1) : r * (q + 1) + (xcd - r) * q) + off; }
        const int nig = WGM * nN, gid = wgid / nig, fm = gid * WGM, gsz = (nM - fm) < WGM ? (nM - fm) : WGM;
        u.pm = fm + ((wgid % nig) % gsz); u.pn = (wgid % nig) / gsz; u.kt0 = 0; u.nt = KT; return true;
    }
    __device__ __forceinline__ void a_ready(const Unit&) const {}
    __device__ __forceinline__ void done(const Unit&) const {}
};
struct CountedOrder : StaticOrder {
    const unsigned* ready; unsigned need; unsigned* tmo;
    __device__ __forceinline__ void a_ready(const Unit& u) const {
        if ((int)threadIdx.x < 64) {
            const unsigned long long t0 = __builtin_amdgcn_s_memrealtime(); unsigned polls = 0;
            while ((unsigned)__builtin_amdgcn_readfirstlane(__hip_atomic_load(ready + 64 * u.pm, __ATOMIC_RELAXED, __HIP_MEMORY_SCOPE_AGENT)) < need) {
                if ((++polls & 255u) == 0u && __builtin_amdgcn_readfirstlane(__hip_atomic_load(tmo, __ATOMIC_RELAXED, __HIP_MEMORY_SCOPE_AGENT)) != 0u) break;
                if (__builtin_amdgcn_s_memrealtime() - t0 > 2000000ull) {
                    if ((int)threadIdx.x == 0) { unsigned expect = 0u; __hip_atomic_compare_exchange_strong(tmo + 1, &expect, 0x600u | (unsigned)(u.pm & 0xff), __ATOMIC_RELAXED, __ATOMIC_RELAXED, __HIP_MEMORY_SCOPE_AGENT); __hip_atomic_store(tmo, 1u, __ATOMIC_RELAXED, __HIP_MEMORY_SCOPE_AGENT); }
                    break; }
                __builtin_amdgcn_s_sleep(2); }
            __builtin_amdgcn_fence(__ATOMIC_ACQUIRE, "agent");
            asm volatile("s_waitcnt vmcnt(0)" ::: "memory");
        }
#if !defined(BROKEN_HOOK_NO_BARRIER)
        asm volatile("" ::: "memory"); __builtin_amdgcn_s_barrier(); asm volatile("" ::: "memory");
#endif
    }
};

__device__ __forceinline__ unsigned cvt_pk_bf16(float lo, float hi) { unsigned r; asm volatile("v_cvt_pk_bf16_f32 %0, %1, %2" : "=v"(r) : "v"(lo), "v"(hi)); return r; }
typedef float f32x2 __attribute__((ext_vector_type(2)));
__device__ __forceinline__ f32x2 gelu_pk(f32x2 v) {
    const f32x2 av = __builtin_elementwise_abs(v), d = av * 0.2316418882f + 1.0f;
    f32x2 t; t.x = __builtin_amdgcn_rcpf(d.x); t.y = __builtin_amdgcn_rcpf(d.y);
    f32x2 q = t * 0.5307027145f + (-0.7265760135f); q = q * t + 0.7107068705f; q = q * t + (-0.142248368f); q = q * t + 0.127414796f; q = q * t;
    const f32x2 s = (v * v) * (-0.72134752044f);
    f32x2 e; e.x = __builtin_amdgcn_exp2f(s.x); e.y = __builtin_amdgcn_exp2f(s.y);
    const f32x2 m = v * (q * e), r = v - m;
    f32x2 o; o.x = v.x < 0.f ? m.x : r.x; o.y = v.y < 0.f ? m.y : r.y; return o;
}

struct EpiF32 {
    static constexpr bool PERM = false, AFTER_DRAIN = false;
    float* C; int ldc; const float* bias;
    __device__ __forceinline__ void operator()(const f32x4 (&acc)[2][2][4][2], const Unit& u, int wr, int wc, int fr, int fq) const {
        const int row0 = u.pm * BM + wr * 64 + fr, col0 = u.pn * BM + wc * 32 + 4 * fq;
        f32x4 bv[2][2];
#pragma unroll
        for (int bj = 0; bj < 2; ++bj)
#pragma unroll
            for (int n = 0; n < 2; ++n) bv[bj][n] = bias ? *(const f32x4*)(bias + col0 + bj * HALF + n * 16) : (f32x4){0.f, 0.f, 0.f, 0.f};
#pragma unroll
        for (int ai = 0; ai < 2; ++ai)
#pragma unroll
            for (int m = 0; m < 4; ++m) { float* rowp = C + (size_t)(row0 + ai * HALF + m * 16) * ldc + col0;
#pragma unroll
                for (int bj = 0; bj < 2; ++bj)
#pragma unroll
                    for (int n = 0; n < 2; ++n) *(f32x4*)(rowp + bj * HALF + n * 16) = acc[ai][bj][m][n] + bv[bj][n]; }
    }
};
template <int ACT  > struct EpiBf16 {
    static constexpr bool PERM = true, AFTER_DRAIN = false;
    bf16_t* O; int ldc; const float* bias; int split_cols; size_t split_stride;
    __device__ __forceinline__ void operator()(const f32x4 (&acc)[2][2][4][2], const Unit& u, int wr, int wc, int fr, int fq) const {
        const int row0 = u.pm * BM + wr * 64 + fr; int colt = u.pn * BM; bf16_t* base = O;
        if (split_cols) { const int t = colt / split_cols; base += (size_t)t * split_stride; colt -= t * split_cols; }
        const int col0 = colt + wc * 32 + 8 * fq, bcol0 = u.pn * BM + wc * 32 + 8 * fq;
        f32x4 bv[2][2];
#pragma unroll
        for (int bj = 0; bj < 2; ++bj)
#pragma unroll
            for (int n = 0; n < 2; ++n) bv[bj][n] = bias ? *(const f32x4*)(bias + bcol0 + bj * HALF + 4 * n) : (f32x4){0.f, 0.f, 0.f, 0.f};
#pragma unroll
        for (int ai = 0; ai < 2; ++ai)
#pragma unroll
            for (int m = 0; m < 4; ++m) { bf16_t* rowp = base + (size_t)(row0 + ai * HALF + m * 16) * ldc + col0;
#pragma unroll
                for (int bj = 0; bj < 2; ++bj) { f32x4 v0 = acc[ai][bj][m][0] + bv[bj][0], v1 = acc[ai][bj][m][1] + bv[bj][1];
                    if (ACT == 1) { f32x2 a = gelu_pk((f32x2){v0[0], v0[1]}), b = gelu_pk((f32x2){v0[2], v0[3]}), c = gelu_pk((f32x2){v1[0], v1[1]}), d = gelu_pk((f32x2){v1[2], v1[3]});
                        v0 = (f32x4){a.x, a.y, b.x, b.y}; v1 = (f32x4){c.x, c.y, d.x, d.y}; }
                    if (ACT == 2) {
#pragma unroll
                        for (int j = 0; j < 4; ++j) { v0[j] = 0.5f * v0[j] * (1.0f + erff(v0[j] * 0.70710678f)); v1[j] = 0.5f * v1[j] * (1.0f + erff(v1[j] * 0.70710678f)); } }
                    u32x4 w; w.x = cvt_pk_bf16(v0[0], v0[1]); w.y = cvt_pk_bf16(v0[2], v0[3]); w.z = cvt_pk_bf16(v1[0], v1[1]); w.w = cvt_pk_bf16(v1[2], v1[3]);
                    *(u32x4*)(rowp + bj * HALF) = w; } }
    }
};

template <class Epi, class Sched, bool STAMP = false>
__device__ __forceinline__ void gemm_phase(PG8_LAS unsigned char* lds, const Gemm g, const Sched& S, const Epi& E, unsigned long long* stamps, const int wave_s__) {
    const int tid = ltid(wave_s__), wid = __builtin_amdgcn_readfirstlane(tid >> 6), lane = tid & 63, wr = wid >> 2, wc = wid & 3, fr = lane & 15, fq = lane >> 4;
    const int K = g.K; int nt;
    int ts_lo = 0, ts_hi = 0, nts = 0; const unsigned long long rt_entry = STAMP ? (unsigned long long)wall_clock64() : 0ull;
#define PG8_STAMP() do { if (STAMP && wid == 0 && nts < 64) { const unsigned long long _c = (unsigned long long)clock64(); \
        ts_lo = (lane == nts) ? (int)(unsigned)_c : ts_lo; ts_hi = (lane == nts) ? (int)(unsigned)(_c >> 32) : ts_hi; ++nts; } } while (0)
    PG8_STAMP();
    unsigned voffA[2], voffB[2];
#pragma unroll
    for (int i = 0; i < 2; ++i) { int R, C; stage_rc(tid * 16 + i * 8192, R, C); const int Rb = Epi::PERM ? ((R & ~31) + perm32(R & 31)) : R;
        voffA[i] = (unsigned)(R * K + C) * 2u; voffB[i] = (unsigned)(Rb * K + C) * 2u; }
    const size_t kstep = (size_t)(BK * 2);
    const size_t hstep = (size_t)HALF * K * 2;
    const size_t tstep = 2 * hstep;
    const unsigned ldsw = (unsigned)wid * 1024u;
    const int aoff = lds_byte(wr * 64 + fr, fq * 8), boff = lds_byte(wc * 32 + fr, fq * 8);
#define PG8_SA(b, h) (((b) * 2 + (h)) * HTB)
#define PG8_SB(b, h) ((4 + (b) * 2 + (h)) * HTB)
#define PG8_STAGE(bufoff, gbase, voff) do { _Pragma("unroll") for (int _i = 0; _i < 2; ++_i) \
        __builtin_amdgcn_global_load_lds((const unsigned*)((const char*)(gbase) + (voff)[_i]), (PG8_LAS unsigned*)(lds + (bufoff) + ldsw + _i * 8192), 16, 0, 0); } while (0)
#define PG8_LDA(dst, b, h) do { _Pragma("unroll") for (int m = 0; m < 4; ++m) _Pragma("unroll") for (int k = 0; k < 2; ++k) dst[m][k] = *(const PG8_LAS bf16x8*)(lds + PG8_SA(b, h) + aoff + m * 2048 + k * 1024); } while (0)
#define PG8_LDB(dst, b, h) do { _Pragma("unroll") for (int n = 0; n < 2; ++n) _Pragma("unroll") for (int k = 0; k < 2; ++k) dst[n][k] = *(const PG8_LAS bf16x8*)(lds + PG8_SB(b, h) + boff + n * 2048 + k * 1024); } while (0)
#define PG8_MMA(ai, bj, At, Bt) do { __builtin_amdgcn_s_setprio(1); _Pragma("unroll") for (int m = 0; m < 4; ++m) _Pragma("unroll") for (int n = 0; n < 2; ++n) _Pragma("unroll") for (int k = 0; k < 2; ++k) \
        acc[ai][bj][m][n] = __builtin_amdgcn_mfma_f32_16x16x32_bf16(Bt[n][k], At[m][k], acc[ai][bj][m][n], 0, 0, 0); __builtin_amdgcn_s_setprio(0); } while (0)
#define PG8_WAIT_V(n) asm volatile("s_waitcnt vmcnt(" #n ")" ::: "memory")
#define PG8_WAIT_L(n) asm volatile("s_waitcnt lgkmcnt(" #n ")" ::: "memory")
#define PG8_BAR __builtin_amdgcn_s_barrier()
#define PG8_SCHED __builtin_amdgcn_sched_barrier(0)
    Unit cur, nxt; int ui = 0;
    if (!S.next(0, cur)) return;
    f32x4 acc[2][2][4][2];
#pragma unroll
    for (int a = 0; a < 2; ++a)
#pragma unroll
        for (int b = 0; b < 2; ++b)
#pragma unroll
            for (int m = 0; m < 4; ++m)
#pragma unroll
                for (int n = 0; n < 2; ++n) acc[a][b][m][n] = (f32x4){0.f, 0.f, 0.f, 0.f};
    bf16x8 At[4][2], B0[2][2], B1[2][2];
    nt = cur.nt;
    const char* cA = (const char*)g.A + (size_t)cur.pm * tstep + (size_t)cur.kt0 * kstep; const char* cB = (const char*)g.Bt + (size_t)cur.pn * tstep + (size_t)cur.kt0 * kstep;
    S.a_ready(cur);
    PG8_STAGE(PG8_SB(0, 0), cB, voffB); PG8_STAGE(PG8_SA(0, 0), cA, voffA); PG8_STAGE(PG8_SB(0, 1), cB + hstep, voffB); PG8_STAGE(PG8_SA(0, 1), cA + hstep, voffA);
    if (wr == 1) PG8_BAR;
    PG8_WAIT_V(4); PG8_BAR;
    PG8_STAGE(PG8_SB(1, 0), cB + kstep, voffB); PG8_STAGE(PG8_SA(1, 0), cA + kstep, voffA); PG8_STAGE(PG8_SB(1, 1), cB + hstep + kstep, voffB);
    PG8_WAIT_V(6); PG8_BAR;
    PG8_STAMP();
    for (;;) {
        const bool has_next = S.next(ui + 1, nxt);
        const char* nA = has_next ? (const char*)g.A + (size_t)nxt.pm * tstep + (size_t)nxt.kt0 * kstep : cA; const char* nB = has_next ? (const char*)g.Bt + (size_t)nxt.pn * tstep + (size_t)nxt.kt0 * kstep : cB;
        for (int t = 0; t < nt; t += 2) {
            const bool last = (t == nt - 2);
            const char* a1 = cA + (size_t)(t + 1) * kstep;
            const char* a2 = last ? nA : cA + (size_t)(t + 2) * kstep; const char* b2 = last ? nB : cB + (size_t)(t + 2) * kstep;
            const char* a3 = a2 + kstep; const char* b3 = b2 + kstep;
            if (last && has_next) S.a_ready(nxt);
            PG8_LDB(B0, 0, 0); PG8_SCHED; PG8_LDA(At, 0, 0); PG8_STAGE(PG8_SA(1, 1), a1 + hstep, voffA);
            PG8_WAIT_L(8); PG8_BAR; PG8_WAIT_L(0); PG8_MMA(0, 0, At, B0); PG8_BAR; PG8_SCHED;
            PG8_LDB(B1, 0, 1); PG8_STAGE(PG8_SB(0, 0), b2, voffB);
            PG8_BAR; PG8_WAIT_L(0); PG8_MMA(0, 1, At, B1); PG8_BAR;
            PG8_LDA(At, 0, 1); PG8_STAGE(PG8_SA(0, 0), a2, voffA);
            PG8_BAR; PG8_WAIT_L(0); PG8_MMA(1, 0, At, B0); PG8_BAR; PG8_SCHED;
            PG8_STAGE(PG8_SB(0, 1), b2 + hstep, voffB);
            PG8_WAIT_V(6); PG8_BAR; PG8_MMA(1, 1, At, B1); PG8_BAR;
            PG8_LDB(B0, 1, 0); PG8_SCHED; PG8_LDA(At, 1, 0); PG8_STAGE(PG8_SA(0, 1), a2 + hstep, voffA);
            PG8_WAIT_L(8); PG8_BAR; PG8_WAIT_L(0); PG8_MMA(0, 0, At, B0); PG8_BAR; PG8_SCHED;
            PG8_LDB(B1, 1, 1); PG8_STAGE(PG8_SB(1, 0), b3, voffB);
            PG8_BAR; PG8_WAIT_L(0); PG8_MMA(0, 1, At, B1); PG8_BAR;
            PG8_LDA(At, 1, 1); PG8_STAGE(PG8_SA(1, 0), a3, voffA);
            PG8_BAR; PG8_WAIT_L(0); PG8_MMA(1, 0, At, B0); PG8_BAR; PG8_SCHED;
            PG8_STAGE(PG8_SB(1, 1), b3 + hstep, voffB);
            PG8_WAIT_V(6); PG8_BAR; PG8_MMA(1, 1, At, B1); PG8_BAR;
        }
        PG8_STAMP();
        if constexpr (!Epi::AFTER_DRAIN) { E(acc, cur, wr, wc, fr, fq); S.done(cur); }
        PG8_STAMP();
        if (!has_next) break;
#pragma unroll
        for (int a = 0; a < 2; ++a)
#pragma unroll
            for (int b = 0; b < 2; ++b)
#pragma unroll
                for (int m = 0; m < 4; ++m)
#pragma unroll
                    for (int n = 0; n < 2; ++n) acc[a][b][m][n] = (f32x4){0.f, 0.f, 0.f, 0.f};
        cur = nxt; cA = nA; cB = nB; ++ui; nt = cur.nt;
    }
    PG8_WAIT_V(0);
    if (wr == 0) PG8_BAR;
    PG8_BAR;
    if constexpr (Epi::AFTER_DRAIN) { E.fused(acc, cur, wr, wc, fr, fq, lds, wid, lane); S.done(cur); }
    PG8_STAMP();
    if (STAMP && wid == 0) { stamps[lane] = lane < nts ? (((unsigned long long)(unsigned)ts_hi << 32) | (unsigned)ts_lo) : 0ull;
        if (lane == 62) stamps[62] = rt_entry; if (lane == 63) stamps[63] = (unsigned long long)wall_clock64(); }
#undef PG8_STAMP
#undef PG8_SA
#undef PG8_SB
#undef PG8_STAGE
#undef PG8_LDA
#undef PG8_LDB
#undef PG8_MMA
#undef PG8_WAIT_V
#undef PG8_WAIT_L
#undef PG8_BAR
#undef PG8_SCHED
}
}

using pg8::bf16_t; using pg8::bf16x8; using pg8::f32x4; using pg8::u32x4;
typedef short s16x4 __attribute__((ext_vector_type(4)));
typedef float f32x16 __attribute__((ext_vector_type(16)));
typedef unsigned u32x2 __attribute__((ext_vector_type(2)));
#define LAS __attribute__((address_space(3)))
#define DI __device__ __forceinline__
#define MFMA32(a, b, c) __builtin_amdgcn_mfma_f32_32x32x16_bf16((a), (b), (c), 0, 0, 0)

constexpr int NB = 8, LL = 2064, NMETA = 16, DM = 2048, MTOK = NB * LL, MPAD = 16640;
constexpr int EVEN_IN = 15360, ODD_IN = 16384, MIXW = 4096;
constexpr int ODD_LD = ODD_IN + 128;
constexpr int LDS_BYTES = 131072 + 1024;
#ifndef PHM
#define PHM 255
#endif
constexpr float LOG2E = 1.4426950408889634f, LN2 = 0.6931471805599453f;

constexpr size_t OFF_H = 0;
constexpr size_t OFF_HN = OFF_H + (size_t)MPAD * DM * 4;
constexpr size_t OFF_Z = OFF_HN + (size_t)MPAD * DM * 2;
constexpr size_t OFF_MIX = OFF_Z + (size_t)MPAD * ODD_LD * 2;
constexpr size_t OFF_WIN = OFF_MIX + (size_t)MPAD * MIXW * 2;
constexpr size_t OFF_WOUT = OFF_WIN + (size_t)ODD_IN * DM * 2;
constexpr size_t OFF_WIN2 = OFF_WOUT + (size_t)DM * MIXW * 2;
constexpr size_t OFF_MISC = OFF_WIN2 + (size_t)ODD_IN * DM * 2;
constexpr size_t OFF_QCTR = OFF_MISC + 384;
constexpr size_t OFF_HFLAG = OFF_MISC + 4608;
constexpr size_t OFF_NRM = OFF_MISC + 512;
constexpr size_t OFF_PART = OFF_MISC + 8192;
constexpr size_t WS_END = OFF_PART + (size_t)16 * 128 * DM * 4;

struct Params {
    const float *x, *meta, *norm_a, *w_in_a, *w_out_a, *hgrn_lb, *hgrn_norm, *sink, *norm_c, *w_in_c, *w_out_c, *dlam, *dnorm, *fnorm;
    float* out; unsigned char* ws; int ph_lo, ph_hi, dup_e, dup_o;
};

DI unsigned cvt_pk(float lo, float hi) { unsigned r; asm("v_cvt_pk_bf16_f32 %0, %1, %2" : "=v"(r) : "v"(lo), "v"(hi)); return r; }
DI float bf2f(bf16_t x) { return __uint_as_float(((unsigned)x) << 16); }
DI float bflo(unsigned u) { return __uint_as_float(u << 16); }
DI float bfhi(unsigned u) { return __uint_as_float(u & 0xffff0000u); }
DI float ex2(float x) { return __builtin_amdgcn_exp2f(x); }
DI float lg2(float x) { return __builtin_amdgcn_logf(x); }
DI float rcpf(float x) { return __builtin_amdgcn_rcpf(x); }
DI float siluf(float x) { return x * rcpf(1.f + ex2(-x * LOG2E)); }
DI float wave_sum(float v) {
#pragma unroll
    for (int o = 32; o; o >>= 1) v += __shfl_xor(v, o);
    return v; }
DI float xhalf_max(float v) { const auto r = __builtin_amdgcn_permlane32_swap(__float_as_uint(v), __float_as_uint(v), false, false); return fmaxf(__uint_as_float(r[0]), __uint_as_float(r[1])); }
DI float xhalf_sum(float v) { const auto r = __builtin_amdgcn_permlane32_swap(__float_as_uint(v), __float_as_uint(v), false, false); return __uint_as_float(r[0]) + __uint_as_float(r[1]); }
DI int crow(int reg, int h) { return (reg & 3) + 8 * (reg >> 2) + 4 * h; }
DI f32x16 zero16() { f32x16 z;
#pragma unroll
    for (int i = 0; i < 16; ++i) z[i] = 0.f;
    return z; }

template <int MODE>
DI void row_phase(const Params& p, const float* __restrict__ g, const int wave_s__) {
    const int wid = ltid(wave_s__) >> 6, lane = ltid(wave_s__) & 63;
    float* H = (float*)(p.ws + OFF_H); bf16_t* HN = (bf16_t*)(p.ws + OFF_HN);
    for (int r = blockIdx.x * 8 + wid; r < MPAD; r += gridDim.x * 8) {
        if (r >= MTOK) {
            if (MODE == 0) {
#pragma unroll
                for (int j = 0; j < 8; ++j) { *(f32x4*)(H + (size_t)r * DM + (j * 64 + lane) * 4) = (f32x4){0.f, 0.f, 0.f, 0.f}; }
            }
            if (MODE != 2) {
#pragma unroll
                for (int j = 0; j < 8; ++j) { u32x2 zz; zz.x = 0u; zz.y = 0u; *(u32x2*)(HN + (size_t)r * DM + (j * 64 + lane) * 4) = zz; }
            }
            continue;
        }
        const int b = r / LL, t = r - b * LL;
        const float* src;
        if (MODE == 0) src = (t < NMETA) ? (p.meta + (size_t)t * DM) : (p.x + ((size_t)b * 2048 + (t - NMETA)) * DM);
        else src = H + (size_t)r * DM;
        f32x4 v[8]; float ss = 0.f;
#pragma unroll
        for (int j = 0; j < 8; ++j) v[j] = *(const f32x4*)(src + (j * 64 + lane) * 4);
        if (MODE != 0 && r >= 16384) {
            const float* pp = (const float*)(p.ws + OFF_PART) + (size_t)(r - 16384) * DM;
            for (int sp = 0; sp < 16; ++sp) {
#pragma unroll
                for (int j = 0; j < 8; ++j) v[j] = v[j] + *(const f32x4*)(pp + (size_t)sp * 128 * DM + (j * 64 + lane) * 4); }
            if (MODE == 1) {
#pragma unroll
                for (int j = 0; j < 8; ++j) *(f32x4*)(H + (size_t)r * DM + (j * 64 + lane) * 4) = v[j]; }
        }
#pragma unroll
        for (int j = 0; j < 8; ++j) ss += v[j][0] * v[j][0] + v[j][1] * v[j][1] + v[j][2] * v[j][2] + v[j][3] * v[j][3];
        ss = wave_sum(ss);
        const float rstd = rsqrtf(ss * (1.f / DM) + 1e-6f);
        if (MODE == 0 && r >= 16384) {
#pragma unroll
            for (int j = 0; j < 8; ++j) *(f32x4*)(H + (size_t)r * DM + (j * 64 + lane) * 4) = v[j];
        }
        if (MODE == 2) {
            if (t >= NMETA) { float* op = p.out + ((size_t)b * 2048 + (t - NMETA)) * DM;
#pragma unroll
                for (int j = 0; j < 8; ++j) { const f32x4 gg = *(const f32x4*)(g + (j * 64 + lane) * 4); f32x4 o; o[0] = v[j][0] * rstd * gg[0]; o[1] = v[j][1] * rstd * gg[1]; o[2] = v[j][2] * rstd * gg[2]; o[3] = v[j][3] * rstd * gg[3];
                    *(f32x4*)(op + (j * 64 + lane) * 4) = o; } }
        } else {
#pragma unroll
            for (int j = 0; j < 8; ++j) { const f32x4 gg = *(const f32x4*)(g + (j * 64 + lane) * 4); u32x2 w; w.x = cvt_pk(v[j][0] * rstd * gg[0], v[j][1] * rstd * gg[1]); w.y = cvt_pk(v[j][2] * rstd * gg[2], v[j][3] * rstd * gg[3]);
                *(u32x2*)(HN + (size_t)r * DM + (j * 64 + lane) * 4) = w; }
        }
    }
}

DI void convert_T(LAS unsigned char* lds, const float* __restrict__ W, bf16_t* __restrict__ Wt, const int K, const int N, const int wave_s__, const int first = 0) {
    LAS float* tile = (LAS float*)lds;
    const int tid = ltid(wave_s__), nk = K >> 6, ntile = nk * (N >> 8);
    const int tx = tid & 63, ty = tid >> 6, wn = tid >> 3, wk = (tid & 7) * 8;
    if ((int)blockIdx.x < first) return;
    for (int t = (int)blockIdx.x - first; t < ntile; t += (int)gridDim.x - first) {
        const int k0 = (t % nk) << 6, n0 = (t / nk) << 8;
        float r[4][8];
#pragma unroll
        for (int c = 0; c < 4; ++c)
#pragma unroll
            for (int i = 0; i < 8; ++i) r[c][i] = __builtin_nontemporal_load(W + (size_t)(k0 + ty * 8 + i) * N + n0 + c * 64 + tx);
#pragma unroll
        for (int c = 0; c < 4; ++c) {
#pragma unroll
            for (int i = 0; i < 8; ++i) tile[(ty * 8 + i) * 65 + tx] = r[c][i];
            __syncthreads();
            float e[8];
#pragma unroll
            for (int i = 0; i < 8; ++i) e[i] = tile[(wk + i) * 65 + wn];
            u32x4 w; w.x = cvt_pk(e[0], e[1]); w.y = cvt_pk(e[2], e[3]); w.z = cvt_pk(e[4], e[5]); w.w = cvt_pk(e[6], e[7]);
            *(u32x4*)(Wt + (size_t)(n0 + c * 64 + wn) * K + k0 + wk) = w;
            __syncthreads();
        }
    }
}

struct EpiResAdd {
    static constexpr bool PERM = false, AFTER_DRAIN = false;
    float* H; int ldc; float* P; const float* x0; const float* meta0;
    DI void operator()(const f32x4 (&acc)[2][2][4][2], const pg8::Unit& u, int wr, int wc, int fr, int fq) const {
        const int row0 = u.pm * pg8::BM + wr * 64 + fr, col0 = u.pn * pg8::BM + wc * 32 + 4 * fq;
        if (u.nt != MIXW / 64) {
            float* pb = P + ((size_t)(u.kt0 >> 2) * 128 + (row0 - 16384)) * DM + col0;
#pragma unroll
            for (int m = 0; m < 4; ++m)
#pragma unroll
                for (int bj = 0; bj < 2; ++bj)
#pragma unroll
                    for (int n = 0; n < 2; ++n) *(f32x4*)(pb + (size_t)(m * 16) * DM + bj * pg8::HALF + n * 16) = acc[0][bj][m][n];
            return;
        }
#pragma unroll
        for (int ai = 0; ai < 2; ++ai)
#pragma unroll
            for (int m = 0; m < 4; ++m) { const int row = row0 + ai * pg8::HALF + m * 16; float* rowp = H + (size_t)row * ldc + col0;
                const float* srcp = rowp;
                if (x0) { const int b = row / LL, t = row - b * LL; srcp = (t < NMETA ? meta0 + (size_t)t * DM : x0 + ((size_t)b * 2048 + (t - NMETA)) * DM) + col0; }
#pragma unroll
                for (int bj = 0; bj < 2; ++bj)
#pragma unroll
                    for (int n = 0; n < 2; ++n) { *(f32x4*)(rowp + bj * pg8::HALF + n * 16) = *(const f32x4*)(srcp + bj * pg8::HALF + n * 16) + acc[ai][bj][m][n]; } }
    }
};

template <int NDV, int NK, bool WINM>
DI void attn_unit(LAS unsigned char* lds, const bf16_t* __restrict__ zb, const int ldz, const int qcol, const int kcol0, const int kcol1, const int vcol,
                  const int gcol, const int ocol, const float c2, const float sink2, const int t0, const int lo, const int nt,
                  bf16_t* __restrict__ mixb, const float lam, const float* __restrict__ normg, const float oscale, const int wave_s__) {
    constexpr int DV = NDV * 32, ROWB = DV * 2, KBY = 8192, VBY = 32 * ROWB, BUFB = NK * KBY + VBY, NI = (NK * KBY + VBY) / 1024, NPW = NI / 8;
    static_assert(3 * BUFB <= LDS_BYTES && NI % 8 == 0, "attention tile buffers");
    const int tid = ltid(wave_s__), wid = tid >> 6, lane = tid & 63, r32 = lane & 31, half = lane >> 5, j = wid >> 2, wq = wid & 3;
    const int tq = t0 + wq * 32 + r32;
    const float c1 = 0.08838834764831845f * LOG2E;
    bf16x8 qf[8];
    { const bf16_t* qp = zb + (size_t)tq * ldz + qcol + half * 8;
#pragma unroll
      for (int ks = 0; ks < 8; ++ks) qf[ks] = *(const bf16x8*)(qp + ks * 16); }
    f32x16 o[NDV];
#pragma unroll
    for (int n = 0; n < NDV; ++n) o[n] = zero16();
    float m = -1e30f, l = 0.f;
    unsigned soff[NPW]; int ddst[NPW];
#pragma unroll
    for (int e = 0; e < NPW; ++e) { const int qi = wid * NPW + e;
        if (qi < NK * 8) { const int mp = qi >> 3, r4 = qi & 7; const int row = 4 * r4 + (lane >> 4), slot = (lane & 15) ^ (row & 15);
            soff[e] = (unsigned)(row * ldz + (mp ? kcol1 : kcol0) + slot * 8) * 2u; ddst[e] = mp * KBY + r4 * 1024; }
        else { const int qv = qi - NK * 8; constexpr int SPR = DV / 8, RPI = 1024 / ROWB; const int row = qv * RPI + lane / SPR, ps = lane % SPR; const int ls = (((ps >> 2) ^ (row & 3)) << 2) | (ps & 3);
            soff[e] = (unsigned)(row * ldz + vcol + ls * 8) * 2u; ddst[e] = NK * KBY + qv * 1024; } }
#define ATT_DMA(tile_, buf_) do { const char* tb_ = (const char*)(zb + (size_t)(32 * (tile_)) * ldz); \
        _Pragma("unroll") for (int e = 0; e < NPW; ++e) __builtin_amdgcn_global_load_lds((const unsigned*)(tb_ + soff[e]), (LAS unsigned*)(lds + (buf_) * BUFB + ddst[e]), 16, 0, 0); } while (0)
#define ATT_BAR() do { asm volatile("" ::: "memory"); __builtin_amdgcn_s_barrier(); asm volatile("" ::: "memory"); } while (0)
    const int td = t0 >> 5, ndiag = (65 - td) < 4 ? (65 - td) : 4, nleft = td - lo;
#define ATT_TILE(it_) (WINM ? ((it_) == 0 ? 0 : lo + (it_) - 1) : ((it_) < ndiag ? td + (it_) : ((it_) < ndiag + nleft ? td - 1 - ((it_) - ndiag) : td + (it_) - nleft)))
    const int kbase = (NK == 2 ? j * KBY : 0) + r32 * 256 + ((((r32 & 15) ^ half) & 1) << 4) + ((r32 & 14) << 4);
    const int q4 = (lane >> 2) & 3, p4 = lane & 3, blk = (lane >> 4) & 1;
    int vb[4];
#pragma unroll
    for (int c = 0; c < 4; ++c) vb[c] = NK * KBY + (4 * half + q4) * ROWB + ((c ^ q4) << 6) + blk * 32 + 8 * p4;
    ATT_DMA(ATT_TILE(0), 0);
    asm volatile("s_waitcnt vmcnt(0)" ::: "memory");
    ATT_BAR();
    f32x16 st = zero16();
    u32x4 pk0, pk1; pk0.x = pk0.y = pk0.z = pk0.w = 0u; pk1 = pk0;
    bool pv_act = false;
    for (int ph = 0; ph < 2 * nt + 2; ++ph) {
        if (((ph + j) & 1) == 0) {
            const int idx = (ph - j) >> 1;
            if (idx >= 1 && pv_act) {
                const int bo = ((idx - 1) % 3) * BUFB;
                const bf16x8 pb0 = __builtin_bit_cast(bf16x8, pk0), pb1 = __builtin_bit_cast(bf16x8, pk1);
                bf16x8 av[3];
#define ATT_VLD1(k_, dst_) do { const int s2_ = (k_) / NDV, n_ = (k_) % NDV; LAS unsigned char* vp_ = lds + bo + vb[n_ & 3] + (n_ >> 2) * 256 + (16 * s2_) * ROWB; \
                        const s16x4 lo4_ = __builtin_amdgcn_ds_read_tr16_b64_v4i16((LAS s16x4*)vp_); const s16x4 hi4_ = __builtin_amdgcn_ds_read_tr16_b64_v4i16((LAS s16x4*)(vp_ + 8 * ROWB)); \
                        dst_ = __builtin_shufflevector(lo4_, hi4_, 0, 1, 2, 3, 4, 5, 6, 7); } while (0)
                ATT_VLD1(0, av[0]); ATT_VLD1(1, av[1]);
#pragma unroll
                for (int k = 0; k < 2 * NDV; ++k) {
                    if (k + 2 < 2 * NDV) ATT_VLD1(k + 2, av[(k + 2) % 3]);
                    __builtin_amdgcn_sched_barrier(0);
                    o[k % NDV] = MFMA32(av[k % 3], (k / NDV) ? pb1 : pb0, o[k % NDV]);
                    __builtin_amdgcn_sched_barrier(0);
                }
#undef ATT_VLD1
            }
            if (idx < nt) {
                const int ka = (idx % 3) * BUFB + kbase;
                st = zero16();
                bf16x8 ak[3];
                ak[0] = *(LAS bf16x8*)(lds + ka); ak[1] = *(LAS bf16x8*)(lds + (ka ^ 32));
#pragma unroll
                for (int ks = 0; ks < 8; ++ks) { if (ks + 2 < 8) ak[(ks + 2) % 3] = *(LAS bf16x8*)(lds + (ka ^ ((ks + 2) << 5)));
                    __builtin_amdgcn_sched_barrier(0);
                    st = MFMA32(ak[ks % 3], qf[ks], st);
                    __builtin_amdgcn_sched_barrier(0); }
            }
        } else {
            const int idx = (ph - j - 1) >> 1;
            { const int ti = idx + 1 + j; if (ti < nt) ATT_DMA(ATT_TILE(ti), ti % 3); }
            if (idx >= 0 && idx < nt) {
                const int key0 = 32 * ATT_TILE(idx);
                const float basef = (float)(tq - key0 - 4 * half);
                const bool tail = (key0 + 32 > LL);
                float x[16]; float mx = -INFINITY;
                if (WINM || tail) {
#pragma unroll
                    for (int i = 0; i < 16; ++i) { const int off = 8 * (i >> 2) + (i & 3); float d = fabsf(basef - (float)off); bool valid;
                        const int s = key0 + 4 * half + off;
                        if (WINM) { const bool meta = s < NMETA; valid = meta || (d <= 128.f && s < LL); d = meta ? fminf(d, 128.f) : d; }
                        else valid = (s < LL);
                        float xv = fmaf(st[i], c1, -c2 * d); xv = valid ? xv : -INFINITY; x[i] = xv; mx = fmaxf(mx, xv); }
                } else if (key0 + 31 < t0 + wq * 32 || key0 > t0 + wq * 32 + 31) {
                    const bool left = key0 + 31 < t0 + wq * 32; const float cs = left ? c2 : -c2, cbs = (left ? -c2 : c2) * basef;
#pragma unroll
                    for (int i = 0; i < 16; ++i) { const int off = 8 * (i >> 2) + (i & 3);
                        const float xv = fmaf(st[i], c1, fmaf((float)off, cs, cbs)); x[i] = xv; mx = fmaxf(mx, xv); }
                } else {
#pragma unroll
                    for (int i = 0; i < 16; ++i) { const int off = 8 * (i >> 2) + (i & 3); const float d = fabsf(basef - (float)off);
                        const float xv = fmaf(st[i], c1, -c2 * d); x[i] = xv; mx = fmaxf(mx, xv); }
                }
                mx = xhalf_max(mx);
                pv_act = __any(mx > m - 40.f) != 0;
                if (pv_act) {
                    const bool need = mx > m + 8.f;
                    if (__any(need)) {
                        const float mn = need ? mx : m; const float al = ex2(m - mn);
                        l *= al;
#pragma unroll
                        for (int n = 0; n < NDV; ++n)
#pragma unroll
                            for (int i = 0; i < 16; ++i) o[n][i] *= al;
                        m = mn;
                    }
                    float ps = 0.f;
#pragma unroll
                    for (int i = 0; i < 16; ++i) { x[i] = ex2(x[i] - m); ps += x[i]; }
                    l += ps;
                    pk0.x = cvt_pk(x[0], x[1]); pk0.y = cvt_pk(x[2], x[3]); pk0.z = cvt_pk(x[4], x[5]); pk0.w = cvt_pk(x[6], x[7]);
                    pk1.x = cvt_pk(x[8], x[9]); pk1.y = cvt_pk(x[10], x[11]); pk1.z = cvt_pk(x[12], x[13]); pk1.w = cvt_pk(x[14], x[15]);
                }
            }
        }
        if (ph & 1) { asm volatile("s_waitcnt vmcnt(0)" ::: "memory"); ATT_BAR(); }
    }
    __syncthreads();
#undef ATT_DMA
#undef ATT_BAR
#undef ATT_TILE
    float lt = xhalf_sum(l);
    if (WINM) lt += ex2(sink2 - m);
    const float inv = 1.f / lt;
    const bool tval = tq < LL;
    if (WINM) {
        if (tval) { const bf16_t* gp = zb + (size_t)tq * ldz + gcol + 4 * half; bf16_t* op = mixb + (size_t)tq * MIXW + ocol + 4 * half;
#pragma unroll
            for (int n = 0; n < NDV; ++n)
#pragma unroll
                for (int g4 = 0; g4 < 4; ++g4) { const int dv = n * 32 + 8 * g4; const u32x2 gg = *(const u32x2*)(gp + dv);
                    u32x2 w; w.x = cvt_pk(o[n][4 * g4] * inv * siluf(bflo(gg.x)), o[n][4 * g4 + 1] * inv * siluf(bfhi(gg.x)));
                    w.y = cvt_pk(o[n][4 * g4 + 2] * inv * siluf(bflo(gg.y)), o[n][4 * g4 + 3] * inv * siluf(bfhi(gg.y)));
                    *(u32x2*)(op + dv) = w; } }
    } else {
        LAS float* xb = (LAS float*)lds + wq * (DV * 32) + 128 * half + r32;
        if (j == 1) { const float sc = inv * lam;
#pragma unroll
            for (int n = 0; n < NDV; ++n)
#pragma unroll
                for (int i = 0; i < 16; ++i) xb[(n * 32 + 8 * (i >> 2) + (i & 3)) * 32] = o[n][i] * sc; }
        __syncthreads();
        if (j == 0) { float ss = 0.f;
#pragma unroll
            for (int n = 0; n < NDV; ++n)
#pragma unroll
                for (int i = 0; i < 16; ++i) { const float v = o[n][i] * inv - xb[(n * 32 + 8 * (i >> 2) + (i & 3)) * 32]; o[n][i] = v; ss += v * v; }
            ss = xhalf_sum(ss);
            const float rstd = rsqrtf(ss * (1.f / DV) + 1e-6f) * oscale;
            const float* ngp = normg; asm volatile("" : "+s"(ngp)); ngp += 4 * half;
            if (tval) { const bf16_t* gp = zb + (size_t)tq * ldz + gcol + 4 * half; bf16_t* op = mixb + (size_t)tq * MIXW + ocol + 4 * half;
#pragma unroll
                for (int n = 0; n < NDV; ++n)
#pragma unroll
                    for (int g4 = 0; g4 < 4; ++g4) { const int dv = n * 32 + 8 * g4; const u32x2 gg = *(const u32x2*)(gp + dv); const f32x4 ng = *(const f32x4*)(ngp + dv);
                        u32x2 w; w.x = cvt_pk(o[n][4 * g4] * rstd * ng[0] * siluf(bflo(gg.x)), o[n][4 * g4 + 1] * rstd * ng[1] * siluf(bfhi(gg.x)));
                        w.y = cvt_pk(o[n][4 * g4 + 2] * rstd * ng[2] * siluf(bflo(gg.y)), o[n][4 * g4 + 3] * rstd * ng[3] * siluf(bfhi(gg.y)));
                        *(u32x2*)(op + dv) = w; } }
        }
        __syncthreads();
    }
}

DI void hgrn_seq(LAS unsigned char* lds, const bf16_t* __restrict__ zb, const int ldz, const int h, const int dir, const float lbv, bf16_t* __restrict__ dst, const int ldd, const int wave_s__) {
    constexpr int QC = 0, KH = 17408, KT = 34816, VT = 53248, SL = 71680, SC = 106496, TOT = 115712, E1 = 117760, GM = 118272;
    const int tid = ltid(wave_s__), wid = tid >> 6, lane = tid & 63, r32 = lane & 31, half = lane >> 5;
    const int k = tid & 127, tg = tid >> 7;
    const int fcol = dir ? 4096 : 2048;
    const int n = wid & 3, kt0 = 2 * (wid >> 2), ti = wid >> 2;
    LAS float* tot = (LAS float*)(lds + TOT); LAS float* e1p = (LAS float*)(lds + E1); LAS float* gmp = (LAS float*)(lds + GM);
    LAS float* e1l = e1p + kt0 * 32 + 4 * half; LAS float* gml = gmp + kt0 * 32 + 4 * half;
    f32x16 S[2]; S[0] = zero16(); S[1] = zero16();
    const float oml = 1.f - lbv;
    bf16_t rq[16], rf[16], rv[16];
#define HG_LOAD(c_) do { _Pragma("unroll") for (int e = 0; e < 16; ++e) { const int P_ = 64 * (c_) + tg * 16 + e; const int pp_ = dir ? 2111 - P_ : P_; const int t_ = pp_ - 48; const int tt_ = t_ < 0 ? 0 : t_; \
            const bf16_t* row_ = zb + (size_t)tt_ * ldz + h * 128 + k; rq[e] = row_[0]; rf[e] = row_[fcol]; rv[e] = row_[6144]; } } while (0)
    HG_LOAD(0);
    for (int c = 0; c < 33; ++c) {
        float qv[16], kk[16], bl[16]; unsigned vp[8]; float run = 0.f;
        {
            float vv[16];
#pragma unroll
            for (int e = 0; e < 16; ++e) {
                const int P = 64 * c + tg * 16 + e; const int pp = dir ? 2111 - P : P; const int t = pp - 48; const bool ok = t >= 0;
                const float q = bf2f(rq[e]), zf = bf2f(rf[e]), v = bf2f(rv[e]);
                const float ex = ex2(-zf * LOG2E), rden = rcpf(1.f + ex);
                const float lf = lg2((1.f + lbv * ex) * rden);
                run += ok ? lf : 0.f; bl[e] = run; qv[e] = ok ? q : 0.f; kk[e] = ok ? oml * ex * rden : 0.f; vv[e] = ok ? v : 0.f;
            }
#pragma unroll
            for (int e = 0; e < 8; ++e) vp[e] = cvt_pk(vv[2 * e], vv[2 * e + 1]);
        }
        tot[tg * 128 + k] = run;
        __syncthreads();
        {
            const float t0_ = tot[k], t1_ = tot[128 + k], t2_ = tot[256 + k], t3_ = tot[384 + k];
            const float off = (tg > 0 ? t0_ : 0.f) + (tg > 1 ? t1_ : 0.f) + (tg > 2 ? t2_ : 0.f);
            const float bmid = t0_ + t1_;
            if (tg == 0) { e1p[k] = ex2(bmid); gmp[k] = ex2(t2_ + t3_); }
            unsigned khp[8]; float khv[16];
#pragma unroll
            for (int e = 0; e < 16; ++e) { const float dq = off + bl[e] - bmid; const float qc = qv[e] * ex2(dq); khv[e] = kk[e] * ex2(-dq);
                const int i = tg * 16 + e;
                *(LAS bf16_t*)(lds + QC + i * 272 + k * 2) = (bf16_t)(cvt_pk(qc, qc) & 0xffffu);
                *(LAS bf16_t*)(lds + KH + i * 272 + k * 2) = (bf16_t)(cvt_pk(khv[e], khv[e]) & 0xffffu); }
#pragma unroll
            for (int e = 0; e < 8; ++e) khp[e] = cvt_pk(khv[2 * e], khv[2 * e + 1]);
            u32x4 w0, w1; w0.x = khp[0]; w0.y = khp[1]; w0.z = khp[2]; w0.w = khp[3]; w1.x = khp[4]; w1.y = khp[5]; w1.z = khp[6]; w1.w = khp[7];
            *(LAS u32x4*)(lds + KT + k * 144 + tg * 32) = w0; *(LAS u32x4*)(lds + KT + k * 144 + tg * 32 + 16) = w1;
            w0.x = vp[0]; w0.y = vp[1]; w0.z = vp[2]; w0.w = vp[3]; w1.x = vp[4]; w1.y = vp[5]; w1.z = vp[6]; w1.w = vp[7];
            *(LAS u32x4*)(lds + VT + k * 144 + tg * 32) = w0; *(LAS u32x4*)(lds + VT + k * 144 + tg * 32 + 16) = w1;
        }
        if (c + 1 < 33) HG_LOAD(c + 1);
        __syncthreads();
#pragma unroll
        for (int a = 0; a < 2; ++a) { const int kt = kt0 + a;
#pragma unroll
            for (int i = 0; i < 16; ++i) S[a][i] *= e1l[a * 32 + 8 * (i >> 2) + (i & 3)];
#pragma unroll
            for (int g4 = 0; g4 < 4; ++g4) { u32x2 w; w.x = cvt_pk(S[a][4 * g4], S[a][4 * g4 + 1]); w.y = cvt_pk(S[a][4 * g4 + 2], S[a][4 * g4 + 3]);
                *(LAS u32x2*)(lds + SL + (n * 32 + r32) * 272 + (kt * 32 + 8 * g4 + 4 * half) * 2) = w; } }
        if (wid < 4) { const int si = wid >> 1, tj = wid & 1;
            f32x16 acc = zero16();
            if (si <= tj) {
#pragma unroll
                for (int ks = 0; ks < 8; ++ks) { const bf16x8 a = *(LAS bf16x8*)(lds + KH + (si * 32 + r32) * 272 + ks * 32 + half * 16); const bf16x8 b = *(LAS bf16x8*)(lds + QC + (tj * 32 + r32) * 272 + ks * 32 + half * 16);
                    acc = MFMA32(a, b, acc); }
            }
            const int tt = tj * 32 + r32;
#pragma unroll
            for (int g4 = 0; g4 < 4; ++g4) { float v4[4];
#pragma unroll
                for (int q = 0; q < 4; ++q) { const int s = si * 32 + 8 * g4 + 4 * half + q; v4[q] = (s <= tt) ? acc[4 * g4 + q] : 0.f; }
                u32x2 w; w.x = cvt_pk(v4[0], v4[1]); w.y = cvt_pk(v4[2], v4[3]);
                *(LAS u32x2*)(lds + SC + tt * 144 + (si * 32 + 8 * g4 + 4 * half) * 2) = w; } }
        __syncthreads();
        { f32x16 acc = zero16();
#pragma unroll
          for (int ks = 0; ks < 8; ++ks) { const bf16x8 a = *(LAS bf16x8*)(lds + SL + (n * 32 + r32) * 272 + ks * 32 + half * 16); const bf16x8 b = *(LAS bf16x8*)(lds + QC + (ti * 32 + r32) * 272 + ks * 32 + half * 16);
              acc = MFMA32(a, b, acc); }
#pragma unroll
          for (int ss = 0; ss < 4; ++ss) { if (ss < 2 || ti == 1) { const bf16x8 a = *(LAS bf16x8*)(lds + VT + (n * 32 + r32) * 144 + ss * 32 + half * 16); const bf16x8 b = *(LAS bf16x8*)(lds + SC + (ti * 32 + r32) * 144 + ss * 32 + half * 16);
              acc = MFMA32(a, b, acc); } }
          const int P = 64 * c + ti * 32 + r32; const int pp = dir ? 2111 - P : P; const int t = pp - 48;
          if (t >= 0) { bf16_t* op = dst + (size_t)t * ldd + n * 32 + 4 * half;
#pragma unroll
              for (int g4 = 0; g4 < 4; ++g4) { u32x2 w; w.x = cvt_pk(acc[4 * g4], acc[4 * g4 + 1]); w.y = cvt_pk(acc[4 * g4 + 2], acc[4 * g4 + 3]); *(u32x2*)(op + 8 * g4) = w; } }
        }
#pragma unroll
        for (int a = 0; a < 2; ++a) { const int kt = kt0 + a;
#pragma unroll
            for (int ss = 0; ss < 4; ++ss) { const bf16x8 av = *(LAS bf16x8*)(lds + KT + (kt * 32 + r32) * 144 + ss * 32 + half * 16); const bf16x8 bv = *(LAS bf16x8*)(lds + VT + (n * 32 + r32) * 144 + ss * 32 + half * 16);
                S[a] = MFMA32(av, bv, S[a]); }
#pragma unroll
            for (int i = 0; i < 16; ++i) S[a][i] *= gml[a * 32 + 8 * (i >> 2) + (i & 3)]; }
    }
#undef HG_LOAD
    __syncthreads();
}

DI int xcd_unit(int i) { const int G = gridDim.x, c = blockIdx.x; return (G & 7) ? (i * G + c) : ((i * 8 + (c & 7)) * (G >> 3) + (c >> 3)); }


DI void fin_head(const Params& p, const int li, const int b, const int h, const int wave_s__) {
    const bf16_t* Z = (const bf16_t*)(p.ws + OFF_Z); bf16_t* MIX = (bf16_t*)(p.ws + OFF_MIX); const bf16_t* OF = (const bf16_t*)(p.ws + OFF_HN);
    const int lane = (int)__lane_id(), rr = lane >> 4, c8 = (lane & 15) * 8;
    const f32x4 g0 = *(const f32x4*)(p.hgrn_norm + li * 128 + c8), g1 = *(const f32x4*)(p.hgrn_norm + li * 128 + c8 + 4);
    for (int t0 = wave_s__ * 16; t0 < LL; t0 += 128) {
        u32x4 a[4], c[4], gt[4];
#pragma unroll
        for (int q = 0; q < 4; ++q) { const int t = t0 + q * 4 + rr; const size_t r = (size_t)b * LL + (t < LL ? t : LL - 1);
            a[q] = *(const u32x4*)(OF + r * DM + h * 128 + c8); c[q] = *(const u32x4*)(MIX + r * MIXW + h * 128 + c8); gt[q] = *(const u32x4*)(Z + r * EVEN_IN + 8192 + h * 128 + c8); }
#pragma unroll
        for (int q = 0; q < 4; ++q) { const int t = t0 + q * 4 + rr; float v[8]; float ss = 0.f;
#pragma unroll
            for (int w = 0; w < 4; ++w) { v[2 * w] = bflo(a[q][w]) + bflo(c[q][w]); v[2 * w + 1] = bfhi(a[q][w]) + bfhi(c[q][w]); ss += v[2 * w] * v[2 * w] + v[2 * w + 1] * v[2 * w + 1]; }
            ss += __shfl_xor(ss, 1); ss += __shfl_xor(ss, 2); ss += __shfl_xor(ss, 4); ss += __shfl_xor(ss, 8);
            const float rstd = rsqrtf(ss * (1.f / 128) + 1e-6f);
            u32x4 w4;
#pragma unroll
            for (int w = 0; w < 4; ++w) { const float ga = (w < 2) ? g0[2 * w] : g1[2 * w - 4], gb = (w < 2) ? g0[2 * w + 1] : g1[2 * w - 3];
                w4[w] = cvt_pk(v[2 * w] * rstd * ga * siluf(bflo(gt[q][w])), v[2 * w + 1] * rstd * gb * siluf(bfhi(gt[q][w]))); }
            if (t < LL) *(u32x4*)(MIX + ((size_t)b * LL + t) * MIXW + h * 128 + c8) = w4; }
    }
}

DI void mix_even(const Params& p, LAS unsigned char* lds, const int li, const int wave_s__) {
    const bf16_t* Z = (const bf16_t*)(p.ws + OFF_Z); bf16_t* MIX = (bf16_t*)(p.ws + OFF_MIX); bf16_t* HN = (bf16_t*)(p.ws + OFF_HN);
    const int k = ltid(wave_s__) & 127, wid = ltid(wave_s__) >> 6;
    for (int u = blockIdx.x; u < 256; u += gridDim.x) {
        const int b = u >> 5, h = (u >> 1) & 15, dir = u & 1;
        float lbv = 0.f;
        if (li == 1) { const float a0 = p.hgrn_lb[(size_t)(dir * 2 + 0) * 2048 + h * 128 + k], a1 = p.hgrn_lb[(size_t)(dir * 2 + 1) * 2048 + h * 128 + k]; lbv = 1.f / (1.f + __expf(a0 - a1)); }
        hgrn_seq(lds, Z + (size_t)b * LL * EVEN_IN, EVEN_IN, h, dir, lbv, dir ? (MIX + (size_t)b * LL * MIXW + h * 128) : (HN + (size_t)b * LL * DM + h * 128), dir ? MIXW : DM, wave_s__);
        unsigned* hf = (unsigned*)(p.ws + OFF_HFLAG) + li * 128 + b * 16 + h;
        if (wave_s__ == 0 && __lane_id() == 0) { __threadfence(); __hip_atomic_fetch_add(hf, 1u, __ATOMIC_RELEASE, __HIP_MEMORY_SCOPE_AGENT);
            if (dir) { while (__hip_atomic_load(hf, __ATOMIC_RELAXED, __HIP_MEMORY_SCOPE_AGENT) < 2u) __builtin_amdgcn_s_sleep(2);
                __builtin_amdgcn_fence(__ATOMIC_ACQUIRE, "agent"); } }
        if (dir) { __syncthreads(); fin_head(p, li, b, h, wave_s__); __syncthreads(); }
    }
    const int j = wid >> 2;
    for (int i = 0;; ++i) {
        const int u = xcd_unit(i); if (u >= 1088) break;
        const int qb = u % 17, r = u / 17, pair = r & 1, kvh = (r >> 1) & 3, b = r >> 3;
        const int hq = kvh * 4 + pair * 2 + j;
        const float slope = exp2f(-0.5f * (float)(hq + 1));
        const int t0 = qb * 128;
        const int lo = (t0 - 128) < 32 ? 1 : ((t0 - 128) >> 5);
        const int hi = ((t0 + 255) >> 5) > 64 ? 64 : ((t0 + 255) >> 5);
        attn_unit<4, 1, true>(lds, Z + (size_t)b * LL * EVEN_IN, EVEN_IN, 10240 + hq * 128, 12288 + kvh * 128, 0, 12800 + kvh * 128, 13312 + hq * 128, 2048 + hq * 128,
                              slope * LOG2E, p.sink[li * 16 + hq] * LOG2E, t0, lo, 2 + hi - lo, MIX + (size_t)b * LL * MIXW, 0.f, nullptr, 0.f, wave_s__);
    }
}

DI void fin_even(const Params& p, const int li, const int wave_s__) {
    const bf16_t* Z = (const bf16_t*)(p.ws + OFF_Z); bf16_t* MIX = (bf16_t*)(p.ws + OFF_MIX); const bf16_t* OF = (const bf16_t*)(p.ws + OFF_HN);
    const int wid = ltid(wave_s__) >> 6, lane = ltid(wave_s__) & 63;
    const float* ng = p.hgrn_norm + li * 128 + (lane & 3) * 32;
    for (int r = blockIdx.x * 8 + wid; r < MTOK; r += gridDim.x * 8) {
        const bf16_t* f = OF + (size_t)r * DM + lane * 32; bf16_t* mb = MIX + (size_t)r * MIXW + lane * 32; const bf16_t* gp = Z + (size_t)r * EVEN_IN + 8192 + lane * 32;
        float v[32]; float ss = 0.f;
#pragma unroll
        for (int q = 0; q < 4; ++q) { const u32x4 a = *(const u32x4*)(f + q * 8), c = *(const u32x4*)(mb + q * 8);
#pragma unroll
            for (int w = 0; w < 4; ++w) { v[q * 8 + 2 * w] = bflo(a[w]) + bflo(c[w]); v[q * 8 + 2 * w + 1] = bfhi(a[w]) + bfhi(c[w]); } }
#pragma unroll
        for (int e = 0; e < 32; ++e) ss += v[e] * v[e];
        ss += __shfl_xor(ss, 1); ss += __shfl_xor(ss, 2);
        const float rstd = rsqrtf(ss * (1.f / 128) + 1e-6f);
#pragma unroll
        for (int q = 0; q < 4; ++q) { const u32x4 g = *(const u32x4*)(gp + q * 8); u32x4 w;
#pragma unroll
            for (int w_ = 0; w_ < 4; ++w_) { const int e = q * 8 + 2 * w_;
                w[w_] = cvt_pk(v[e] * rstd * ng[e] * siluf(bflo(g[w_])), v[e + 1] * rstd * ng[e + 1] * siluf(bfhi(g[w_]))); }
            *(u32x4*)(mb + q * 8) = w; }
    }
}


DI void qk_norm_pass(const Params& p, const int li, const int wave_s__) {
    const bf16_t* Z = (const bf16_t*)(p.ws + OFF_Z); unsigned* nrm = (unsigned*)(p.ws + OFF_NRM) + li * 512;
    const int lane = (int)__lane_id();
    const int gw = blockIdx.x * 8 + wave_s__, nw = gridDim.x * 8;
    const int per = (MTOK + nw - 1) / nw; const int r0 = gw * per, r1 = (r0 + per) < MTOK ? (r0 + per) : MTOK;
    float mxv[16]; int curb = -1;
#pragma unroll
    for (int jx = 0; jx < 16; ++jx) mxv[jx] = 0.f;
    for (int r = r0; r < r1; ++r) {
        const int b = r / LL;
        if (b != curb) { if (curb >= 0) {
#pragma unroll
                for (int jx = 0; jx < 16; ++jx) { if ((lane & 15) == 0) atomicMax(nrm + curb * 64 + jx * 4 + (lane >> 4), __float_as_uint(mxv[jx])); mxv[jx] = 0.f; } }
            curb = b; }
        const bf16_t* row = Z + (size_t)r * ODD_LD;
#pragma unroll
        for (int jx = 0; jx < 16; ++jx) { const u32x4 v = *(const u32x4*)(row + (jx * 64 + lane) * 8); float ss = 0.f;
#pragma unroll
            for (int w = 0; w < 4; ++w) { const float a = bflo(v[w]), c = bfhi(v[w]); ss += a * a + c * c; }
            ss += __shfl_xor(ss, 1); ss += __shfl_xor(ss, 2); ss += __shfl_xor(ss, 4); ss += __shfl_xor(ss, 8);
            mxv[jx] = fmaxf(mxv[jx], ss); }
    }
    if (curb >= 0) {
#pragma unroll
        for (int jx = 0; jx < 16; ++jx) if ((lane & 15) == 0) atomicMax(nrm + curb * 64 + jx * 4 + (lane >> 4), __float_as_uint(mxv[jx]));
    }
}

DI void mix_odd(const Params& p, LAS unsigned char* lds, const int li, const int layer, const int wave_s__) {
    const bf16_t* Z = (const bf16_t*)(p.ws + OFF_Z); bf16_t* MIX = (bf16_t*)(p.ws + OFF_MIX);
    const int lane = ltid(wave_s__) & 63, wid = ltid(wave_s__) >> 6, j = wid >> 2;
    const float lam_init = 0.8f - 0.6f * expf(-0.3f * (float)layer);
    const float lam = ((const float*)(p.ws + OFF_MISC))[li];
    unsigned* qctr = (unsigned*)(p.ws + OFF_QCTR) + li * 8;
    volatile LAS unsigned* qw = (volatile LAS unsigned*)(lds + 131072);
    for (int sq = 0; sq < 8; ++sq) {
      const int b = ((int)blockIdx.x + sq) & 7;
      for (;;) {
        if (wid == 0 && lane == 0) qw[0] = atomicAdd(qctr + b, 1u);
        __syncthreads();
        const unsigned uq = qw[0];
        __syncthreads();
        if (uq >= 272u) break;
        const int h = 15 - (int)(uq / 17u), qb = (int)(uq % 17u);
        const float slope = exp2f(-0.5f * (float)(h + 1));
        const unsigned* nr = (const unsigned*)(p.ws + OFF_NRM) + li * 512 + b * 64;
        const float q0 = __uint_as_float(nr[h * 2]), q1 = __uint_as_float(nr[h * 2 + 1]), k0 = __uint_as_float(nr[32 + h * 2]), k1 = __uint_as_float(nr[32 + h * 2 + 1]);
        const float Bq = sqrtf(fmaxf(q0 * k0, q1 * k1)) * (0.08838834764831845f * LOG2E * 1.001f);
        const float Dmin = (40.f + 2.f * Bq) / (slope * LOG2E);
        const int t0 = qb * 128;
        int first = (int)floorf(((float)(t0 - 31) - Dmin) * (1.f / 32.f)) + 1; first = first < 0 ? 0 : first;
        int last = (int)ceilf(((float)(t0 + 127) + Dmin) * (1.f / 32.f)) - 1; last = last > 64 ? 64 : last;
        attn_unit<8, 2, false>(lds, Z + (size_t)b * LL * ODD_LD, ODD_LD, h * 256 + j * 128, 4096 + h * 256, 4096 + h * 256 + 128, 8192 + h * 256, 12288 + h * 256, h * 256,
                               slope * LOG2E, 0.f, t0, first, last - first + 1, MIX + (size_t)b * LL * MIXW, lam, p.dnorm + li * 256, 1.f - lam_init, wave_s__);
      }
    }
}


struct G2Order : pg8::StaticOrder {
    __device__ bool next(int i, pg8::Unit& u) const {
        const long L = (long)i * G + c;
        if (L < nwg) return pg8::StaticOrder::next(i, u);
        const int jx = (int)(L - nwg); if (jx >= 128) return false;
        u.pm = 64; u.pn = jx & 7; u.kt0 = (jx >> 3) * 4; u.nt = 4; return true;
    }
};
template <bool EVEN>
DI void run_g1(const Params& p, LAS unsigned char* lds, const int layer, const int wave_s__) {
    constexpr int nin = EVEN ? EVEN_IN : ODD_IN;
    pg8::Gemm g; g.A = (const bf16_t*)(p.ws + OFF_HN); g.Bt = (const bf16_t*)(p.ws + ((layer & 1) ? OFF_WIN2 : OFF_WIN)); g.M = MPAD; g.N = nin; g.K = DM;
    pg8::StaticOrder S; S.init(MPAD, nin, (int)gridDim.x, (int)blockIdx.x, DM);
    pg8::EpiBf16<0> E; E.O = (bf16_t*)(p.ws + OFF_Z); E.ldc = EVEN ? EVEN_IN : ODD_LD; E.bias = nullptr; E.split_cols = 0; E.split_stride = 0;
    pg8::gemm_phase<pg8::EpiBf16<0>, pg8::StaticOrder, false>(lds, g, S, E, nullptr, wave_s__);
    const int rem = ((MPAD / 256) * (nin / 256)) % (int)gridDim.x; const int first = (rem == 0 || 2 * rem > (int)gridDim.x) ? 0 : rem;
    const int li = layer >> 1;
    convert_T(lds, (EVEN ? p.w_out_a : p.w_out_c) + (size_t)li * MIXW * DM, (bf16_t*)(p.ws + OFF_WOUT), MIXW, DM, wave_s__, first);
    if (layer < 3) { bf16_t* wn = (bf16_t*)(p.ws + (((layer + 1) & 1) ? OFF_WIN2 : OFF_WIN));
        if (EVEN) convert_T(lds, p.w_in_c + (size_t)li * DM * ODD_IN, wn, DM, ODD_IN, wave_s__, first);
        else convert_T(lds, p.w_in_a + (size_t)(li + 1) * DM * EVEN_IN, wn, DM, EVEN_IN, wave_s__, first); }
}
DI void run_g2(const Params& p, LAS unsigned char* lds, const int layer, const int wave_s__) {
    pg8::Gemm g; g.A = (const bf16_t*)(p.ws + OFF_MIX); g.Bt = (const bf16_t*)(p.ws + OFF_WOUT); g.M = MPAD; g.N = DM; g.K = MIXW;
    G2Order S; S.init(16384, DM, (int)gridDim.x, (int)blockIdx.x, MIXW);
    EpiResAdd E; E.H = (float*)(p.ws + OFF_H); E.ldc = DM; E.P = (float*)(p.ws + OFF_PART); E.x0 = layer == 0 ? p.x : nullptr; E.meta0 = p.meta;
    pg8::gemm_phase<EpiResAdd, G2Order, false>(lds, g, S, E, nullptr, wave_s__);
}

#define PH_IN(k) (lo <= (k) && (k) < hi)
DI void grid_bar(unsigned* base, const unsigned epoch, const int wave_s__) {
    __syncthreads();
    if (wave_s__ == 0 && __lane_id() == 0) {
        const unsigned G = gridDim.x, x = blockIdx.x & 7u;
        const unsigned gsize = (G - x + 7u) >> 3, ngroups = G < 8u ? G : 8u;
        const unsigned old = __hip_atomic_fetch_add(base + 32u * (1u + x), 1u, __ATOMIC_ACQ_REL, __HIP_MEMORY_SCOPE_AGENT);
        if (old + 1u == gsize * epoch) __hip_atomic_fetch_add(base, 1u, __ATOMIC_ACQ_REL, __HIP_MEMORY_SCOPE_AGENT);
        while (__hip_atomic_load(base, __ATOMIC_RELAXED, __HIP_MEMORY_SCOPE_AGENT) < ngroups * epoch) __builtin_amdgcn_s_sleep(1);
        __builtin_amdgcn_fence(__ATOMIC_ACQUIRE, "agent");
    }
    __syncthreads();
}
#define PH_SYNC(k) do { if (PH_IN(k) && PH_IN((k) + 1)) { nbar += 1u; grid_bar(barcnt, nbar, wave_s__); } } while (0)
DI void layer_pair(const Params& p, LAS unsigned char* lds, unsigned* barcnt, unsigned& nbar, const int lo, const int hi, const int pr, const int wave_s__) {
    bf16_t* WIN = (bf16_t*)(p.ws + OFF_WIN); bf16_t* WOUT = (bf16_t*)(p.ws + OFF_WOUT);

        const int k0 = 1 + 9 * pr;
        if (PH_IN(k0 + 0)) run_g1<true>(p, lds, 2 * pr, wave_s__);
        PH_SYNC(k0 + 0);
        if (PH_IN(k0 + 1)) {
#pragma unroll 1
            for (int rep = 0; rep <= p.dup_e; ++rep) { mix_even(p, lds, pr, wave_s__); __syncthreads(); }

}
        PH_SYNC(k0 + 1);
        if (PH_IN(k0 + 3)) run_g2(p, lds, 2 * pr, wave_s__);
        PH_SYNC(k0 + 3);
        if (PH_IN(k0 + 4)) row_phase<1>(p, p.norm_c + (size_t)pr * DM, wave_s__);
        PH_SYNC(k0 + 4);
        if (PH_IN(k0 + 5)) run_g1<false>(p, lds, 2 * pr + 1, wave_s__);
        PH_SYNC(k0 + 5);
        if (PH_IN(k0 + 6)) {
            qk_norm_pass(p, pr, wave_s__);
            nbar += 1u; grid_bar(barcnt, nbar, wave_s__);
#pragma unroll 1
            for (int rep = 0; rep <= p.dup_o; ++rep) { mix_odd(p, lds, pr, 2 * pr + 1, wave_s__); __syncthreads(); }

}
        PH_SYNC(k0 + 6);
        if (PH_IN(k0 + 7)) run_g2(p, lds, 2 * pr + 1, wave_s__);
        PH_SYNC(k0 + 7);
        if (PH_IN(k0 + 8)) { if (pr == 1) row_phase<2>(p, p.fnorm, wave_s__); else row_phase<1>(p, p.norm_a + (size_t)DM, wave_s__); }
        PH_SYNC(k0 + 8);
}

__global__ void __launch_bounds__(512, 2) mega(Params p) {
    extern __shared__ __attribute__((aligned(16))) unsigned char lds_raw[];
    LAS unsigned char* lds = (LAS unsigned char*)lds_raw;
    cg::grid_group grid = cg::this_grid();
    const int lo = p.ph_lo, hi = p.ph_hi;
    const int wave_s__ = __builtin_amdgcn_readfirstlane((int)threadIdx.x >> 6);
    bf16_t* WIN = (bf16_t*)(p.ws + OFF_WIN); bf16_t* WOUT = (bf16_t*)(p.ws + OFF_WOUT);
    if (PH_IN(0)) {
        if (blockIdx.x == 0) { unsigned* cw = (unsigned*)(p.ws + OFF_MISC + 256); for (int i = ltid(wave_s__); i < (8192 - 256) / 4; i += 512) cw[i] = 0u; }
        if (blockIdx.x == 0 && wave_s__ < 2) {
            const int lane = (int)__lane_id(); const float* lv = p.dlam + wave_s__ * 512;
            const float d1 = wave_sum(lv[lane] * lv[128 + lane] + lv[64 + lane] * lv[192 + lane]);
            const float d2 = wave_sum(lv[256 + lane] * lv[384 + lane] + lv[320 + lane] * lv[448 + lane]);
            const float lam_init = 0.8f - 0.6f * expf(-0.3f * (float)(2 * wave_s__ + 1));
            if (lane == 0) ((float*)(p.ws + OFF_MISC))[wave_s__] = expf(d1) - expf(d2) + lam_init;
        }
        row_phase<0>(p, p.norm_a, wave_s__); convert_T(lds, p.w_in_a, WIN, DM, EVEN_IN, wave_s__); }
    unsigned* barcnt = (unsigned*)(p.ws + OFF_MISC + 5632); unsigned nbar = 0u;
    if (PH_IN(0) && PH_IN(1)) grid.sync();
    layer_pair(p, lds, barcnt, nbar, lo, hi, 0, wave_s__);
    layer_pair(p, lds, barcnt, nbar, lo, hi, 1, wave_s__);
}

constexpr int N_PHASES = 19;

extern "C" void kernel_launch(void* const* d_in, const int* in_sizes, int n_in, void* d_out, int out_size, void* d_ws, size_t ws_size, hipStream_t stream) {
    static int grid = 0;
    if (grid == 0) {
        if (n_in != 14 || ws_size < WS_END) { fprintf(stderr, "kernel_launch: need 14 inputs and %zu bytes of workspace; got %d, %zu\n", (size_t)WS_END, n_in, ws_size); grid = -1; return; }
        int dev = 0, cus = 0, per_cu = 0;
        hipGetDevice(&dev); hipDeviceGetAttribute(&cus, hipDeviceAttributeMultiprocessorCount, dev);
        if (hipFuncSetAttribute((const void*)mega, hipFuncAttributeMaxDynamicSharedMemorySize, LDS_BYTES) != hipSuccess) { fprintf(stderr, "kernel_launch: hipFuncSetAttribute failed\n"); grid = -1; return; }
        if (hipOccupancyMaxActiveBlocksPerMultiprocessor(&per_cu, (const void*)mega, 512, LDS_BYTES) != hipSuccess || per_cu < 1) { fprintf(stderr, "kernel_launch: occupancy query says %d\n", per_cu); per_cu = 1; }
        (void)hipGetLastError();
        grid = cus * 1;
    }
    if (grid < 0) return;
    Params p{};
    p.x = (const float*)d_in[0]; p.meta = (const float*)d_in[1]; p.norm_a = (const float*)d_in[2]; p.w_in_a = (const float*)d_in[3]; p.w_out_a = (const float*)d_in[4];
    p.hgrn_lb = (const float*)d_in[5]; p.hgrn_norm = (const float*)d_in[6]; p.sink = (const float*)d_in[7]; p.norm_c = (const float*)d_in[8]; p.w_in_c = (const float*)d_in[9];
    p.w_out_c = (const float*)d_in[10]; p.dlam = (const float*)d_in[11]; p.dnorm = (const float*)d_in[12]; p.fnorm = (const float*)d_in[13];
    p.out = (float*)d_out; p.ws = (unsigned char*)d_ws; p.ph_lo = 0; p.ph_hi = N_PHASES;
#ifdef DUP_ODD
    p.dup_o = 1;
#endif
#ifdef DUP_EVEN
    p.dup_e = 1;
#endif
    void* args[] = {&p};
    hipError_t e = hipLaunchCooperativeKernel((const void*)mega, dim3(grid), dim3(512), args, LDS_BYTES, stream);
    if (e != hipSuccess) fprintf(stderr, "kernel_launch: cooperative launch failed: %s (grid %d)\n", hipGetErrorString(e), grid);
}
```

```cpp
#include <hip/hip_runtime.h>
#include <hip/hip_cooperative_groups.h>
#include <cstdio>
namespace cg = cooperative_groups;
__device__ __forceinline__ int ltid(int wave_s__) { int t = wave_s__ * 64 + (int)__lane_id(); asm volatile("" : "+v"(t)); return t; }
namespace pg8 {
#define PG8_LAS __attribute__((address_space(3)))
typedef unsigned short bf16_t;
typedef short bf16x8 __attribute__((ext_vector_type(8)));
typedef float f32x4 __attribute__((ext_vector_type(4)));
typedef unsigned u32x4 __attribute__((ext_vector_type(4)));
constexpr int BM = 256, BK = 64, HALF = 128, HTB = HALF * BK * 2  , STAGE_BYTES = 8 * HTB, NXCD = 8, WGM = 4;

__host__ __device__ __forceinline__ int lds_byte(int r, int c) { const int st = (r >> 4) * 2 + (c >> 5), rr = r & 15, cc = c & 31, ob = rr * 64 + cc * 2; return st * 1024 + (ob ^ (((ob >> 9) & 1) << 5)); }
__host__ __device__ __forceinline__ void stage_rc(int b, int& R, int& C) { const int st = b / 1024, sb = b % 1024, swz = sb ^ (((sb >> 9) & 1) << 5); R = (st >> 1) * 16 + swz / 64; C = (st & 1) * 32 + (swz % 64) / 2; }
__host__ __device__ __forceinline__ int perm32(int rho) { const int n = rho >> 4, i = rho & 15; return 8 * (i >> 2) + 4 * n + (i & 3); }

struct Unit { int pm, pn, kt0, nt; };
struct Gemm { const bf16_t* A; const bf16_t* Bt; int M, N, K; };

struct StaticOrder {
    int nM, nN, nwg, G, c, KT;
    __host__ __device__ void init(int M, int N, int G_, int c_, int K_ = 0) { nM = M / BM; nN = N / BM; nwg = nM * nN; G = G_; c = c_; KT = K_ / BK; }
    __host__ __device__ bool next(int i, Unit& u) const {
        const long L = (long)i * G + c; if (L >= nwg) return false;
        int wgid = (int)L; { const int q = nwg / NXCD, r = nwg % NXCD, xcd = wgid % NXCD, off = wgid / NXCD; wgid = (xcd < r ? xcd * (q + 1) : r * (q + 1) + (xcd - r) * q) + off; }
        const int nig = WGM * nN, gid = wgid / nig, fm = gid * WGM, gsz = (nM - fm) < WGM ? (nM - fm) : WGM;
        u.pm = fm + ((wgid % nig) % gsz); u.pn = (wgid % nig) / gsz; u.kt0 = 0; u.nt = KT; return true;
    }
    __device__ __forceinline__ void a_ready(const Unit&) const {}
    __device__ __forceinline__ void done(const Unit&) const {}
};
struct CountedOrder : StaticOrder {
    const unsigned* ready; unsigned need; unsigned* tmo;
    __device__ __forceinline__ void a_ready(const Unit& u) const {
        if ((int)threadIdx.x < 64) {
            const unsigned long long t0 = __builtin_amdgcn_s_memrealtime(); unsigned polls = 0;
            while ((unsigned)__builtin_amdgcn_readfirstlane(__hip_atomic_load(ready + 64 * u.pm, __ATOMIC_RELAXED, __HIP_MEMORY_SCOPE_AGENT)) < need) {
                if ((++polls & 255u) == 0u && __builtin_amdgcn_readfirstlane(__hip_atomic_load(tmo, __ATOMIC_RELAXED, __HIP_MEMORY_SCOPE_AGENT)) != 0u) break;
                if (__builtin_amdgcn_s_memrealtime() - t0 > 2000000ull) {
                    if ((int)threadIdx.x == 0) { unsigned expect = 0u; __hip_atomic_compare_exchange_strong(tmo + 1, &expect, 0x600u | (unsigned)(u.pm & 0xff), __ATOMIC_RELAXED, __ATOMIC_RELAXED, __HIP_MEMORY_SCOPE_AGENT); __hip_atomic_store(tmo, 1u, __ATOMIC_RELAXED, __HIP_MEMORY_SCOPE_AGENT); }
                    break; }
                __builtin_amdgcn_s_sleep(2); }
            __builtin_amdgcn_fence(__ATOMIC_ACQUIRE, "agent");
            asm volatile("s_waitcnt vmcnt(0)" ::: "memory");
        }
#if !defined(BROKEN_HOOK_NO_BARRIER)
        asm volatile("" ::: "memory"); __builtin_amdgcn_s_barrier(); asm volatile("" ::: "memory");
#endif
    }
};

__device__ __forceinline__ unsigned cvt_pk_bf16(float lo, float hi) { unsigned r; asm volatile("v_cvt_pk_bf16_f32 %0, %1, %2" : "=v"(r) : "v"(lo), "v"(hi)); return r; }
typedef float f32x2 __attribute__((ext_vector_type(2)));
__device__ __forceinline__ f32x2 gelu_pk(f32x2 v) {
    const f32x2 av = __builtin_elementwise_abs(v), d = av * 0.2316418882f + 1.0f;
    f32x2 t; t.x = __builtin_amdgcn_rcpf(d.x); t.y = __builtin_amdgcn_rcpf(d.y);
    f32x2 q = t * 0.5307027145f + (-0.7265760135f); q = q * t + 0.7107068705f; q = q * t + (-0.142248368f); q = q * t + 0.127414796f; q = q * t;
    const f32x2 s = (v * v) * (-0.72134752044f);
    f32x2 e; e.x = __builtin_amdgcn_exp2f(s.x); e.y = __builtin_amdgcn_exp2f(s.y);
    const f32x2 m = v * (q * e), r = v - m;
    f32x2 o; o.x = v.x < 0.f ? m.x : r.x; o.y = v.y < 0.f ? m.y : r.y; return o;
}

struct EpiF32 {
    static constexpr bool PERM = false, AFTER_DRAIN = false;
    float* C; int ldc; const float* bias;
    __device__ __forceinline__ void operator()(const f32x4 (&acc)[2][2][4][2], const Unit& u, int wr, int wc, int fr, int fq) const {
        const int row0 = u.pm * BM + wr * 64 + fr, col0 = u.pn * BM + wc * 32 + 4 * fq;
        f32x4 bv[2][2];
#pragma unroll
        for (int bj = 0; bj < 2; ++bj)
#pragma unroll
            for (int n = 0; n < 2; ++n) bv[bj][n] = bias ? *(const f32x4*)(bias + col0 + bj * HALF + n * 16) : (f32x4){0.f, 0.f, 0.f, 0.f};
#pragma unroll
        for (int ai = 0; ai < 2; ++ai)
#pragma unroll
            for (int m = 0; m < 4; ++m) { float* rowp = C + (size_t)(row0 + ai * HALF + m * 16) * ldc + col0;
#pragma unroll
                for (int bj = 0; bj < 2; ++bj)
#pragma unroll
                    for (int n = 0; n < 2; ++n) *(f32x4*)(rowp + bj * HALF + n * 16) = acc[ai][bj][m][n] + bv[bj][n]; }
    }
};
template <int ACT  > struct EpiBf16 {
    static constexpr bool PERM = true, AFTER_DRAIN = false;
    bf16_t* O; int ldc; const float* bias; int split_cols; size_t split_stride;
    __device__ __forceinline__ void operator()(const f32x4 (&acc)[2][2][4][2], const Unit& u, int wr, int wc, int fr, int fq) const {
        const int row0 = u.pm * BM + wr * 64 + fr; int colt = u.pn * BM; bf16_t* base = O;
        if (split_cols) { const int t = colt / split_cols; base += (size_t)t * split_stride; colt -= t * split_cols; }
        const int col0 = colt + wc * 32 + 8 * fq, bcol0 = u.pn * BM + wc * 32 + 8 * fq;
        f32x4 bv[2][2];
#pragma unroll
        for (int bj = 0; bj < 2; ++bj)
#pragma unroll
            for (int n = 0; n < 2; ++n) bv[bj][n] = bias ? *(const f32x4*)(bias + bcol0 + bj * HALF + 4 * n) : (f32x4){0.f, 0.f, 0.f, 0.f};
#pragma unroll
        for (int ai = 0; ai < 2; ++ai)
#pragma unroll
            for (int m = 0; m < 4; ++m) { bf16_t* rowp = base + (size_t)(row0 + ai * HALF + m * 16) * ldc + col0;
#pragma unroll
                for (int bj = 0; bj < 2; ++bj) { f32x4 v0 = acc[ai][bj][m][0] + bv[bj][0], v1 = acc[ai][bj][m][1] + bv[bj][1];
                    if (ACT == 1) { f32x2 a = gelu_pk((f32x2){v0[0], v0[1]}), b = gelu_pk((f32x2){v0[2], v0[3]}), c = gelu_pk((f32x2){v1[0], v1[1]}), d = gelu_pk((f32x2){v1[2], v1[3]});
                        v0 = (f32x4){a.x, a.y, b.x, b.y}; v1 = (f32x4){c.x, c.y, d.x, d.y}; }
                    if (ACT == 2) {
#pragma unroll
                        for (int j = 0; j < 4; ++j) { v0[j] = 0.5f * v0[j] * (1.0f + erff(v0[j] * 0.70710678f)); v1[j] = 0.5f * v1[j] * (1.0f + erff(v1[j] * 0.70710678f)); } }
                    u32x4 w; w.x = cvt_pk_bf16(v0[0], v0[1]); w.y = cvt_pk_bf16(v0[2], v0[3]); w.z = cvt_pk_bf16(v1[0], v1[1]); w.w = cvt_pk_bf16(v1[2], v1[3]);
                    *(u32x4*)(rowp + bj * HALF) = w; } }
    }
};

template <class Epi, class Sched, bool STAMP = false>
__device__ __forceinline__ void gemm_phase(PG8_LAS unsigned char* lds, const Gemm g, const Sched& S, const Epi& E, unsigned long long* stamps, const int wave_s__) {
    const int tid = ltid(wave_s__), wid = __builtin_amdgcn_readfirstlane(tid >> 6), lane = tid & 63, wr = wid >> 2, wc = wid & 3, fr = lane & 15, fq = lane >> 4;
    const int K = g.K; int nt;
    int ts_lo = 0, ts_hi = 0, nts = 0; const unsigned long long rt_entry = STAMP ? (unsigned long long)wall_clock64() : 0ull;
#define PG8_STAMP() do { if (STAMP && wid == 0 && nts < 64) { const unsigned long long _c = (unsigned long long)clock64(); \
        ts_lo = (lane == nts) ? (int)(unsigned)_c : ts_lo; ts_hi = (lane == nts) ? (int)(unsigned)(_c >> 32) : ts_hi; ++nts; } } while (0)
    PG8_STAMP();
    unsigned voffA[2], voffB[2];
#pragma unroll
    for (int i = 0; i < 2; ++i) { int R, C; stage_rc(tid * 16 + i * 8192, R, C); const int Rb = Epi::PERM ? ((R & ~31) + perm32(R & 31)) : R;
        voffA[i] = (unsigned)(R * K + C) * 2u; voffB[i] = (unsigned)(Rb * K + C) * 2u; }
    const size_t kstep = (size_t)(BK * 2);
    const size_t hstep = (size_t)HALF * K * 2;
    const size_t tstep = 2 * hstep;
    const unsigned ldsw = (unsigned)wid * 1024u;
    const int aoff = lds_byte(wr * 64 + fr, fq * 8), boff = lds_byte(wc * 32 + fr, fq * 8);
#define PG8_SA(b, h) (((b) * 2 + (h)) * HTB)
#define PG8_SB(b, h) ((4 + (b) * 2 + (h)) * HTB)
#define PG8_STAGE(bufoff, gbase, voff) do { _Pragma("unroll") for (int _i = 0; _i < 2; ++_i) \
        __builtin_amdgcn_global_load_lds((const unsigned*)((const char*)(gbase) + (voff)[_i]), (PG8_LAS unsigned*)(lds + (bufoff) + ldsw + _i * 8192), 16, 0, 0); } while (0)
#define PG8_LDA(dst, b, h) do { _Pragma("unroll") for (int m = 0; m < 4; ++m) _Pragma("unroll") for (int k = 0; k < 2; ++k) dst[m][k] = *(const PG8_LAS bf16x8*)(lds + PG8_SA(b, h) + aoff + m * 2048 + k * 1024); } while (0)
#define PG8_LDB(dst, b, h) do { _Pragma("unroll") for (int n = 0; n < 2; ++n) _Pragma("unroll") for (int k = 0; k < 2; ++k) dst[n][k] = *(const PG8_LAS bf16x8*)(lds + PG8_SB(b, h) + boff + n * 2048 + k * 1024); } while (0)
#define PG8_MMA(ai, bj, At, Bt) do { __builtin_amdgcn_s_setprio(1); _Pragma("unroll") for (int m = 0; m < 4; ++m) _Pragma("unroll") for (int n = 0; n < 2; ++n) _Pragma("unroll") for (int k = 0; k < 2; ++k) \
        acc[ai][bj][m][n] = __builtin_amdgcn_mfma_f32_16x16x32_bf16(Bt[n][k], At[m][k], acc[ai][bj][m][n], 0, 0, 0); __builtin_amdgcn_s_setprio(0); } while (0)
#define PG8_WAIT_V(n) asm volatile("s_waitcnt vmcnt(" #n ")" ::: "memory")
#define PG8_WAIT_L(n) asm volatile("s_waitcnt lgkmcnt(" #n ")" ::: "memory")
#define PG8_BAR __builtin_amdgcn_s_barrier()
#define PG8_SCHED __builtin_amdgcn_sched_barrier(0)
    Unit cur, nxt; int ui = 0;
    if (!S.next(0, cur)) return;
    f32x4 acc[2][2][4][2];
#pragma unroll
    for (int a = 0; a < 2; ++a)
#pragma unroll
        for (int b = 0; b < 2; ++b)
#pragma unroll
            for (int m = 0; m < 4; ++m)
#pragma unroll
                for (int n = 0; n < 2; ++n) acc[a][b][m][n] = (f32x4){0.f, 0.f, 0.f, 0.f};
    bf16x8 At[4][2], B0[2][2], B1[2][2];
    nt = cur.nt;
    const char* cA = (const char*)g.A + (size_t)cur.pm * tstep + (size_t)cur.kt0 * kstep; const char* cB = (const char*)g.Bt + (size_t)cur.pn * tstep + (size_t)cur.kt0 * kstep;
    S.a_ready(cur);
    PG8_STAGE(PG8_SB(0, 0), cB, voffB); PG8_STAGE(PG8_SA(0, 0), cA, voffA); PG8_STAGE(PG8_SB(0, 1), cB + hstep, voffB); PG8_STAGE(PG8_SA(0, 1), cA + hstep, voffA);
    if (wr == 1) PG8_BAR;
    PG8_WAIT_V(4); PG8_BAR;
    PG8_STAGE(PG8_SB(1, 0), cB + kstep, voffB); PG8_STAGE(PG8_SA(1, 0), cA + kstep, voffA); PG8_STAGE(PG8_SB(1, 1), cB + hstep + kstep, voffB);
    PG8_WAIT_V(6); PG8_BAR;
    PG8_STAMP();
    for (;;) {
        const bool has_next = S.next(ui + 1, nxt);
        const char* nA = has_next ? (const char*)g.A + (size_t)nxt.pm * tstep + (size_t)nxt.kt0 * kstep : cA; const char* nB = has_next ? (const char*)g.Bt + (size_t)nxt.pn * tstep + (size_t)nxt.kt0 * kstep : cB;
        for (int t = 0; t < nt; t += 2) {
            const bool last = (t == nt - 2);
            const char* a1 = cA + (size_t)(t + 1) * kstep;
            const char* a2 = last ? nA : cA + (size_t)(t + 2) * kstep; const char* b2 = last ? nB : cB + (size_t)(t + 2) * kstep;
            const char* a3 = a2 + kstep; const char* b3 = b2 + kstep;
            if (last && has_next) S.a_ready(nxt);
            PG8_LDB(B0, 0, 0); PG8_SCHED; PG8_LDA(At, 0, 0); PG8_STAGE(PG8_SA(1, 1), a1 + hstep, voffA);
            PG8_WAIT_L(8); PG8_BAR; PG8_WAIT_L(0); PG8_MMA(0, 0, At, B0); PG8_BAR; PG8_SCHED;
            PG8_LDB(B1, 0, 1); PG8_STAGE(PG8_SB(0, 0), b2, voffB);
            PG8_BAR; PG8_WAIT_L(0); PG8_MMA(0, 1, At, B1); PG8_BAR;
            PG8_LDA(At, 0, 1); PG8_STAGE(PG8_SA(0, 0), a2, voffA);
            PG8_BAR; PG8_WAIT_L(0); PG8_MMA(1, 0, At, B0); PG8_BAR; PG8_SCHED;
            PG8_STAGE(PG8_SB(0, 1), b2 + hstep, voffB);
            PG8_WAIT_V(6); PG8_BAR; PG8_MMA(1, 1, At, B1); PG8_BAR;
            PG8_LDB(B0, 1, 0); PG8_SCHED; PG8_LDA(At, 1, 0); PG8_STAGE(PG8_SA(0, 1), a2 + hstep, voffA);
            PG8_WAIT_L(8); PG8_BAR; PG8_WAIT_L(0); PG8_MMA(0, 0, At, B0); PG8_BAR; PG8_SCHED;
            PG8_LDB(B1, 1, 1); PG8_STAGE(PG8_SB(1, 0), b3, voffB);
            PG8_BAR; PG8_WAIT_L(0); PG8_MMA(0, 1, At, B1); PG8_BAR;
            PG8_LDA(At, 1, 1); PG8_STAGE(PG8_SA(1, 0), a3, voffA);
            PG8_BAR; PG8_WAIT_L(0); PG8_MMA(1, 0, At, B0); PG8_BAR; PG8_SCHED;
            PG8_STAGE(PG8_SB(1, 1), b3 + hstep, voffB);
            PG8_WAIT_V(6); PG8_BAR; PG8_MMA(1, 1, At, B1); PG8_BAR;
        }
        PG8_STAMP();
        if constexpr (!Epi::AFTER_DRAIN) { E(acc, cur, wr, wc, fr, fq); S.done(cur); }
        PG8_STAMP();
        if (!has_next) break;
#pragma unroll
        for (int a = 0; a < 2; ++a)
#pragma unroll
            for (int b = 0; b < 2; ++b)
#pragma unroll
                for (int m = 0; m < 4; ++m)
#pragma unroll
                    for (int n = 0; n < 2; ++n) acc[a][b][m][n] = (f32x4){0.f, 0.f, 0.f, 0.f};
        cur = nxt; cA = nA; cB = nB; ++ui; nt = cur.nt;
    }
    PG8_WAIT_V(0);
    if (wr == 0) PG8_BAR;
    PG8_BAR;
    if constexpr (Epi::AFTER_DRAIN) { E.fused(acc, cur, wr, wc, fr, fq, lds, wid, lane); S.done(cur); }
    PG8_STAMP();
    if (STAMP && wid == 0) { stamps[lane] = lane < nts ? (((unsigned long long)(unsigned)ts_hi << 32) | (unsigned)ts_lo) : 0ull;
        if (lane == 62) stamps[62] = rt_entry; if (lane == 63) stamps[63] = (unsigned long long)wall_clock64(); }
#undef PG8_STAMP
#undef PG8_SA
#undef PG8_SB
#undef PG8_STAGE
#undef PG8_LDA
#undef PG8_LDB
#undef PG8_MMA
#undef PG8_WAIT_V
#undef PG8_WAIT_L
#undef PG8_BAR
#undef PG8_SCHED
}
}

using pg8::bf16_t; using pg8::bf16x8; using pg8::f32x4; using pg8::u32x4;
typedef short s16x4 __attribute__((ext_vector_type(4)));
typedef float f32x16 __attribute__((ext_vector_type(16)));
typedef unsigned u32x2 __attribute__((ext_vector_type(2)));
#define LAS __attribute__((address_space(3)))
#define DI __device__ __forceinline__
#define MFMA32(a, b, c) __builtin_amdgcn_mfma_f32_32x32x16_bf16((a), (b), (c), 0, 0, 0)

constexpr int NB = 8, LL = 2064, NMETA = 16, DM = 2048, MTOK = NB * LL, MPAD = 16640;
constexpr int EVEN_IN = 15360, ODD_IN = 16384, MIXW = 4096;
constexpr int ODD_LD = ODD_IN + 128;
constexpr int LDS_BYTES = 131072 + 1024;
#ifndef PHM
#define PHM 255
#endif
constexpr float LOG2E = 1.4426950408889634f, LN2 = 0.6931471805599453f;

constexpr size_t OFF_H = 0;
constexpr size_t OFF_HN = OFF_H + (size_t)MPAD * DM * 4;
constexpr size_t OFF_Z = OFF_HN + (size_t)MPAD * DM * 2;
constexpr size_t OFF_MIX = OFF_Z + (size_t)MPAD * ODD_LD * 2;
constexpr size_t OFF_WIN = OFF_MIX + (size_t)MPAD * MIXW * 2;
constexpr size_t OFF_WOUT = OFF_WIN + (size_t)ODD_IN * DM * 2;
constexpr size_t OFF_WIN2 = OFF_WOUT + (size_t)DM * MIXW * 2;
constexpr size_t OFF_MISC = OFF_WIN2 + (size_t)ODD_IN * DM * 2;
constexpr size_t OFF_QCTR = OFF_MISC + 384;
constexpr size_t OFF_HFLAG = OFF_MISC + 4608;
constexpr size_t OFF_NRM = OFF_MISC + 512;
constexpr size_t OFF_PART = OFF_MISC + 8192;
constexpr size_t WS_END = OFF_PART + (size_t)16 * 128 * DM * 4;

struct Params {
    const float *x, *meta, *norm_a, *w_in_a, *w_out_a, *hgrn_lb, *hgrn_norm, *sink, *norm_c, *w_in_c, *w_out_c, *dlam, *dnorm, *fnorm;
    float* out; unsigned char* ws; int ph_lo, ph_hi, dup_e, dup_o;
};

DI unsigned cvt_pk(float lo, float hi) { unsigned r; asm("v_cvt_pk_bf16_f32 %0, %1, %2" : "=v"(r) : "v"(lo), "v"(hi)); return r; }
DI float bf2f(bf16_t x) { return __uint_as_float(((unsigned)x) << 16); }
DI float bflo(unsigned u) { return __uint_as_float(u << 16); }
DI float bfhi(unsigned u) { return __uint_as_float(u & 0xffff0000u); }
DI float ex2(float x) { return __builtin_amdgcn_exp2f(x); }
DI float lg2(float x) { return __builtin_amdgcn_logf(x); }
DI float rcpf(float x) { return __builtin_amdgcn_rcpf(x); }
DI float siluf(float x) { return x * rcpf(1.f + ex2(-x * LOG2E)); }
DI float wave_sum(float v) {
#pragma unroll
    for (int o = 32; o; o >>= 1) v += __shfl_xor(v, o);
    return v; }
DI float xhalf_max(float v) { const auto r = __builtin_amdgcn_permlane32_swap(__float_as_uint(v), __float_as_uint(v), false, false); return fmaxf(__uint_as_float(r[0]), __uint_as_float(r[1])); }
DI float xhalf_sum(float v) { const auto r = __builtin_amdgcn_permlane32_swap(__float_as_uint(v), __float_as_uint(v), false, false); return __uint_as_float(r[0]) + __uint_as_float(r[1]); }
DI int crow(int reg, int h) { return (reg & 3) + 8 * (reg >> 2) + 4 * h; }
DI f32x16 zero16() { f32x16 z;
#pragma unroll
    for (int i = 0; i < 16; ++i) z[i] = 0.f;
    return z; }

template <int MODE>
DI void row_phase(const Params& p, const float* __restrict__ g, const int wave_s__) {
    const int wid = ltid(wave_s__) >> 6, lane = ltid(wave_s__) & 63;
    float* H = (float*)(p.ws + OFF_H); bf16_t* HN = (bf16_t*)(p.ws + OFF_HN);
    for (int r = blockIdx.x * 8 + wid; r < MPAD; r += gridDim.x * 8) {
        if (r >= MTOK) {
            if (MODE == 0) {
#pragma unroll
                for (int j = 0; j < 8; ++j) { *(f32x4*)(H + (size_t)r * DM + (j * 64 + lane) * 4) = (f32x4){0.f, 0.f, 0.f, 0.f}; }
            }
            if (MODE != 2) {
#pragma unroll
                for (int j = 0; j < 8; ++j) { u32x2 zz; zz.x = 0u; zz.y = 0u; *(u32x2*)(HN + (size_t)r * DM + (j * 64 + lane) * 4) = zz; }
            }
            continue;
        }
        const int b = r / LL, t = r - b * LL;
        const float* src;
        if (MODE == 0) src = (t < NMETA) ? (p.meta + (size_t)t * DM) : (p.x + ((size_t)b * 2048 + (t - NMETA)) * DM);
        else src = H + (size_t)r * DM;
        f32x4 v[8]; float ss = 0.f;
#pragma unroll
        for (int j = 0; j < 8; ++j) v[j] = *(const f32x4*)(src + (j * 64 + lane) * 4);
        if (MODE != 0 && r >= 16384) {
            const float* pp = (const float*)(p.ws + OFF_PART) + (size_t)(r - 16384) * DM;
            for (int sp = 0; sp < 16; ++sp) {
#pragma unroll
                for (int j = 0; j < 8; ++j) v[j] = v[j] + *(const f32x4*)(pp + (size_t)sp * 128 * DM + (j * 64 + lane) * 4); }
            if (MODE == 1) {
#pragma unroll
                for (int j = 0; j < 8; ++j) *(f32x4*)(H + (size_t)r * DM + (j * 64 + lane) * 4) = v[j]; }
        }
#pragma unroll
        for (int j = 0; j < 8; ++j) ss += v[j][0] * v[j][0] + v[j][1] * v[j][1] + v[j][2] * v[j][2] + v[j][3] * v[j][3];
        ss = wave_sum(ss);
        const float rstd = rsqrtf(ss * (1.f / DM) + 1e-6f);
        if (MODE == 0 && r >= 16384) {
#pragma unroll
            for (int j = 0; j < 8; ++j) *(f32x4*)(H + (size_t)r * DM + (j * 64 + lane) * 4) = v[j];
        }
        if (MODE == 2) {
            if (t >= NMETA) { float* op = p.out + ((size_t)b * 2048 + (t - NMETA)) * DM;
#pragma unroll
                for (int j = 0; j < 8; ++j) { const f32x4 gg = *(const f32x4*)(g + (j * 64 + lane) * 4); f32x4 o; o[0] = v[j][0] * rstd * gg[0]; o[1] = v[j][1] * rstd * gg[1]; o[2] = v[j][2] * rstd * gg[2]; o[3] = v[j][3] * rstd * gg[3];
                    *(f32x4*)(op + (j * 64 + lane) * 4) = o; } }
        } else {
#pragma unroll
            for (int j = 0; j < 8; ++j) { const f32x4 gg = *(const f32x4*)(g + (j * 64 + lane) * 4); u32x2 w; w.x = cvt_pk(v[j][0] * rstd * gg[0], v[j][1] * rstd * gg[1]); w.y = cvt_pk(v[j][2] * rstd * gg[2], v[j][3] * rstd * gg[3]);
                *(u32x2*)(HN + (size_t)r * DM + (j * 64 + lane) * 4) = w; }
        }
    }
}

DI void convert_T(LAS unsigned char* lds, const float* __restrict__ W, bf16_t* __restrict__ Wt, const int K, const int N, const int wave_s__, const int first = 0) {
    LAS float* tile = (LAS float*)lds;
    const int tid = ltid(wave_s__), nk = K >> 6, ntile = nk * (N >> 8);
    const int tx = tid & 63, ty = tid >> 6, wn = tid >> 3, wk = (tid & 7) * 8;
    if ((int)blockIdx.x < first) return;
    for (int t = (int)blockIdx.x - first; t < ntile; t += (int)gridDim.x - first) {
        const int k0 = (t % nk) << 6, n0 = (t / nk) << 8;
        float r[4][8];
#pragma unroll
        for (int c = 0; c < 4; ++c)
#pragma unroll
            for (int i = 0; i < 8; ++i) r[c][i] = __builtin_nontemporal_load(W + (size_t)(k0 + ty * 8 + i) * N + n0 + c * 64 + tx);
#pragma unroll
        for (int c = 0; c < 4; ++c) {
#pragma unroll
            for (int i = 0; i < 8; ++i) tile[(ty * 8 + i) * 65 + tx] = r[c][i];
            __syncthreads();
            float e[8];
#pragma unroll
            for (int i = 0; i < 8; ++i) e[i] = tile[(wk + i) * 65 + wn];
            u32x4 w; w.x = cvt_pk(e[0], e[1]); w.y = cvt_pk(e[2], e[3]); w.z = cvt_pk(e[4], e[5]); w.w = cvt_pk(e[6], e[7]);
            *(u32x4*)(Wt + (size_t)(n0 + c * 64 + wn) * K + k0 + wk) = w;
            __syncthreads();
        }
    }
}

struct EpiResAdd {
    static constexpr bool PERM = false, AFTER_DRAIN = false;
    float* H; int ldc; float* P; const float* x0; const float* meta0;
    DI void operator()(const f32x4 (&acc)[2][2][4][2], const pg8::Unit& u, int wr, int wc, int fr, int fq) const {
        const int row0 = u.pm * pg8::BM + wr * 64 + fr, col0 = u.pn * pg8::BM + wc * 32 + 4 * fq;
        if (u.nt != MIXW / 64) {
            float* pb = P + ((size_t)(u.kt0 >> 2) * 128 + (row0 - 16384)) * DM + col0;
#pragma unroll
            for (int m = 0; m < 4; ++m)
#pragma unroll
                for (int bj = 0; bj < 2; ++bj)
#pragma unroll
                    for (int n = 0; n < 2; ++n) *(f32x4*)(pb + (size_t)(m * 16) * DM + bj * pg8::HALF + n * 16) = acc[0][bj][m][n];
            return;
        }
#pragma unroll
        for (int ai = 0; ai < 2; ++ai)
#pragma unroll
            for (int m = 0; m < 4; ++m) { const int row = row0 + ai * pg8::HALF + m * 16; float* rowp = H + (size_t)row * ldc + col0;
                const float* srcp = rowp;
                if (x0) { const int b = row / LL, t = row - b * LL; srcp = (t < NMETA ? meta0 + (size_t)t * DM : x0 + ((size_t)b * 2048 + (t - NMETA)) * DM) + col0; }
#pragma unroll
                for (int bj = 0; bj < 2; ++bj)
#pragma unroll
                    for (int n = 0; n < 2; ++n) { *(f32x4*)(rowp + bj * pg8::HALF + n * 16) = *(const f32x4*)(srcp + bj * pg8::HALF + n * 16) + acc[ai][bj][m][n]; } }
    }
};

template <int NDV, int NK, bool WINM>
DI void attn_unit(LAS unsigned char* lds, const bf16_t* __restrict__ zb, const int ldz, const int qcol, const int kcol0, const int kcol1, const int vcol,
                  const int gcol, const int ocol, const float c2, const float sink2, const int t0, const int lo, const int nt,
                  bf16_t* __restrict__ mixb, const float lam, const float* __restrict__ normg, const float oscale, const int wave_s__) {
    constexpr int DV = NDV * 32, ROWB = DV * 2, KBY = 8192, VBY = 32 * ROWB, BUFB = NK * KBY + VBY, NI = (NK * KBY + VBY) / 1024, NPW = NI / 8;
    static_assert(3 * BUFB <= LDS_BYTES && NI % 8 == 0, "attention tile buffers");
    const int tid = ltid(wave_s__), wid = tid >> 6, lane = tid & 63, r32 = lane & 31, half = lane >> 5, j = wid >> 2, wq = wid & 3;
    const int tq = t0 + wq * 32 + r32;
    const float c1 = 0.08838834764831845f * LOG2E;
    bf16x8 qf[8];
    { const bf16_t* qp = zb + (size_t)tq * ldz + qcol + half * 8;
#pragma unroll
      for (int ks = 0; ks < 8; ++ks) qf[ks] = *(const bf16x8*)(qp + ks * 16); }
    f32x16 o[NDV];
#pragma unroll
    for (int n = 0; n < NDV; ++n) o[n] = zero16();
    float m = -1e30f, l = 0.f;
    unsigned soff[NPW]; int ddst[NPW];
#pragma unroll
    for (int e = 0; e < NPW; ++e) { const int qi = wid * NPW + e;
        if (qi < NK * 8) { const int mp = qi >> 3, r4 = qi & 7; const int row = 4 * r4 + (lane >> 4), slot = (lane & 15) ^ (row & 15);
            soff[e] = (unsigned)(row * ldz + (mp ? kcol1 : kcol0) + slot * 8) * 2u; ddst[e] = mp * KBY + r4 * 1024; }
        else { const int qv = qi - NK * 8; constexpr int SPR = DV / 8, RPI = 1024 / ROWB; const int row = qv * RPI + lane / SPR, ps = lane % SPR; const int ls = (((ps >> 2) ^ (row & 3)) << 2) | (ps & 3);
            soff[e] = (unsigned)(row * ldz + vcol + ls * 8) * 2u; ddst[e] = NK * KBY + qv * 1024; } }
#define ATT_DMA(tile_, buf_) do { const char* tb_ = (const char*)(zb + (size_t)(32 * (tile_)) * ldz); \
        _Pragma("unroll") for (int e = 0; e < NPW; ++e) __builtin_amdgcn_global_load_lds((const unsigned*)(tb_ + soff[e]), (LAS unsigned*)(lds + (buf_) * BUFB + ddst[e]), 16, 0, 0); } while (0)
#define ATT_BAR() do { asm volatile("" ::: "memory"); __builtin_amdgcn_s_barrier(); asm volatile("" ::: "memory"); } while (0)
    const int td = t0 >> 5, ndiag = (65 - td) < 4 ? (65 - td) : 4, nleft = td - lo;
#define ATT_TILE(it_) (WINM ? ((it_) == 0 ? 0 : lo + (it_) - 1) : ((it_) < ndiag ? td + (it_) : ((it_) < ndiag + nleft ? td - 1 - ((it_) - ndiag) : td + (it_) - nleft)))
    const int kbase = (NK == 2 ? j * KBY : 0) + r32 * 256 + ((((r32 & 15) ^ half) & 1) << 4) + ((r32 & 14) << 4);
    const int q4 = (lane >> 2) & 3, p4 = lane & 3, blk = (lane >> 4) & 1;
    int vb[4];
#pragma unroll
    for (int c = 0; c < 4; ++c) vb[c] = NK * KBY + (4 * half + q4) * ROWB + ((c ^ q4) << 6) + blk * 32 + 8 * p4;
    ATT_DMA(ATT_TILE(0), 0);
    asm volatile("s_waitcnt vmcnt(0)" ::: "memory");
    ATT_BAR();
    f32x16 st = zero16();
    u32x4 pk0, pk1; pk0.x = pk0.y = pk0.z = pk0.w = 0u; pk1 = pk0;
    bool pv_act = false;
    for (int ph = 0; ph < 2 * nt + 2; ++ph) {
        if (((ph + j) & 1) == 0) {
            const int idx = (ph - j) >> 1;
            if (idx >= 1 && pv_act) {
                const int bo = ((idx - 1) % 3) * BUFB;
                const bf16x8 pb0 = __builtin_bit_cast(bf16x8, pk0), pb1 = __builtin_bit_cast(bf16x8, pk1);
                bf16x8 av[3];
#define ATT_VLD1(k_, dst_) do { const int s2_ = (k_) / NDV, n_ = (k_) % NDV; LAS unsigned char* vp_ = lds + bo + vb[n_ & 3] + (n_ >> 2) * 256 + (16 * s2_) * ROWB; \
                        const s16x4 lo4_ = __builtin_amdgcn_ds_read_tr16_b64_v4i16((LAS s16x4*)vp_); const s16x4 hi4_ = __builtin_amdgcn_ds_read_tr16_b64_v4i16((LAS s16x4*)(vp_ + 8 * ROWB)); \
                        dst_ = __builtin_shufflevector(lo4_, hi4_, 0, 1, 2, 3, 4, 5, 6, 7); } while (0)
                ATT_VLD1(0, av[0]); ATT_VLD1(1, av[1]);
#pragma unroll
                for (int k = 0; k < 2 * NDV; ++k) {
                    if (k + 2 < 2 * NDV) ATT_VLD1(k + 2, av[(k + 2) % 3]);
                    __builtin_amdgcn_sched_barrier(0);
                    o[k % NDV] = MFMA32(av[k % 3], (k / NDV) ? pb1 : pb0, o[k % NDV]);
                    __builtin_amdgcn_sched_barrier(0);
                }
#undef ATT_VLD1
            }
            if (idx < nt) {
                const int ka = (idx % 3) * BUFB + kbase;
                st = zero16();
                bf16x8 ak[3];
                ak[0] = *(LAS bf16x8*)(lds + ka); ak[1] = *(LAS bf16x8*)(lds + (ka ^ 32));
#pragma unroll
                for (int ks = 0; ks < 8; ++ks) { if (ks + 2 < 8) ak[(ks + 2) % 3] = *(LAS bf16x8*)(lds + (ka ^ ((ks + 2) << 5)));
                    __builtin_amdgcn_sched_barrier(0);
                    st = MFMA32(ak[ks % 3], qf[ks], st);
                    __builtin_amdgcn_sched_barrier(0); }
            }
        } else {
            const int idx = (ph - j - 1) >> 1;
            { const int ti = idx + 1 + j; if (ti < nt) ATT_DMA(ATT_TILE(ti), ti % 3); }
            if (idx >= 0 && idx < nt) {
                const int key0 = 32 * ATT_TILE(idx);
                const float basef = (float)(tq - key0 - 4 * half);
                const bool tail = (key0 + 32 > LL);
                float x[16]; float mx = -INFINITY;
                if (WINM || tail) {
#pragma unroll
                    for (int i = 0; i < 16; ++i) { const int off = 8 * (i >> 2) + (i & 3); float d = fabsf(basef - (float)off); bool valid;
                        const int s = key0 + 4 * half + off;
                        if (WINM) { const bool meta = s < NMETA; valid = meta || (d <= 128.f && s < LL); d = meta ? fminf(d, 128.f) : d; }
                        else valid = (s < LL);
                        float xv = fmaf(st[i], c1, -c2 * d); xv = valid ? xv : -INFINITY; x[i] = xv; mx = fmaxf(mx, xv); }
                } else if (key0 + 31 < t0 + wq * 32 || key0 > t0 + wq * 32 + 31) {
                    const bool left = key0 + 31 < t0 + wq * 32; const float cs = left ? c2 : -c2, cbs = (left ? -c2 : c2) * basef;
#pragma unroll
                    for (int i = 0; i < 16; ++i) { const int off = 8 * (i >> 2) + (i & 3);
                        float kb = fmaf((float)off, cs, cbs); asm volatile("" : "+v"(kb)); float sv = st[i]; asm volatile("" : "+v"(sv));
                        float xv = fmaf(sv, c1, kb); asm volatile("" : "+v"(xv)); x[i] = xv; mx = fmaxf(mx, xv); }
                } else {
#pragma unroll
                    for (int i = 0; i < 16; ++i) { const int off = 8 * (i >> 2) + (i & 3); float d = basef - (float)off; asm volatile("" : "+v"(d)); float sv = st[i]; asm volatile("" : "+v"(sv));
                        float kb = -c2 * fabsf(d); asm volatile("" : "+v"(kb)); float xv = fmaf(sv, c1, kb); asm volatile("" : "+v"(xv)); x[i] = xv; mx = fmaxf(mx, xv); }
                }
                mx = xhalf_max(mx);
                pv_act = __any(mx > m - 40.f) != 0;
                if (pv_act) {
                    const bool need = mx > m + 8.f;
                    if (__any(need)) {
                        const float mn = need ? mx : m; const float al = ex2(m - mn);
                        l *= al;
#pragma unroll
                        for (int n = 0; n < NDV; ++n)
#pragma unroll
                            for (int i = 0; i < 16; ++i) o[n][i] *= al;
                        m = mn;
                    }
                    float ps = 0.f;
#pragma unroll
                    for (int i = 0; i < 16; ++i) { float dm = x[i] - m; asm volatile("" : "+v"(dm)); x[i] = ex2(dm); ps += x[i]; }
                    l += ps;
                    pk0.x = cvt_pk(x[0], x[1]); pk0.y = cvt_pk(x[2], x[3]); pk0.z = cvt_pk(x[4], x[5]); pk0.w = cvt_pk(x[6], x[7]);
                    pk1.x = cvt_pk(x[8], x[9]); pk1.y = cvt_pk(x[10], x[11]); pk1.z = cvt_pk(x[12], x[13]); pk1.w = cvt_pk(x[14], x[15]);
                }
            }
        }
        if (ph & 1) { asm volatile("s_waitcnt vmcnt(0)" ::: "memory"); ATT_BAR(); }
    }
    __syncthreads();
#undef ATT_DMA
#undef ATT_BAR
#undef ATT_TILE
    float lt = xhalf_sum(l);
    if (WINM) lt += ex2(sink2 - m);
    const float inv = 1.f / lt;
    const bool tval = tq < LL;
    if (WINM) {
        if (tval) { const bf16_t* gp = zb + (size_t)tq * ldz + gcol + 4 * half; bf16_t* op = mixb + (size_t)tq * MIXW + ocol + 4 * half;
#pragma unroll
            for (int n = 0; n < NDV; ++n)
#pragma unroll
                for (int g4 = 0; g4 < 4; ++g4) { const int dv = n * 32 + 8 * g4; const u32x2 gg = *(const u32x2*)(gp + dv);
                    u32x2 w; w.x = cvt_pk(o[n][4 * g4] * inv * siluf(bflo(gg.x)), o[n][4 * g4 + 1] * inv * siluf(bfhi(gg.x)));
                    w.y = cvt_pk(o[n][4 * g4 + 2] * inv * siluf(bflo(gg.y)), o[n][4 * g4 + 3] * inv * siluf(bfhi(gg.y)));
                    *(u32x2*)(op + dv) = w; } }
    } else {
        LAS float* xb = (LAS float*)lds + wq * (DV * 32) + 128 * half + r32;
        if (j == 1) { const float sc = inv * lam;
#pragma unroll
            for (int n = 0; n < NDV; ++n)
#pragma unroll
                for (int i = 0; i < 16; ++i) xb[(n * 32 + 8 * (i >> 2) + (i & 3)) * 32] = o[n][i] * sc; }
        __syncthreads();
        if (j == 0) { float ss = 0.f;
#pragma unroll
            for (int n = 0; n < NDV; ++n)
#pragma unroll
                for (int i = 0; i < 16; ++i) { const float v = o[n][i] * inv - xb[(n * 32 + 8 * (i >> 2) + (i & 3)) * 32]; o[n][i] = v; ss += v * v; }
            ss = xhalf_sum(ss);
            const float rstd = rsqrtf(ss * (1.f / DV) + 1e-6f) * oscale;
            const float* ngp = normg; asm volatile("" : "+s"(ngp)); ngp += 4 * half;
            if (tval) { const bf16_t* gp = zb + (size_t)tq * ldz + gcol + 4 * half; bf16_t* op = mixb + (size_t)tq * MIXW + ocol + 4 * half;
#pragma unroll
                for (int n = 0; n < NDV; ++n)
#pragma unroll
                    for (int g4 = 0; g4 < 4; ++g4) { const int dv = n * 32 + 8 * g4; const u32x2 gg = *(const u32x2*)(gp + dv); const f32x4 ng = *(const f32x4*)(ngp + dv);
                        u32x2 w; w.x = cvt_pk(o[n][4 * g4] * rstd * ng[0] * siluf(bflo(gg.x)), o[n][4 * g4 + 1] * rstd * ng[1] * siluf(bfhi(gg.x)));
                        w.y = cvt_pk(o[n][4 * g4 + 2] * rstd * ng[2] * siluf(bflo(gg.y)), o[n][4 * g4 + 3] * rstd * ng[3] * siluf(bfhi(gg.y)));
                        *(u32x2*)(op + dv) = w; } }
        }
        __syncthreads();
    }
}

DI void hgrn_seq(LAS unsigned char* lds, const bf16_t* __restrict__ zb, const int ldz, const int h, const int dir, const float lbv, bf16_t* __restrict__ dst, const int ldd, const int wave_s__) {
    constexpr int QC = 0, KH = 17408, KT = 34816, VT = 53248, SL = 71680, SC = 106496, TOT = 115712, E1 = 117760, GM = 118272;
    const int tid = ltid(wave_s__), wid = tid >> 6, lane = tid & 63, r32 = lane & 31, half = lane >> 5;
    const int k = tid & 127, tg = tid >> 7;
    const int fcol = dir ? 4096 : 2048;
    const int n = wid & 3, kt0 = 2 * (wid >> 2), ti = wid >> 2;
    LAS float* tot = (LAS float*)(lds + TOT); LAS float* e1p = (LAS float*)(lds + E1); LAS float* gmp = (LAS float*)(lds + GM);
    LAS float* e1l = e1p + kt0 * 32 + 4 * half; LAS float* gml = gmp + kt0 * 32 + 4 * half;
    f32x16 S[2]; S[0] = zero16(); S[1] = zero16();
    const float oml = 1.f - lbv;
    bf16_t rq[16], rf[16], rv[16];
#define HG_LOAD(c_) do { _Pragma("unroll") for (int e = 0; e < 16; ++e) { const int P_ = 64 * (c_) + tg * 16 + e; const int pp_ = dir ? 2111 - P_ : P_; const int t_ = pp_ - 48; const int tt_ = t_ < 0 ? 0 : t_; \
            const bf16_t* row_ = zb + (size_t)tt_ * ldz + h * 128 + k; rq[e] = row_[0]; rf[e] = row_[fcol]; rv[e] = row_[6144]; } } while (0)
    HG_LOAD(0);
    for (int c = 0; c < 33; ++c) {
        float qv[16], kk[16], bl[16]; unsigned vp[8]; float run = 0.f;
        {
            float vv[16];
#pragma unroll
            for (int e = 0; e < 16; ++e) {
                const int P = 64 * c + tg * 16 + e; const int pp = dir ? 2111 - P : P; const int t = pp - 48; const bool ok = t >= 0;
                const float q = bf2f(rq[e]), zf = bf2f(rf[e]), v = bf2f(rv[e]);
                const float ex = ex2(-zf * LOG2E), rden = rcpf(1.f + ex);
                const float lf = lg2((1.f + lbv * ex) * rden);
                run += ok ? lf : 0.f; bl[e] = run; qv[e] = ok ? q : 0.f; kk[e] = ok ? oml * ex * rden : 0.f; vv[e] = ok ? v : 0.f;
            }
#pragma unroll
            for (int e = 0; e < 8; ++e) vp[e] = cvt_pk(vv[2 * e], vv[2 * e + 1]);
        }
        tot[tg * 128 + k] = run;
        __syncthreads();
        {
            const float t0_ = tot[k], t1_ = tot[128 + k], t2_ = tot[256 + k], t3_ = tot[384 + k];
            const float off = (tg > 0 ? t0_ : 0.f) + (tg > 1 ? t1_ : 0.f) + (tg > 2 ? t2_ : 0.f);
            const float bmid = t0_ + t1_;
            if (tg == 0) { e1p[k] = ex2(bmid); gmp[k] = ex2(t2_ + t3_); }
            unsigned khp[8]; float khv[16];
#pragma unroll
            for (int e = 0; e < 16; ++e) { const float dq = off + bl[e] - bmid; const float qc = qv[e] * ex2(dq); khv[e] = kk[e] * ex2(-dq);
                const int i = tg * 16 + e;
                *(LAS bf16_t*)(lds + QC + i * 272 + k * 2) = (bf16_t)(cvt_pk(qc, qc) & 0xffffu);
                *(LAS bf16_t*)(lds + KH + i * 272 + k * 2) = (bf16_t)(cvt_pk(khv[e], khv[e]) & 0xffffu); }
#pragma unroll
            for (int e = 0; e < 8; ++e) khp[e] = cvt_pk(khv[2 * e], khv[2 * e + 1]);
            u32x4 w0, w1; w0.x = khp[0]; w0.y = khp[1]; w0.z = khp[2]; w0.w = khp[3]; w1.x = khp[4]; w1.y = khp[5]; w1.z = khp[6]; w1.w = khp[7];
            *(LAS u32x4*)(lds + KT + k * 144 + tg * 32) = w0; *(LAS u32x4*)(lds + KT + k * 144 + tg * 32 + 16) = w1;
            w0.x = vp[0]; w0.y = vp[1]; w0.z = vp[2]; w0.w = vp[3]; w1.x = vp[4]; w1.y = vp[5]; w1.z = vp[6]; w1.w = vp[7];
            *(LAS u32x4*)(lds + VT + k * 144 + tg * 32) = w0; *(LAS u32x4*)(lds + VT + k * 144 + tg * 32 + 16) = w1;
        }
        if (c + 1 < 33) HG_LOAD(c + 1);
        __syncthreads();
#pragma unroll
        for (int a = 0; a < 2; ++a) { const int kt = kt0 + a;
#pragma unroll
            for (int i = 0; i < 16; ++i) S[a][i] *= e1l[a * 32 + 8 * (i >> 2) + (i & 3)];
#pragma unroll
            for (int g4 = 0; g4 < 4; ++g4) { u32x2 w; w.x = cvt_pk(S[a][4 * g4], S[a][4 * g4 + 1]); w.y = cvt_pk(S[a][4 * g4 + 2], S[a][4 * g4 + 3]);
                *(LAS u32x2*)(lds + SL + (n * 32 + r32) * 272 + (kt * 32 + 8 * g4 + 4 * half) * 2) = w; } }
        if (wid < 4) { const int si = wid >> 1, tj = wid & 1;
            f32x16 acc = zero16();
            if (si <= tj) {
#pragma unroll
                for (int ks = 0; ks < 8; ++ks) { const bf16x8 a = *(LAS bf16x8*)(lds + KH + (si * 32 + r32) * 272 + ks * 32 + half * 16); const bf16x8 b = *(LAS bf16x8*)(lds + QC + (tj * 32 + r32) * 272 + ks * 32 + half * 16);
                    acc = MFMA32(a, b, acc); }
            }
            const int tt = tj * 32 + r32;
#pragma unroll
            for (int g4 = 0; g4 < 4; ++g4) { float v4[4];
#pragma unroll
                for (int q = 0; q < 4; ++q) { const int s = si * 32 + 8 * g4 + 4 * half + q; v4[q] = (s <= tt) ? acc[4 * g4 + q] : 0.f; }
                u32x2 w; w.x = cvt_pk(v4[0], v4[1]); w.y = cvt_pk(v4[2], v4[3]);
                *(LAS u32x2*)(lds + SC + tt * 144 + (si * 32 + 8 * g4 + 4 * half) * 2) = w; } }
        __syncthreads();
        { f32x16 acc = zero16();
#pragma unroll
          for (int ks = 0; ks < 8; ++ks) { const bf16x8 a = *(LAS bf16x8*)(lds + SL + (n * 32 + r32) * 272 + ks * 32 + half * 16); const bf16x8 b = *(LAS bf16x8*)(lds + QC + (ti * 32 + r32) * 272 + ks * 32 + half * 16);
              acc = MFMA32(a, b, acc); }
#pragma unroll
          for (int ss = 0; ss < 4; ++ss) { if (ss < 2 || ti == 1) { const bf16x8 a = *(LAS bf16x8*)(lds + VT + (n * 32 + r32) * 144 + ss * 32 + half * 16); const bf16x8 b = *(LAS bf16x8*)(lds + SC + (ti * 32 + r32) * 144 + ss * 32 + half * 16);
              acc = MFMA32(a, b, acc); } }
          const int P = 64 * c + ti * 32 + r32; const int pp = dir ? 2111 - P : P; const int t = pp - 48;
          if (t >= 0) { bf16_t* op = dst + (size_t)t * ldd + n * 32 + 4 * half;
#pragma unroll
              for (int g4 = 0; g4 < 4; ++g4) { u32x2 w; w.x = cvt_pk(acc[4 * g4], acc[4 * g4 + 1]); w.y = cvt_pk(acc[4 * g4 + 2], acc[4 * g4 + 3]); *(u32x2*)(op + 8 * g4) = w; } }
        }
#pragma unroll
        for (int a = 0; a < 2; ++a) { const int kt = kt0 + a;
#pragma unroll
            for (int ss = 0; ss < 4; ++ss) { const bf16x8 av = *(LAS bf16x8*)(lds + KT + (kt * 32 + r32) * 144 + ss * 32 + half * 16); const bf16x8 bv = *(LAS bf16x8*)(lds + VT + (n * 32 + r32) * 144 + ss * 32 + half * 16);
                S[a] = MFMA32(av, bv, S[a]); }
#pragma unroll
            for (int i = 0; i < 16; ++i) S[a][i] *= gml[a * 32 + 8 * (i >> 2) + (i & 3)]; }
    }
#undef HG_LOAD
    __syncthreads();
}

DI int xcd_unit(int i) { const int G = gridDim.x, c = blockIdx.x; return (G & 7) ? (i * G + c) : ((i * 8 + (c & 7)) * (G >> 3) + (c >> 3)); }


DI void fin_head(const Params& p, const int li, const int b, const int h, const int wave_s__) {
    const bf16_t* Z = (const bf16_t*)(p.ws + OFF_Z); bf16_t* MIX = (bf16_t*)(p.ws + OFF_MIX); const bf16_t* OF = (const bf16_t*)(p.ws + OFF_HN);
    const int lane = (int)__lane_id(), rr = lane >> 4, c8 = (lane & 15) * 8;
    const f32x4 g0 = *(const f32x4*)(p.hgrn_norm + li * 128 + c8), g1 = *(const f32x4*)(p.hgrn_norm + li * 128 + c8 + 4);
    for (int t0 = wave_s__ * 16; t0 < LL; t0 += 128) {
        u32x4 a[4], c[4], gt[4];
#pragma unroll
        for (int q = 0; q < 4; ++q) { const int t = t0 + q * 4 + rr; const size_t r = (size_t)b * LL + (t < LL ? t : LL - 1);
            a[q] = *(const u32x4*)(OF + r * DM + h * 128 + c8); c[q] = *(const u32x4*)(MIX + r * MIXW + h * 128 + c8); gt[q] = *(const u32x4*)(Z + r * EVEN_IN + 8192 + h * 128 + c8); }
#pragma unroll
        for (int q = 0; q < 4; ++q) { const int t = t0 + q * 4 + rr; float v[8]; float ss = 0.f;
#pragma unroll
            for (int w = 0; w < 4; ++w) { v[2 * w] = bflo(a[q][w]) + bflo(c[q][w]); v[2 * w + 1] = bfhi(a[q][w]) + bfhi(c[q][w]); ss += v[2 * w] * v[2 * w] + v[2 * w + 1] * v[2 * w + 1]; }
            ss += __shfl_xor(ss, 1); ss += __shfl_xor(ss, 2); ss += __shfl_xor(ss, 4); ss += __shfl_xor(ss, 8);
            const float rstd = rsqrtf(ss * (1.f / 128) + 1e-6f);
            u32x4 w4;
#pragma unroll
            for (int w = 0; w < 4; ++w) { const float ga = (w < 2) ? g0[2 * w] : g1[2 * w - 4], gb = (w < 2) ? g0[2 * w + 1] : g1[2 * w - 3];
                w4[w] = cvt_pk(v[2 * w] * rstd * ga * siluf(bflo(gt[q][w])), v[2 * w + 1] * rstd * gb * siluf(bfhi(gt[q][w]))); }
            if (t < LL) *(u32x4*)(MIX + ((size_t)b * LL + t) * MIXW + h * 128 + c8) = w4; }
    }
}

DI void mix_even(const Params& p, LAS unsigned char* lds, const int li, const int wave_s__) {
    const bf16_t* Z = (const bf16_t*)(p.ws + OFF_Z); bf16_t* MIX = (bf16_t*)(p.ws + OFF_MIX); bf16_t* HN = (bf16_t*)(p.ws + OFF_HN);
    const int k = ltid(wave_s__) & 127, wid = ltid(wave_s__) >> 6;
    for (int u = blockIdx.x; u < 256; u += gridDim.x) {
        const int b = u >> 5, h = (u >> 1) & 15, dir = u & 1;
        float lbv = 0.f;
        if (li == 1) { const float a0 = p.hgrn_lb[(size_t)(dir * 2 + 0) * 2048 + h * 128 + k], a1 = p.hgrn_lb[(size_t)(dir * 2 + 1) * 2048 + h * 128 + k]; lbv = 1.f / (1.f + __expf(a0 - a1)); }
        hgrn_seq(lds, Z + (size_t)b * LL * EVEN_IN, EVEN_IN, h, dir, lbv, dir ? (MIX + (size_t)b * LL * MIXW + h * 128) : (HN + (size_t)b * LL * DM + h * 128), dir ? MIXW : DM, wave_s__);
        unsigned* hf = (unsigned*)(p.ws + OFF_HFLAG) + li * 128 + b * 16 + h;
        if (wave_s__ == 0 && __lane_id() == 0) { __threadfence(); __hip_atomic_fetch_add(hf, 1u, __ATOMIC_RELEASE, __HIP_MEMORY_SCOPE_AGENT);
            if (dir) { while (__hip_atomic_load(hf, __ATOMIC_RELAXED, __HIP_MEMORY_SCOPE_AGENT) < 2u) __builtin_amdgcn_s_sleep(2);
                __builtin_amdgcn_fence(__ATOMIC_ACQUIRE, "agent"); } }
        if (dir) { __syncthreads(); fin_head(p, li, b, h, wave_s__); __syncthreads(); }
    }
    const int j = wid >> 2;
    for (int i = 0;; ++i) {
        const int u = xcd_unit(i); if (u >= 1088) break;
        const int qb = u % 17, r = u / 17, pair = r & 1, kvh = (r >> 1) & 3, b = r >> 3;
        const int hq = kvh * 4 + pair * 2 + j;
        const float slope = exp2f(-0.5f * (float)(hq + 1));
        const int t0 = qb * 128;
        const int lo = (t0 - 128) < 32 ? 1 : ((t0 - 128) >> 5);
        const int hi = ((t0 + 255) >> 5) > 64 ? 64 : ((t0 + 255) >> 5);
        attn_unit<4, 1, true>(lds, Z + (size_t)b * LL * EVEN_IN, EVEN_IN, 10240 + hq * 128, 12288 + kvh * 128, 0, 12800 + kvh * 128, 13312 + hq * 128, 2048 + hq * 128,
                              slope * LOG2E, p.sink[li * 16 + hq] * LOG2E, t0, lo, 2 + hi - lo, MIX + (size_t)b * LL * MIXW, 0.f, nullptr, 0.f, wave_s__);
    }
}

DI void fin_even(const Params& p, const int li, const int wave_s__) {
    const bf16_t* Z = (const bf16_t*)(p.ws + OFF_Z); bf16_t* MIX = (bf16_t*)(p.ws + OFF_MIX); const bf16_t* OF = (const bf16_t*)(p.ws + OFF_HN);
    const int wid = ltid(wave_s__) >> 6, lane = ltid(wave_s__) & 63;
    const float* ng = p.hgrn_norm + li * 128 + (lane & 3) * 32;
    for (int r = blockIdx.x * 8 + wid; r < MTOK; r += gridDim.x * 8) {
        const bf16_t* f = OF + (size_t)r * DM + lane * 32; bf16_t* mb = MIX + (size_t)r * MIXW + lane * 32; const bf16_t* gp = Z + (size_t)r * EVEN_IN + 8192 + lane * 32;
        float v[32]; float ss = 0.f;
#pragma unroll
        for (int q = 0; q < 4; ++q) { const u32x4 a = *(const u32x4*)(f + q * 8), c = *(const u32x4*)(mb + q * 8);
#pragma unroll
            for (int w = 0; w < 4; ++w) { v[q * 8 + 2 * w] = bflo(a[w]) + bflo(c[w]); v[q * 8 + 2 * w + 1] = bfhi(a[w]) + bfhi(c[w]); } }
#pragma unroll
        for (int e = 0; e < 32; ++e) ss += v[e] * v[e];
        ss += __shfl_xor(ss, 1); ss += __shfl_xor(ss, 2);
        const float rstd = rsqrtf(ss * (1.f / 128) + 1e-6f);
#pragma unroll
        for (int q = 0; q < 4; ++q) { const u32x4 g = *(const u32x4*)(gp + q * 8); u32x4 w;
#pragma unroll
            for (int w_ = 0; w_ < 4; ++w_) { const int e = q * 8 + 2 * w_;
                w[w_] = cvt_pk(v[e] * rstd * ng[e] * siluf(bflo(g[w_])), v[e + 1] * rstd * ng[e + 1] * siluf(bfhi(g[w_]))); }
            *(u32x4*)(mb + q * 8) = w; }
    }
}


DI void qk_norm_pass(const Params& p, const int li, const int wave_s__) {
    const bf16_t* Z = (const bf16_t*)(p.ws + OFF_Z); unsigned* nrm = (unsigned*)(p.ws + OFF_NRM) + li * 512;
    const int lane = (int)__lane_id();
    const int gw = blockIdx.x * 8 + wave_s__, nw = gridDim.x * 8;
    const int per = (MTOK + nw - 1) / nw; const int r0 = gw * per, r1 = (r0 + per) < MTOK ? (r0 + per) : MTOK;
    float mxv[16]; int curb = -1;
#pragma unroll
    for (int jx = 0; jx < 16; ++jx) mxv[jx] = 0.f;
    for (int r = r0; r < r1; ++r) {
        const int b = r / LL;
        if (b != curb) { if (curb >= 0) {
#pragma unroll
                for (int jx = 0; jx < 16; ++jx) { if ((lane & 15) == 0) atomicMax(nrm + curb * 64 + jx * 4 + (lane >> 4), __float_as_uint(mxv[jx])); mxv[jx] = 0.f; } }
            curb = b; }
        const bf16_t* row = Z + (size_t)r * ODD_LD;
#pragma unroll
        for (int jx = 0; jx < 16; ++jx) { const u32x4 v = *(const u32x4*)(row + (jx * 64 + lane) * 8); float ss = 0.f;
#pragma unroll
            for (int w = 0; w < 4; ++w) { const float a = bflo(v[w]), c = bfhi(v[w]); ss += a * a + c * c; }
            ss += __shfl_xor(ss, 1); ss += __shfl_xor(ss, 2); ss += __shfl_xor(ss, 4); ss += __shfl_xor(ss, 8);
            mxv[jx] = fmaxf(mxv[jx], ss); }
    }
    if (curb >= 0) {
#pragma unroll
        for (int jx = 0; jx < 16; ++jx) if ((lane & 15) == 0) atomicMax(nrm + curb * 64 + jx * 4 + (lane >> 4), __float_as_uint(mxv[jx]));
    }
}

DI void mix_odd(const Params& p, LAS unsigned char* lds, const int li, const int layer, const int wave_s__) {
    const bf16_t* Z = (const bf16_t*)(p.ws + OFF_Z); bf16_t* MIX = (bf16_t*)(p.ws + OFF_MIX);
    const int lane = ltid(wave_s__) & 63, wid = ltid(wave_s__) >> 6, j = wid >> 2;
    const float lam_init = 0.8f - 0.6f * expf(-0.3f * (float)layer);
    const float lam = ((const float*)(p.ws + OFF_MISC))[li];
    unsigned* qctr = (unsigned*)(p.ws + OFF_QCTR) + li * 8;
    volatile LAS unsigned* qw = (volatile LAS unsigned*)(lds + 131072);
    for (int sq = 0; sq < 8; ++sq) {
      const int b = ((int)blockIdx.x + sq) & 7;
      for (;;) {
        if (wid == 0 && lane == 0) qw[0] = atomicAdd(qctr + b, 1u);
        __syncthreads();
        const unsigned uq = qw[0];
        __syncthreads();
        if (uq >= 272u) break;
        const int h = 15 - (int)(uq / 17u), qb = (int)(uq % 17u);
        const float slope = exp2f(-0.5f * (float)(h + 1));
        const unsigned* nr = (const unsigned*)(p.ws + OFF_NRM) + li * 512 + b * 64;
        const float q0 = __uint_as_float(nr[h * 2]), q1 = __uint_as_float(nr[h * 2 + 1]), k0 = __uint_as_float(nr[32 + h * 2]), k1 = __uint_as_float(nr[32 + h * 2 + 1]);
        const float Bq = sqrtf(fmaxf(q0 * k0, q1 * k1)) * (0.08838834764831845f * LOG2E * 1.001f);
        const float Dmin = (40.f + 2.f * Bq) / (slope * LOG2E);
        const int t0 = qb * 128;
        int first = (int)floorf(((float)(t0 - 31) - Dmin) * (1.f / 32.f)) + 1; first = first < 0 ? 0 : first;
        int last = (int)ceilf(((float)(t0 + 127) + Dmin) * (1.f / 32.f)) - 1; last = last > 64 ? 64 : last;
        attn_unit<8, 2, false>(lds, Z + (size_t)b * LL * ODD_LD, ODD_LD, h * 256 + j * 128, 4096 + h * 256, 4096 + h * 256 + 128, 8192 + h * 256, 12288 + h * 256, h * 256,
                               slope * LOG2E, 0.f, t0, first, last - first + 1, MIX + (size_t)b * LL * MIXW, lam, p.dnorm + li * 256, 1.f - lam_init, wave_s__);
      }
    }
}


struct G2Order : pg8::StaticOrder {
    __device__ bool next(int i, pg8::Unit& u) const {
        const long L = (long)i * G + c;
        if (L < nwg) return pg8::StaticOrder::next(i, u);
        const int jx = (int)(L - nwg); if (jx >= 128) return false;
        u.pm = 64; u.pn = jx & 7; u.kt0 = (jx >> 3) * 4; u.nt = 4; return true;
    }
};
template <bool EVEN>
DI void run_g1(const Params& p, LAS unsigned char* lds, const int layer, const int wave_s__) {
    constexpr int nin = EVEN ? EVEN_IN : ODD_IN;
    pg8::Gemm g; g.A = (const bf16_t*)(p.ws + OFF_HN); g.Bt = (const bf16_t*)(p.ws + ((layer & 1) ? OFF_WIN2 : OFF_WIN)); g.M = MPAD; g.N = nin; g.K = DM;
    pg8::StaticOrder S; S.init(MPAD, nin, (int)gridDim.x, (int)blockIdx.x, DM);
    pg8::EpiBf16<0> E; E.O = (bf16_t*)(p.ws + OFF_Z); E.ldc = EVEN ? EVEN_IN : ODD_LD; E.bias = nullptr; E.split_cols = 0; E.split_stride = 0;
    pg8::gemm_phase<pg8::EpiBf16<0>, pg8::StaticOrder, false>(lds, g, S, E, nullptr, wave_s__);
    const int rem = ((MPAD / 256) * (nin / 256)) % (int)gridDim.x; const int first = (rem == 0 || 2 * rem > (int)gridDim.x) ? 0 : rem;
    const int li = layer >> 1;
    convert_T(lds, (EVEN ? p.w_out_a : p.w_out_c) + (size_t)li * MIXW * DM, (bf16_t*)(p.ws + OFF_WOUT), MIXW, DM, wave_s__, first);
    if (layer < 3) { bf16_t* wn = (bf16_t*)(p.ws + (((layer + 1) & 1) ? OFF_WIN2 : OFF_WIN));
        if (EVEN) convert_T(lds, p.w_in_c + (size_t)li * DM * ODD_IN, wn, DM, ODD_IN, wave_s__, first);
        else convert_T(lds, p.w_in_a + (size_t)(li + 1) * DM * EVEN_IN, wn, DM, EVEN_IN, wave_s__, first); }
}
DI void run_g2(const Params& p, LAS unsigned char* lds, const int layer, const int wave_s__) {
    pg8::Gemm g; g.A = (const bf16_t*)(p.ws + OFF_MIX); g.Bt = (const bf16_t*)(p.ws + OFF_WOUT); g.M = MPAD; g.N = DM; g.K = MIXW;
    G2Order S; S.init(16384, DM, (int)gridDim.x, (int)blockIdx.x, MIXW);
    EpiResAdd E; E.H = (float*)(p.ws + OFF_H); E.ldc = DM; E.P = (float*)(p.ws + OFF_PART); E.x0 = layer == 0 ? p.x : nullptr; E.meta0 = p.meta;
    pg8::gemm_phase<EpiResAdd, G2Order, false>(lds, g, S, E, nullptr, wave_s__);
}

#define PH_IN(k) (lo <= (k) && (k) < hi)
DI void grid_bar(unsigned* base, const unsigned epoch, const int wave_s__) {
    __syncthreads();
    if (wave_s__ == 0 && __lane_id() == 0) {
        const unsigned G = gridDim.x, x = blockIdx.x & 7u;
        const unsigned gsize = (G - x + 7u) >> 3, ngroups = G < 8u ? G : 8u;
        const unsigned old = __hip_atomic_fetch_add(base + 32u * (1u + x), 1u, __ATOMIC_ACQ_REL, __HIP_MEMORY_SCOPE_AGENT);
        if (old + 1u == gsize * epoch) __hip_atomic_fetch_add(base, 1u, __ATOMIC_ACQ_REL, __HIP_MEMORY_SCOPE_AGENT);
        while (__hip_atomic_load(base, __ATOMIC_RELAXED, __HIP_MEMORY_SCOPE_AGENT) < ngroups * epoch) __builtin_amdgcn_s_sleep(1);
        __builtin_amdgcn_fence(__ATOMIC_ACQUIRE, "agent");
    }
    __syncthreads();
}
#define PH_SYNC(k) do { if (PH_IN(k) && PH_IN((k) + 1)) { nbar += 1u; grid_bar(barcnt, nbar, wave_s__); } } while (0)
DI void layer_pair(const Params& p, LAS unsigned char* lds, unsigned* barcnt, unsigned& nbar, const int lo, const int hi, const int pr, const int wave_s__) {
    bf16_t* WIN = (bf16_t*)(p.ws + OFF_WIN); bf16_t* WOUT = (bf16_t*)(p.ws + OFF_WOUT);

        const int k0 = 1 + 9 * pr;
        if (PH_IN(k0 + 0)) run_g1<true>(p, lds, 2 * pr, wave_s__);
        PH_SYNC(k0 + 0);
        if (PH_IN(k0 + 1)) {
#pragma unroll 1
            for (int rep = 0; rep <= p.dup_e; ++rep) { mix_even(p, lds, pr, wave_s__); __syncthreads(); }

}
        PH_SYNC(k0 + 1);
        if (PH_IN(k0 + 3)) run_g2(p, lds, 2 * pr, wave_s__);
        PH_SYNC(k0 + 3);
        if (PH_IN(k0 + 4)) row_phase<1>(p, p.norm_c + (size_t)pr * DM, wave_s__);
        PH_SYNC(k0 + 4);
        if (PH_IN(k0 + 5)) run_g1<false>(p, lds, 2 * pr + 1, wave_s__);
        PH_SYNC(k0 + 5);
        if (PH_IN(k0 + 6)) {
            qk_norm_pass(p, pr, wave_s__);
            nbar += 1u; grid_bar(barcnt, nbar, wave_s__);
#pragma unroll 1
            for (int rep = 0; rep <= p.dup_o; ++rep) { mix_odd(p, lds, pr, 2 * pr + 1, wave_s__); __syncthreads(); }

}
        PH_SYNC(k0 + 6);
        if (PH_IN(k0 + 7)) run_g2(p, lds, 2 * pr + 1, wave_s__);
        PH_SYNC(k0 + 7);
        if (PH_IN(k0 + 8)) { if (pr == 1) row_phase<2>(p, p.fnorm, wave_s__); else row_phase<1>(p, p.norm_a + (size_t)DM, wave_s__); }
        PH_SYNC(k0 + 8);
}

__global__ void __launch_bounds__(512, 2) mega(Params p) {
    extern __shared__ __attribute__((aligned(16))) unsigned char lds_raw[];
    LAS unsigned char* lds = (LAS unsigned char*)lds_raw;
    cg::grid_group grid = cg::this_grid();
    const int lo = p.ph_lo, hi = p.ph_hi;
    const int wave_s__ = __builtin_amdgcn_readfirstlane((int)threadIdx.x >> 6);
    bf16_t* WIN = (bf16_t*)(p.ws + OFF_WIN); bf16_t* WOUT = (bf16_t*)(p.ws + OFF_WOUT);
    if (PH_IN(0)) {
        if (blockIdx.x == 0) { unsigned* cw = (unsigned*)(p.ws + OFF_MISC + 256); for (int i = ltid(wave_s__); i < (8192 - 256) / 4; i += 512) cw[i] = 0u; }
        if (blockIdx.x == 0 && wave_s__ < 2) {
            const int lane = (int)__lane_id(); const float* lv = p.dlam + wave_s__ * 512;
            const float d1 = wave_sum(lv[lane] * lv[128 + lane] + lv[64 + lane] * lv[192 + lane]);
            const float d2 = wave_sum(lv[256 + lane] * lv[384 + lane] + lv[320 + lane] * lv[448 + lane]);
            const float lam_init = 0.8f - 0.6f * expf(-0.3f * (float)(2 * wave_s__ + 1));
            if (lane == 0) ((float*)(p.ws + OFF_MISC))[wave_s__] = expf(d1) - expf(d2) + lam_init;
        }
        row_phase<0>(p, p.norm_a, wave_s__); convert_T(lds, p.w_in_a, WIN, DM, EVEN_IN, wave_s__); }
    unsigned* barcnt = (unsigned*)(p.ws + OFF_MISC + 5632); unsigned nbar = 0u;
    if (PH_IN(0) && PH_IN(1)) grid.sync();
    layer_pair(p, lds, barcnt, nbar, lo, hi, 0, wave_s__);
    layer_pair(p, lds, barcnt, nbar, lo, hi, 1, wave_s__);
}

constexpr int N_PHASES = 19;

extern "C" void kernel_launch(void* const* d_in, const int* in_sizes, int n_in, void* d_out, int out_size, void* d_ws, size_t ws_size, hipStream_t stream) {
    static int grid = 0;
    if (grid == 0) {
        if (n_in != 14 || ws_size < WS_END) { fprintf(stderr, "kernel_launch: need 14 inputs and %zu bytes of workspace; got %d, %zu\n", (size_t)WS_END, n_in, ws_size); grid = -1; return; }
        int dev = 0, cus = 0, per_cu = 0;
        hipGetDevice(&dev); hipDeviceGetAttribute(&cus, hipDeviceAttributeMultiprocessorCount, dev);
        if (hipFuncSetAttribute((const void*)mega, hipFuncAttributeMaxDynamicSharedMemorySize, LDS_BYTES) != hipSuccess) { fprintf(stderr, "kernel_launch: hipFuncSetAttribute failed\n"); grid = -1; return; }
        if (hipOccupancyMaxActiveBlocksPerMultiprocessor(&per_cu, (const void*)mega, 512, LDS_BYTES) != hipSuccess || per_cu < 1) { fprintf(stderr, "kernel_launch: occupancy query says %d\n", per_cu); per_cu = 1; }
        (void)hipGetLastError();
        grid = cus * 1;
    }
    if (grid < 0) return;
    Params p{};
    p.x = (const float*)d_in[0]; p.meta = (const float*)d_in[1]; p.norm_a = (const float*)d_in[2]; p.w_in_a = (const float*)d_in[3]; p.w_out_a = (const float*)d_in[4];
    p.hgrn_lb = (const float*)d_in[5]; p.hgrn_norm = (const float*)d_in[6]; p.sink = (const float*)d_in[7]; p.norm_c = (const float*)d_in[8]; p.w_in_c = (const float*)d_in[9];
    p.w_out_c = (const float*)d_in[10]; p.dlam = (const float*)d_in[11]; p.dnorm = (const float*)d_in[12]; p.fnorm = (const float*)d_in[13];
    p.out = (float*)d_out; p.ws = (unsigned char*)d_ws; p.ph_lo = 0; p.ph_hi = N_PHASES;
#ifdef DUP_ODD
    p.dup_o = 1;
#endif
#ifdef DUP_EVEN
    p.dup_e = 1;
#endif
    void* args[] = {&p};
    hipError_t e = hipLaunchCooperativeKernel((const void*)mega, dim3(grid), dim3(512), args, LDS_BYTES, stream);
    if (e != hipSuccess) fprintf(stderr, "kernel_launch: cooperative launch failed: %s (grid %d)\n", hipGetErrorString(e), grid);
}
```

```cpp
#include <hip/hip_runtime.h>
#include <hip/hip_cooperative_groups.h>
#include <cstdio>
namespace cg = cooperative_groups;
__device__ __forceinline__ int ltid(int wave_s__) { int t = wave_s__ * 64 + (int)__lane_id(); asm volatile("" : "+v"(t)); return t; }
namespace pg8 {
#define PG8_LAS __attribute__((address_space(3)))
typedef unsigned short bf16_t;
typedef short bf16x8 __attribute__((ext_vector_type(8)));
typedef float f32x4 __attribute__((ext_vector_type(4)));
typedef unsigned u32x4 __attribute__((ext_vector_type(4)));
constexpr int BM = 256, BK = 64, HALF = 128, HTB = HALF * BK * 2  , STAGE_BYTES = 8 * HTB, NXCD = 8, WGM = 4;

__host__ __device__ __forceinline__ int lds_byte(int r, int c) { const int st = (r >> 4) * 2 + (c >> 5), rr = r & 15, cc = c & 31, ob = rr * 64 + cc * 2; return st * 1024 + (ob ^ (((ob >> 9) & 1) << 5)); }
__host__ __device__ __forceinline__ void stage_rc(int b, int& R, int& C) { const int st = b / 1024, sb = b % 1024, swz = sb ^ (((sb >> 9) & 1) << 5); R = (st >> 1) * 16 + swz / 64; C = (st & 1) * 32 + (swz % 64) / 2; }
__host__ __device__ __forceinline__ int perm32(int rho) { const int n = rho >> 4, i = rho & 15; return 8 * (i >> 2) + 4 * n + (i & 3); }

struct Unit { int pm, pn, kt0, nt; };
struct Gemm { const bf16_t* A; const bf16_t* Bt; int M, N, K; };

struct StaticOrder {
    int nM, nN, nwg, G, c, KT;
    __host__ __device__ void init(int M, int N, int G_, int c_, int K_ = 0) { nM = M / BM; nN = N / BM; nwg = nM * nN; G = G_; c = c_; KT = K_ / BK; }
    __host__ __device__ bool next(int i, Unit& u) const {
        const long L = (long)i * G + c; if (L >= nwg) return false;
        int wgid = (int)L; { const int q = nwg / NXCD, r = nwg % NXCD, xcd = wgid % NXCD, off = wgid / NXCD; wgid = (xcd < r ? xcd * (q + 1) : r * (q + 1) + (xcd - r) * q) + off; }
        const int nig = WGM * nN, gid = wgid / nig, fm = gid * WGM, gsz = (nM - fm) < WGM ? (nM - fm) : WGM;
        u.pm = fm + ((wgid % nig) % gsz); u.pn = (wgid % nig) / gsz; u.kt0 = 0; u.nt = KT; return true;
    }
    __device__ __forceinline__ void a_ready(const Unit&) const {}
    __device__ __forceinline__ void done(const Unit&) const {}
};
struct CountedOrder : StaticOrder {
    const unsigned* ready; unsigned need; unsigned* tmo;
    __device__ __forceinline__ void a_ready(const Unit& u) const {
        if ((int)threadIdx.x < 64) {
            const unsigned long long t0 = __builtin_amdgcn_s_memrealtime(); unsigned polls = 0;
            while ((unsigned)__builtin_amdgcn_readfirstlane(__hip_atomic_load(ready + 64 * u.pm, __ATOMIC_RELAXED, __HIP_MEMORY_SCOPE_AGENT)) < need) {
                if ((++polls & 255u) == 0u && __builtin_amdgcn_readfirstlane(__hip_atomic_load(tmo, __ATOMIC_RELAXED, __HIP_MEMORY_SCOPE_AGENT)) != 0u) break;
                if (__builtin_amdgcn_s_memrealtime() - t0 > 2000000ull) {
                    if ((int)threadIdx.x == 0) { unsigned expect = 0u; __hip_atomic_compare_exchange_strong(tmo + 1, &expect, 0x600u | (unsigned)(u.pm & 0xff), __ATOMIC_RELAXED, __ATOMIC_RELAXED, __HIP_MEMORY_SCOPE_AGENT); __hip_atomic_store(tmo, 1u, __ATOMIC_RELAXED, __HIP_MEMORY_SCOPE_AGENT); }
                    break; }
                __builtin_amdgcn_s_sleep(2); }
            __builtin_amdgcn_fence(__ATOMIC_ACQUIRE, "agent");
            asm volatile("s_waitcnt vmcnt(0)" ::: "memory");
        }
#if !defined(BROKEN_HOOK_NO_BARRIER)
        asm volatile("" ::: "memory"); __builtin_amdgcn_s_barrier(); asm volatile("" ::: "memory");
#endif
    }
};

__device__ __forceinline__ unsigned cvt_pk_bf16(float lo, float hi) { unsigned r; asm volatile("v_cvt_pk_bf16_f32 %0, %1, %2" : "=v"(r) : "v"(lo), "v"(hi)); return r; }
typedef float f32x2 __attribute__((ext_vector_type(2)));
__device__ __forceinline__ f32x2 gelu_pk(f32x2 v) {
    const f32x2 av = __builtin_elementwise_abs(v), d = av * 0.2316418882f + 1.0f;
    f32x2 t; t.x = __builtin_amdgcn_rcpf(d.x); t.y = __builtin_amdgcn_rcpf(d.y);
    f32x2 q = t * 0.5307027145f + (-0.7265760135f); q = q * t + 0.7107068705f; q = q * t + (-0.142248368f); q = q * t + 0.127414796f; q = q * t;
    const f32x2 s = (v * v) * (-0.72134752044f);
    f32x2 e; e.x = __builtin_amdgcn_exp2f(s.x); e.y = __builtin_amdgcn_exp2f(s.y);
    const f32x2 m = v * (q * e), r = v - m;
    f32x2 o; o.x = v.x < 0.f ? m.x : r.x; o.y = v.y < 0.f ? m.y : r.y; return o;
}

struct EpiF32 {
    static constexpr bool PERM = false, AFTER_DRAIN = false;
    float* C; int ldc; const float* bias;
    __device__ __forceinline__ void operator()(const f32x4 (&acc)[2][2][4][2], const Unit& u, int wr, int wc, int fr, int fq) const {
        const int row0 = u.pm * BM + wr * 64 + fr, col0 = u.pn * BM + wc * 32 + 4 * fq;
        f32x4 bv[2][2];
#pragma unroll
        for (int bj = 0; bj < 2; ++bj)
#pragma unroll
            for (int n = 0; n < 2; ++n) bv[bj][n] = bias ? *(const f32x4*)(bias + col0 + bj * HALF + n * 16) : (f32x4){0.f, 0.f, 0.f, 0.f};
#pragma unroll
        for (int ai = 0; ai < 2; ++ai)
#pragma unroll
            for (int m = 0; m < 4; ++m) { float* rowp = C + (size_t)(row0 + ai * HALF + m * 16) * ldc + col0;
#pragma unroll
                for (int bj = 0; bj < 2; ++bj)
#pragma unroll
                    for (int n = 0; n < 2; ++n) *(f32x4*)(rowp + bj * HALF + n * 16) = acc[ai][bj][m][n] + bv[bj][n]; }
    }
};
template <int ACT  > struct EpiBf16 {
    static constexpr bool PERM = true, AFTER_DRAIN = false;
    bf16_t* O; int ldc; const float* bias; int split_cols; size_t split_stride;
    __device__ __forceinline__ void operator()(const f32x4 (&acc)[2][2][4][2], const Unit& u, int wr, int wc, int fr, int fq) const {
        const int row0 = u.pm * BM + wr * 64 + fr; int colt = u.pn * BM; bf16_t* base = O;
        if (split_cols) { const int t = colt / split_cols; base += (size_t)t * split_stride; colt -= t * split_cols; }
        const int col0 = colt + wc * 32 + 8 * fq, bcol0 = u.pn * BM + wc * 32 + 8 * fq;
        f32x4 bv[2][2];
#pragma unroll
        for (int bj = 0; bj < 2; ++bj)
#pragma unroll
            for (int n = 0; n < 2; ++n) bv[bj][n] = bias ? *(const f32x4*)(bias + bcol0 + bj * HALF + 4 * n) : (f32x4){0.f, 0.f, 0.f, 0.f};
#pragma unroll
        for (int ai = 0; ai < 2; ++ai)
#pragma unroll
            for (int m = 0; m < 4; ++m) { bf16_t* rowp = base + (size_t)(row0 + ai * HALF + m * 16) * ldc + col0;
#pragma unroll
                for (int bj = 0; bj < 2; ++bj) { f32x4 v0 = acc[ai][bj][m][0] + bv[bj][0], v1 = acc[ai][bj][m][1] + bv[bj][1];
                    if (ACT == 1) { f32x2 a = gelu_pk((f32x2){v0[0], v0[1]}), b = gelu_pk((f32x2){v0[2], v0[3]}), c = gelu_pk((f32x2){v1[0], v1[1]}), d = gelu_pk((f32x2){v1[2], v1[3]});
                        v0 = (f32x4){a.x, a.y, b.x, b.y}; v1 = (f32x4){c.x, c.y, d.x, d.y}; }
                    if (ACT == 2) {
#pragma unroll
                        for (int j = 0; j < 4; ++j) { v0[j] = 0.5f * v0[j] * (1.0f + erff(v0[j] * 0.70710678f)); v1[j] = 0.5f * v1[j] * (1.0f + erff(v1[j] * 0.70710678f)); } }
                    u32x4 w; w.x = cvt_pk_bf16(v0[0], v0[1]); w.y = cvt_pk_bf16(v0[2], v0[3]); w.z = cvt_pk_bf16(v1[0], v1[1]); w.w = cvt_pk_bf16(v1[2], v1[3]);
                    *(u32x4*)(rowp + bj * HALF) = w; } }
    }
};

template <class Epi, class Sched, bool STAMP = false>
__device__ __forceinline__ void gemm_phase(PG8_LAS unsigned char* lds, const Gemm g, const Sched& S, const Epi& E, unsigned long long* stamps, const int wave_s__) {
    const int tid = ltid(wave_s__), wid = __builtin_amdgcn_readfirstlane(tid >> 6), lane = tid & 63, wr = wid >> 2, wc = wid & 3, fr = lane & 15, fq = lane >> 4;
    const int K = g.K; int nt;
    int ts_lo = 0, ts_hi = 0, nts = 0; const unsigned long long rt_entry = STAMP ? (unsigned long long)wall_clock64() : 0ull;
#define PG8_STAMP() do { if (STAMP && wid == 0 && nts < 64) { const unsigned long long _c = (unsigned long long)clock64(); \
        ts_lo = (lane == nts) ? (int)(unsigned)_c : ts_lo; ts_hi = (lane == nts) ? (int)(unsigned)(_c >> 32) : ts_hi; ++nts; } } while (0)
    PG8_STAMP();
    unsigned voffA[2], voffB[2];
#pragma unroll
    for (int i = 0; i < 2; ++i) { int R, C; stage_rc(tid * 16 + i * 8192, R, C); const int Rb = Epi::PERM ? ((R & ~31) + perm32(R & 31)) : R;
        voffA[i] = (unsigned)(R * K + C) * 2u; voffB[i] = (unsigned)(Rb * K + C) * 2u; }
    const size_t kstep = (size_t)(BK * 2);
    const size_t hstep = (size_t)HALF * K * 2;
    const size_t tstep = 2 * hstep;
    const unsigned ldsw = (unsigned)wid * 1024u;
    const int aoff = lds_byte(wr * 64 + fr, fq * 8), boff = lds_byte(wc * 32 + fr, fq * 8);
#define PG8_SA(b, h) (((b) * 2 + (h)) * HTB)
#define PG8_SB(b, h) ((4 + (b) * 2 + (h)) * HTB)
#define PG8_STAGE(bufoff, gbase, voff) do { _Pragma("unroll") for (int _i = 0; _i < 2; ++_i) \
        __builtin_amdgcn_global_load_lds((const unsigned*)((const char*)(gbase) + (voff)[_i]), (PG8_LAS unsigned*)(lds + (bufoff) + ldsw + _i * 8192), 16, 0, 0); } while (0)
#define PG8_LDA(dst, b, h) do { _Pragma("unroll") for (int m = 0; m < 4; ++m) _Pragma("unroll") for (int k = 0; k < 2; ++k) dst[m][k] = *(const PG8_LAS bf16x8*)(lds + PG8_SA(b, h) + aoff + m * 2048 + k * 1024); } while (0)
#define PG8_LDB(dst, b, h) do { _Pragma("unroll") for (int n = 0; n < 2; ++n) _Pragma("unroll") for (int k = 0; k < 2; ++k) dst[n][k] = *(const PG8_LAS bf16x8*)(lds + PG8_SB(b, h) + boff + n * 2048 + k * 1024); } while (0)
#define PG8_MMA(ai, bj, At, Bt) do { __builtin_amdgcn_s_setprio(1); _Pragma("unroll") for (int m = 0; m < 4; ++m) _Pragma("unroll") for (int n = 0; n < 2; ++n) _Pragma("unroll") for (int k = 0; k < 2; ++k) \
        acc[ai][bj][m][n] = __builtin_amdgcn_mfma_f32_16x16x32_bf16(Bt[n][k], At[m][k], acc[ai][bj][m][n], 0, 0, 0); __builtin_amdgcn_s_setprio(0); } while (0)
#define PG8_WAIT_V(n) asm volatile("s_waitcnt vmcnt(" #n ")" ::: "memory")
#define PG8_WAIT_L(n) asm volatile("s_waitcnt lgkmcnt(" #n ")" ::: "memory")
#define PG8_BAR __builtin_amdgcn_s_barrier()
#define PG8_SCHED __builtin_amdgcn_sched_barrier(0)
    Unit cur, nxt; int ui = 0;
    if (!S.next(0, cur)) return;
    f32x4 acc[2][2][4][2];
#pragma unroll
    for (int a = 0; a < 2; ++a)
#pragma unroll
        for (int b = 0; b < 2; ++b)
#pragma unroll
            for (int m = 0; m < 4; ++m)
#pragma unroll
                for (int n = 0; n < 2; ++n) acc[a][b][m][n] = (f32x4){0.f, 0.f, 0.f, 0.f};
    bf16x8 At[4][2], B0[2][2], B1[2][2];
    nt = cur.nt;
    const char* cA = (const char*)g.A + (size_t)cur.pm * tstep + (size_t)cur.kt0 * kstep; const char* cB = (const char*)g.Bt + (size_t)cur.pn * tstep + (size_t)cur.kt0 * kstep;
    S.a_ready(cur);
    PG8_STAGE(PG8_SB(0, 0), cB, voffB); PG8_STAGE(PG8_SA(0, 0), cA, voffA); PG8_STAGE(PG8_SB(0, 1), cB + hstep, voffB); PG8_STAGE(PG8_SA(0, 1), cA + hstep, voffA);
    if (wr == 1) PG8_BAR;
    PG8_WAIT_V(4); PG8_BAR;
    PG8_STAGE(PG8_SB(1, 0), cB + kstep, voffB); PG8_STAGE(PG8_SA(1, 0), cA + kstep, voffA); PG8_STAGE(PG8_SB(1, 1), cB + hstep + kstep, voffB);
    PG8_WAIT_V(6); PG8_BAR;
    PG8_STAMP();
    for (;;) {
        const bool has_next = S.next(ui + 1, nxt);
        const char* nA = has_next ? (const char*)g.A + (size_t)nxt.pm * tstep + (size_t)nxt.kt0 * kstep : cA; const char* nB = has_next ? (const char*)g.Bt + (size_t)nxt.pn * tstep + (size_t)nxt.kt0 * kstep : cB;
        for (int t = 0; t < nt; t += 2) {
            const bool last = (t == nt - 2);
            const char* a1 = cA + (size_t)(t + 1) * kstep;
            const char* a2 = last ? nA : cA + (size_t)(t + 2) * kstep; const char* b2 = last ? nB : cB + (size_t)(t + 2) * kstep;
            const char* a3 = a2 + kstep; const char* b3 = b2 + kstep;
            if (last && has_next) S.a_ready(nxt);
            PG8_LDB(B0, 0, 0); PG8_SCHED; PG8_LDA(At, 0, 0); PG8_STAGE(PG8_SA(1, 1), a1 + hstep, voffA);
            PG8_WAIT_L(8); PG8_BAR; PG8_WAIT_L(0); PG8_MMA(0, 0, At, B0); PG8_BAR; PG8_SCHED;
            PG8_LDB(B1, 0, 1); PG8_STAGE(PG8_SB(0, 0), b2, voffB);
            PG8_BAR; PG8_WAIT_L(0); PG8_MMA(0, 1, At, B1); PG8_BAR;
            PG8_LDA(At, 0, 1); PG8_STAGE(PG8_SA(0, 0), a2, voffA);
            PG8_BAR; PG8_WAIT_L(0); PG8_MMA(1, 0, At, B0); PG8_BAR; PG8_SCHED;
            PG8_STAGE(PG8_SB(0, 1), b2 + hstep, voffB);
            PG8_WAIT_V(6); PG8_BAR; PG8_MMA(1, 1, At, B1); PG8_BAR;
            PG8_LDB(B0, 1, 0); PG8_SCHED; PG8_LDA(At, 1, 0); PG8_STAGE(PG8_SA(0, 1), a2 + hstep, voffA);
            PG8_WAIT_L(8); PG8_BAR; PG8_WAIT_L(0); PG8_MMA(0, 0, At, B0); PG8_BAR; PG8_SCHED;
            PG8_LDB(B1, 1, 1); PG8_STAGE(PG8_SB(1, 0), b3, voffB);
            PG8_BAR; PG8_WAIT_L(0); PG8_MMA(0, 1, At, B1); PG8_BAR;
            PG8_LDA(At, 1, 1); PG8_STAGE(PG8_SA(1, 0), a3, voffA);
            PG8_BAR; PG8_WAIT_L(0); PG8_MMA(1, 0, At, B0); PG8_BAR; PG8_SCHED;
            PG8_STAGE(PG8_SB(1, 1), b3 + hstep, voffB);
            PG8_WAIT_V(6); PG8_BAR; PG8_MMA(1, 1, At, B1); PG8_BAR;
        }
        PG8_STAMP();
        if constexpr (!Epi::AFTER_DRAIN) { E(acc, cur, wr, wc, fr, fq); S.done(cur); }
        PG8_STAMP();
        if (!has_next) break;
#pragma unroll
        for (int a = 0; a < 2; ++a)
#pragma unroll
            for (int b = 0; b < 2; ++b)
#pragma unroll
                for (int m = 0; m < 4; ++m)
#pragma unroll
                    for (int n = 0; n < 2; ++n) acc[a][b][m][n] = (f32x4){0.f, 0.f, 0.f, 0.f};
        cur = nxt; cA = nA; cB = nB; ++ui; nt = cur.nt;
    }
    PG8_WAIT_V(0);
    if (wr == 0) PG8_BAR;
    PG8_BAR;
    if constexpr (Epi::AFTER_DRAIN) { E.fused(acc, cur, wr, wc, fr, fq, lds, wid, lane); S.done(cur); }
    PG8_STAMP();
    if (STAMP && wid == 0) { stamps[lane] = lane < nts ? (((unsigned long long)(unsigned)ts_hi << 32) | (unsigned)ts_lo) : 0ull;
        if (lane == 62) stamps[62] = rt_entry; if (lane == 63) stamps[63] = (unsigned long long)wall_clock64(); }
#undef PG8_STAMP
#undef PG8_SA
#undef PG8_SB
#undef PG8_STAGE
#undef PG8_LDA
#undef PG8_LDB
#undef PG8_MMA
#undef PG8_WAIT_V
#undef PG8_WAIT_L
#undef PG8_BAR
#undef PG8_SCHED
}
}

using pg8::bf16_t; using pg8::bf16x8; using pg8::f32x4; using pg8::u32x4;
typedef short s16x4 __attribute__((ext_vector_type(4)));
typedef float f32x16 __attribute__((ext_vector_type(16)));
typedef unsigned u32x2 __attribute__((ext_vector_type(2)));
#define LAS __attribute__((address_space(3)))
#define DI __device__ __forceinline__
#define MFMA32(a, b, c) __builtin_amdgcn_mfma_f32_32x32x16_bf16((a), (b), (c), 0, 0, 0)

constexpr int NB = 8, LL = 2064, NMETA = 16, DM = 2048, MTOK = NB * LL, MPAD = 16640;
constexpr int EVEN_IN = 15360, ODD_IN = 16384, MIXW = 4096;
constexpr int ODD_LD = ODD_IN;
constexpr int LDS_BYTES = 131072 + 1024;
#ifndef PHM
#define PHM 255
#endif
constexpr float LOG2E = 1.4426950408889634f, LN2 = 0.6931471805599453f;

constexpr size_t OFF_H = 0;
constexpr size_t OFF_HN = OFF_H + (size_t)MPAD * DM * 4;
constexpr size_t OFF_Z = OFF_HN + (size_t)MPAD * DM * 2;
constexpr size_t OFF_MIX = OFF_Z + (size_t)MPAD * ODD_LD * 2;
constexpr size_t OFF_WIN = OFF_MIX + (size_t)MPAD * MIXW * 2;
constexpr size_t OFF_WOUT = OFF_WIN + (size_t)ODD_IN * DM * 2;
constexpr size_t OFF_WIN2 = OFF_WOUT + (size_t)DM * MIXW * 2;
constexpr size_t OFF_MISC = OFF_WIN2 + (size_t)ODD_IN * DM * 2;
constexpr size_t OFF_QCTR = OFF_MISC + 384;
constexpr size_t OFF_HFLAG = OFF_MISC + 4608;
constexpr size_t OFF_NRM = OFF_MISC + 512;
constexpr size_t OFF_PART = OFF_MISC + 8192;
constexpr size_t WS_END = OFF_PART + (size_t)16 * 128 * DM * 4;

struct Params {
    const float *x, *meta, *norm_a, *w_in_a, *w_out_a, *hgrn_lb, *hgrn_norm, *sink, *norm_c, *w_in_c, *w_out_c, *dlam, *dnorm, *fnorm;
    float* out; unsigned char* ws; int ph_lo, ph_hi, dup_e, dup_o;
};

DI unsigned cvt_pk(float lo, float hi) { unsigned r; asm("v_cvt_pk_bf16_f32 %0, %1, %2" : "=v"(r) : "v"(lo), "v"(hi)); return r; }
DI float bf2f(bf16_t x) { return __uint_as_float(((unsigned)x) << 16); }
DI float bflo(unsigned u) { return __uint_as_float(u << 16); }
DI float bfhi(unsigned u) { return __uint_as_float(u & 0xffff0000u); }
DI float ex2(float x) { return __builtin_amdgcn_exp2f(x); }
DI float lg2(float x) { return __builtin_amdgcn_logf(x); }
DI float rcpf(float x) { return __builtin_amdgcn_rcpf(x); }
DI float siluf(float x) { return x * rcpf(1.f + ex2(-x * LOG2E)); }
DI float wave_sum(float v) {
#pragma unroll
    for (int o = 32; o; o >>= 1) v += __shfl_xor(v, o);
    return v; }
DI float xhalf_max(float v) { const auto r = __builtin_amdgcn_permlane32_swap(__float_as_uint(v), __float_as_uint(v), false, false); return fmaxf(__uint_as_float(r[0]), __uint_as_float(r[1])); }
DI float xhalf_sum(float v) { const auto r = __builtin_amdgcn_permlane32_swap(__float_as_uint(v), __float_as_uint(v), false, false); return __uint_as_float(r[0]) + __uint_as_float(r[1]); }
DI int crow(int reg, int h) { return (reg & 3) + 8 * (reg >> 2) + 4 * h; }
DI f32x16 zero16() { f32x16 z;
#pragma unroll
    for (int i = 0; i < 16; ++i) z[i] = 0.f;
    return z; }

template <int MODE>
DI void row_phase(const Params& p, const float* __restrict__ g, const int wave_s__) {
    const int wid = ltid(wave_s__) >> 6, lane = ltid(wave_s__) & 63;
    float* H = (float*)(p.ws + OFF_H); bf16_t* HN = (bf16_t*)(p.ws + OFF_HN);
    for (int r = blockIdx.x * 8 + wid; r < MPAD; r += gridDim.x * 8) {
        if (r >= MTOK) {
            if (MODE == 0) {
#pragma unroll
                for (int j = 0; j < 8; ++j) { *(f32x4*)(H + (size_t)r * DM + (j * 64 + lane) * 4) = (f32x4){0.f, 0.f, 0.f, 0.f}; }
            }
            if (MODE != 2) {
#pragma unroll
                for (int j = 0; j < 8; ++j) { u32x2 zz; zz.x = 0u; zz.y = 0u; *(u32x2*)(HN + (size_t)r * DM + (j * 64 + lane) * 4) = zz; }
            }
            continue;
        }
        const int b = r / LL, t = r - b * LL;
        const float* src;
        if (MODE == 0) src = (t < NMETA) ? (p.meta + (size_t)t * DM) : (p.x + ((size_t)b * 2048 + (t - NMETA)) * DM);
        else src = H + (size_t)r * DM;
        f32x4 v[8]; float ss = 0.f;
#pragma unroll
        for (int j = 0; j < 8; ++j) v[j] = *(const f32x4*)(src + (j * 64 + lane) * 4);
        if (MODE != 0 && r >= 16384) {
            const float* pp = (const float*)(p.ws + OFF_PART) + (size_t)(r - 16384) * DM;
            for (int sp = 0; sp < 16; ++sp) {
#pragma unroll
                for (int j = 0; j < 8; ++j) v[j] = v[j] + *(const f32x4*)(pp + (size_t)sp * 128 * DM + (j * 64 + lane) * 4); }
            if (MODE == 1) {
#pragma unroll
                for (int j = 0; j < 8; ++j) *(f32x4*)(H + (size_t)r * DM + (j * 64 + lane) * 4) = v[j]; }
        }
#pragma unroll
        for (int j = 0; j < 8; ++j) ss += v[j][0] * v[j][0] + v[j][1] * v[j][1] + v[j][2] * v[j][2] + v[j][3] * v[j][3];
        ss = wave_sum(ss);
        const float rstd = rsqrtf(ss * (1.f / DM) + 1e-6f);
        if (MODE == 0 && r >= 16384) {
#pragma unroll
            for (int j = 0; j < 8; ++j) *(f32x4*)(H + (size_t)r * DM + (j * 64 + lane) * 4) = v[j];
        }
        if (MODE == 2) {
            if (t >= NMETA) { float* op = p.out + ((size_t)b * 2048 + (t - NMETA)) * DM;
#pragma unroll
                for (int j = 0; j < 8; ++j) { const f32x4 gg = *(const f32x4*)(g + (j * 64 + lane) * 4); f32x4 o; o[0] = v[j][0] * rstd * gg[0]; o[1] = v[j][1] * rstd * gg[1]; o[2] = v[j][2] * rstd * gg[2]; o[3] = v[j][3] * rstd * gg[3];
                    *(f32x4*)(op + (j * 64 + lane) * 4) = o; } }
        } else {
#pragma unroll
            for (int j = 0; j < 8; ++j) { const f32x4 gg = *(const f32x4*)(g + (j * 64 + lane) * 4); u32x2 w; w.x = cvt_pk(v[j][0] * rstd * gg[0], v[j][1] * rstd * gg[1]); w.y = cvt_pk(v[j][2] * rstd * gg[2], v[j][3] * rstd * gg[3]);
                *(u32x2*)(HN + (size_t)r * DM + (j * 64 + lane) * 4) = w; }
        }
    }
}

DI void convert_T(LAS unsigned char* lds, const float* __restrict__ W, bf16_t* __restrict__ Wt, const int K, const int N, const int wave_s__, const int first = 0) {
    LAS float* tile = (LAS float*)lds;
    const int tid = ltid(wave_s__), nk = K >> 6, ntile = nk * (N >> 8);
    const int tx = tid & 63, ty = tid >> 6, wn = tid >> 3, wk = (tid & 7) * 8;
    if ((int)blockIdx.x < first) return;
    for (int t = (int)blockIdx.x - first; t < ntile; t += (int)gridDim.x - first) {
        const int k0 = (t % nk) << 6, n0 = (t / nk) << 8;
        float r[4][8];
#pragma unroll
        for (int c = 0; c < 4; ++c)
#pragma unroll
            for (int i = 0; i < 8; ++i) r[c][i] = __builtin_nontemporal_load(W + (size_t)(k0 + ty * 8 + i) * N + n0 + c * 64 + tx);
#pragma unroll
        for (int c = 0; c < 4; ++c) {
#pragma unroll
            for (int i = 0; i < 8; ++i) tile[(ty * 8 + i) * 65 + tx] = r[c][i];
            __syncthreads();
            float e[8];
#pragma unroll
            for (int i = 0; i < 8; ++i) e[i] = tile[(wk + i) * 65 + wn];
            u32x4 w; w.x = cvt_pk(e[0], e[1]); w.y = cvt_pk(e[2], e[3]); w.z = cvt_pk(e[4], e[5]); w.w = cvt_pk(e[6], e[7]);
            *(u32x4*)(Wt + (size_t)(n0 + c * 64 + wn) * K + k0 + wk) = w;
            __syncthreads();
        }
    }
}

struct EpiResAdd {
    static constexpr bool PERM = false, AFTER_DRAIN = false;
    float* H; int ldc; float* P; const float* x0; const float* meta0;
    DI void operator()(const f32x4 (&acc)[2][2][4][2], const pg8::Unit& u, int wr, int wc, int fr, int fq) const {
        const int row0 = u.pm * pg8::BM + wr * 64 + fr, col0 = u.pn * pg8::BM + wc * 32 + 4 * fq;
        if (u.nt != MIXW / 64) {
            float* pb = P + ((size_t)(u.kt0 >> 2) * 128 + (row0 - 16384)) * DM + col0;
#pragma unroll
            for (int m = 0; m < 4; ++m)
#pragma unroll
                for (int bj = 0; bj < 2; ++bj)
#pragma unroll
                    for (int n = 0; n < 2; ++n) *(f32x4*)(pb + (size_t)(m * 16) * DM + bj * pg8::HALF + n * 16) = acc[0][bj][m][n];
            return;
        }
#pragma unroll
        for (int ai = 0; ai < 2; ++ai)
#pragma unroll
            for (int m = 0; m < 4; ++m) { const int row = row0 + ai * pg8::HALF + m * 16; float* rowp = H + (size_t)row * ldc + col0;
                const float* srcp = rowp;
                if (x0) { const int b = row / LL, t = row - b * LL; srcp = (t < NMETA ? meta0 + (size_t)t * DM : x0 + ((size_t)b * 2048 + (t - NMETA)) * DM) + col0; }
#pragma unroll
                for (int bj = 0; bj < 2; ++bj)
#pragma unroll
                    for (int n = 0; n < 2; ++n) { *(f32x4*)(rowp + bj * pg8::HALF + n * 16) = *(const f32x4*)(srcp + bj * pg8::HALF + n * 16) + acc[ai][bj][m][n]; } }
    }
};

template <int NDV, int NK, bool WINM>
DI void attn_unit(LAS unsigned char* lds, const bf16_t* __restrict__ zb, const int ldz, const int qcol, const int kcol0, const int kcol1, const int vcol,
                  const int gcol, const int ocol, const float c2, const float sink2, const int t0, const int lo, const int nt,
                  bf16_t* __restrict__ mixb, const float lam, const float* __restrict__ normg, const float oscale, const int wave_s__) {
    constexpr int DV = NDV * 32, ROWB = DV * 2, KBY = 8192, VBY = 32 * ROWB, BUFB = NK * KBY + VBY, NI = (NK * KBY + VBY) / 1024, NPW = NI / 8;
    static_assert(3 * BUFB <= LDS_BYTES && NI % 8 == 0, "attention tile buffers");
    const int tid = ltid(wave_s__), wid = tid >> 6, lane = tid & 63, r32 = lane & 31, half = lane >> 5, j = wid >> 2, wq = wid & 3;
    const int tq = t0 + wq * 32 + r32;
    const float c1 = 0.08838834764831845f * LOG2E;
    bf16x8 qf[8];
    { const bf16_t* qp = zb + (size_t)tq * ldz + qcol + half * 8;
#pragma unroll
      for (int ks = 0; ks < 8; ++ks) qf[ks] = *(const bf16x8*)(qp + ks * 16); }
    f32x16 o[NDV];
#pragma unroll
    for (int n = 0; n < NDV; ++n) o[n] = zero16();
    float m = -1e30f, l = 0.f;
    unsigned soff[NPW]; int ddst[NPW];
#pragma unroll
    for (int e = 0; e < NPW; ++e) { const int qi = wid * NPW + e;
        if (qi < NK * 8) { const int mp = qi >> 3, r4 = qi & 7; const int row = 4 * r4 + (lane >> 4), slot = (lane & 15) ^ (row & 15);
            soff[e] = (unsigned)(row * ldz + (mp ? kcol1 : kcol0) + slot * 8) * 2u; ddst[e] = mp * KBY + r4 * 1024; }
        else { const int qv = qi - NK * 8; constexpr int SPR = DV / 8, RPI = 1024 / ROWB; const int row = qv * RPI + lane / SPR, ps = lane % SPR; const int ls = (((ps >> 2) ^ (row & 3)) << 2) | (ps & 3);
            soff[e] = (unsigned)(row * ldz + vcol + ls * 8) * 2u; ddst[e] = NK * KBY + qv * 1024; } }
#define ATT_DMA(tile_, buf_) do { const char* tb_ = (const char*)(zb + (size_t)(32 * (tile_)) * ldz); \
        _Pragma("unroll") for (int e = 0; e < NPW; ++e) __builtin_amdgcn_global_load_lds((const unsigned*)(tb_ + soff[e]), (LAS unsigned*)(lds + (buf_) * BUFB + ddst[e]), 16, 0, 0); } while (0)
#define ATT_BAR() do { asm volatile("" ::: "memory"); __builtin_amdgcn_s_barrier(); asm volatile("" ::: "memory"); } while (0)
    const int td = t0 >> 5, ndiag = (65 - td) < 4 ? (65 - td) : 4, nleft = td - lo;
#define ATT_TILE(it_) (WINM ? ((it_) == 0 ? 0 : lo + (it_) - 1) : ((it_) < ndiag ? td + (it_) : ((it_) < ndiag + nleft ? td - 1 - ((it_) - ndiag) : td + (it_) - nleft)))
    const int kbase = (NK == 2 ? j * KBY : 0) + r32 * 256 + ((((r32 & 15) ^ half) & 1) << 4) + ((r32 & 14) << 4);
    const int q4 = (lane >> 2) & 3, p4 = lane & 3, blk = (lane >> 4) & 1;
    int vb[4];
#pragma unroll
    for (int c = 0; c < 4; ++c) vb[c] = NK * KBY + (4 * half + q4) * ROWB + ((c ^ q4) << 6) + blk * 32 + 8 * p4;
    ATT_DMA(ATT_TILE(0), 0);
    asm volatile("s_waitcnt vmcnt(0)" ::: "memory");
    ATT_BAR();
    f32x16 st = zero16();
    u32x4 pk0, pk1; pk0.x = pk0.y = pk0.z = pk0.w = 0u; pk1 = pk0;
    bool pv_act = false;
    for (int ph = 0; ph < 2 * nt + 2; ++ph) {
        if (((ph + j) & 1) == 0) {
            const int idx = (ph - j) >> 1;
            if (idx >= 1 && pv_act) {
                const int bo = ((idx - 1) % 3) * BUFB;
                const bf16x8 pb0 = __builtin_bit_cast(bf16x8, pk0), pb1 = __builtin_bit_cast(bf16x8, pk1);
                bf16x8 av[3];
#define ATT_VLD1(k_, dst_) do { const int s2_ = (k_) / NDV, n_ = (k_) % NDV; LAS unsigned char* vp_ = lds + bo + vb[n_ & 3] + (n_ >> 2) * 256 + (16 * s2_) * ROWB; \
                        const s16x4 lo4_ = __builtin_amdgcn_ds_read_tr16_b64_v4i16((LAS s16x4*)vp_); const s16x4 hi4_ = __builtin_amdgcn_ds_read_tr16_b64_v4i16((LAS s16x4*)(vp_ + 8 * ROWB)); \
                        dst_ = __builtin_shufflevector(lo4_, hi4_, 0, 1, 2, 3, 4, 5, 6, 7); } while (0)
                ATT_VLD1(0, av[0]); ATT_VLD1(1, av[1]);
#pragma unroll
                for (int k = 0; k < 2 * NDV; ++k) {
                    if (k + 2 < 2 * NDV) ATT_VLD1(k + 2, av[(k + 2) % 3]);
                    __builtin_amdgcn_sched_barrier(0);
                    o[k % NDV] = MFMA32(av[k % 3], (k / NDV) ? pb1 : pb0, o[k % NDV]);
                    __builtin_amdgcn_sched_barrier(0);
                }
#undef ATT_VLD1
            }
            if (idx < nt) {
                const int ka = (idx % 3) * BUFB + kbase;
                st = zero16();
                bf16x8 ak[3];
                ak[0] = *(LAS bf16x8*)(lds + ka); ak[1] = *(LAS bf16x8*)(lds + (ka ^ 32));
#pragma unroll
                for (int ks = 0; ks < 8; ++ks) { if (ks + 2 < 8) ak[(ks + 2) % 3] = *(LAS bf16x8*)(lds + (ka ^ ((ks + 2) << 5)));
                    __builtin_amdgcn_sched_barrier(0);
                    st = MFMA32(ak[ks % 3], qf[ks], st);
                    __builtin_amdgcn_sched_barrier(0); }
            }
        } else {
            const int idx = (ph - j - 1) >> 1;
            { const int ti = idx + 1 + j; if (ti < nt) ATT_DMA(ATT_TILE(ti), ti % 3); }
            if (idx >= 0 && idx < nt) {
                const int key0 = 32 * ATT_TILE(idx);
                const float basef = (float)(tq - key0 - 4 * half);
                const bool tail = (key0 + 32 > LL);
                float x[16]; float mx = -INFINITY;
                if (WINM || tail) {
#pragma unroll
                    for (int i = 0; i < 16; ++i) { const int off = 8 * (i >> 2) + (i & 3); float d = fabsf(basef - (float)off); bool valid;
                        const int s = key0 + 4 * half + off;
                        if (WINM) { const bool meta = s < NMETA; valid = meta || (d <= 128.f && s < LL); d = meta ? fminf(d, 128.f) : d; }
                        else valid = (s < LL);
                        float xv = fmaf(st[i], c1, -c2 * d); xv = valid ? xv : -INFINITY; x[i] = xv; mx = fmaxf(mx, xv); }
                } else if (key0 + 31 < t0 + wq * 32 || key0 > t0 + wq * 32 + 31) {
                    const bool left = key0 + 31 < t0 + wq * 32; const float cs = left ? c2 : -c2, cbs = (left ? -c2 : c2) * basef;
#pragma unroll
                    for (int i = 0; i < 16; ++i) { const int off = 8 * (i >> 2) + (i & 3);
                        float kb = fmaf((float)off, cs, cbs); asm volatile("" : "+v"(kb)); float sv = st[i]; asm volatile("" : "+v"(sv));
                        float xv = fmaf(sv, c1, kb); asm volatile("" : "+v"(xv)); x[i] = xv; mx = fmaxf(mx, xv); }
                } else {
#pragma unroll
                    for (int i = 0; i < 16; ++i) { const int off = 8 * (i >> 2) + (i & 3); float d = basef - (float)off; asm volatile("" : "+v"(d)); float sv = st[i]; asm volatile("" : "+v"(sv));
                        float kb = -c2 * fabsf(d); asm volatile("" : "+v"(kb)); float xv = fmaf(sv, c1, kb); asm volatile("" : "+v"(xv)); x[i] = xv; mx = fmaxf(mx, xv); }
                }
                mx = xhalf_max(mx);
                pv_act = __any(mx > m - 40.f) != 0;
                if (pv_act) {
                    const bool need = mx > m + 8.f;
                    if (__any(need)) {
                        const float mn = need ? mx : m; const float al = ex2(m - mn);
                        l *= al;
#pragma unroll
                        for (int n = 0; n < NDV; ++n)
#pragma unroll
                            for (int i = 0; i < 16; ++i) o[n][i] *= al;
                        m = mn;
                    }
                    float ps = 0.f;
#pragma unroll
                    for (int i = 0; i < 16; ++i) { float dm = x[i] - m; asm volatile("" : "+v"(dm)); x[i] = ex2(dm); ps += x[i]; }
                    l += ps;
                    pk0.x = cvt_pk(x[0], x[1]); pk0.y = cvt_pk(x[2], x[3]); pk0.z = cvt_pk(x[4], x[5]); pk0.w = cvt_pk(x[6], x[7]);
                    pk1.x = cvt_pk(x[8], x[9]); pk1.y = cvt_pk(x[10], x[11]); pk1.z = cvt_pk(x[12], x[13]); pk1.w = cvt_pk(x[14], x[15]);
                }
            }
        }
        if (ph & 1) { asm volatile("s_waitcnt vmcnt(0)" ::: "memory"); ATT_BAR(); }
    }
    __syncthreads();
#undef ATT_DMA
#undef ATT_BAR
#undef ATT_TILE
    float lt = xhalf_sum(l);
    if (WINM) lt += ex2(sink2 - m);
    const float inv = 1.f / lt;
    const bool tval = tq < LL;
    if (WINM) {
        if (tval) { const bf16_t* gp = zb + (size_t)tq * ldz + gcol + 4 * half; bf16_t* op = mixb + (size_t)tq * MIXW + ocol + 4 * half;
#pragma unroll
            for (int n = 0; n < NDV; ++n)
#pragma unroll
                for (int g4 = 0; g4 < 4; ++g4) { const int dv = n * 32 + 8 * g4; const u32x2 gg = *(const u32x2*)(gp + dv);
                    u32x2 w; w.x = cvt_pk(o[n][4 * g4] * inv * siluf(bflo(gg.x)), o[n][4 * g4 + 1] * inv * siluf(bfhi(gg.x)));
                    w.y = cvt_pk(o[n][4 * g4 + 2] * inv * siluf(bflo(gg.y)), o[n][4 * g4 + 3] * inv * siluf(bfhi(gg.y)));
                    *(u32x2*)(op + dv) = w; } }
    } else {
        LAS float* xb = (LAS float*)lds + wq * (DV * 32) + 128 * half + r32;
        if (j == 1) { const float sc = inv * lam;
#pragma unroll
            for (int n = 0; n < NDV; ++n)
#pragma unroll
                for (int i = 0; i < 16; ++i) xb[(n * 32 + 8 * (i >> 2) + (i & 3)) * 32] = o[n][i] * sc; }
        __syncthreads();
        if (j == 0) { float ss = 0.f;
#pragma unroll
            for (int n = 0; n < NDV; ++n)
#pragma unroll
                for (int i = 0; i < 16; ++i) { const float v = o[n][i] * inv - xb[(n * 32 + 8 * (i >> 2) + (i & 3)) * 32]; o[n][i] = v; ss += v * v; }
            ss = xhalf_sum(ss);
            const float rstd = rsqrtf(ss * (1.f / DV) + 1e-6f) * oscale;
            const float* ngp = normg; asm volatile("" : "+s"(ngp)); ngp += 4 * half;
            if (tval) { const bf16_t* gp = zb + (size_t)tq * ldz + gcol + 4 * half; bf16_t* op = mixb + (size_t)tq * MIXW + ocol + 4 * half;
#pragma unroll
                for (int n = 0; n < NDV; ++n)
#pragma unroll
                    for (int g4 = 0; g4 < 4; ++g4) { const int dv = n * 32 + 8 * g4; const u32x2 gg = *(const u32x2*)(gp + dv); const f32x4 ng = *(const f32x4*)(ngp + dv);
                        u32x2 w; w.x = cvt_pk(o[n][4 * g4] * rstd * ng[0] * siluf(bflo(gg.x)), o[n][4 * g4 + 1] * rstd * ng[1] * siluf(bfhi(gg.x)));
                        w.y = cvt_pk(o[n][4 * g4 + 2] * rstd * ng[2] * siluf(bflo(gg.y)), o[n][4 * g4 + 3] * rstd * ng[3] * siluf(bfhi(gg.y)));
                        *(u32x2*)(op + dv) = w; } }
        }
        __syncthreads();
    }
}

DI void hgrn_seq(LAS unsigned char* lds, const bf16_t* __restrict__ zb, const int ldz, const int h, const int dir, const float lbv, bf16_t* __restrict__ dst, const int ldd, const int wave_s__) {
    constexpr int QC = 0, KH = 17408, KT = 34816, VT = 53248, SL = 71680, SC = 106496, TOT = 115712, E1 = 117760, GM = 118272;
    const int tid = ltid(wave_s__), wid = tid >> 6, lane = tid & 63, r32 = lane & 31, half = lane >> 5;
    const int k = tid & 127, tg = tid >> 7;
    const int fcol = dir ? 4096 : 2048;
    const int n = wid & 3, kt0 = 2 * (wid >> 2), ti = wid >> 2;
    LAS float* tot = (LAS float*)(lds + TOT); LAS float* e1p = (LAS float*)(lds + E1); LAS float* gmp = (LAS float*)(lds + GM);
    LAS float* e1l = e1p + kt0 * 32 + 4 * half; LAS float* gml = gmp + kt0 * 32 + 4 * half;
    f32x16 S[2]; S[0] = zero16(); S[1] = zero16();
    const float oml = 1.f - lbv;
    bf16_t rq[16], rf[16], rv[16];
#define HG_LOAD(c_) do { _Pragma("unroll") for (int e = 0; e < 16; ++e) { const int P_ = 64 * (c_) + tg * 16 + e; const int pp_ = dir ? 2111 - P_ : P_; const int t_ = pp_ - 48; const int tt_ = t_ < 0 ? 0 : t_; \
            const bf16_t* row_ = zb + (size_t)tt_ * ldz + h * 128 + k; rq[e] = row_[0]; rf[e] = row_[fcol]; rv[e] = row_[6144]; } } while (0)
    HG_LOAD(0);
    for (int c = 0; c < 33; ++c) {
        float qv[16], kk[16], bl[16]; unsigned vp[8]; float run = 0.f;
        {
            float vv[16];
#pragma unroll
            for (int e = 0; e < 16; ++e) {
                const int P = 64 * c + tg * 16 + e; const int pp = dir ? 2111 - P : P; const int t = pp - 48; const bool ok = t >= 0;
                const float q = bf2f(rq[e]), zf = bf2f(rf[e]), v = bf2f(rv[e]);
                const float ex = ex2(-zf * LOG2E), rden = rcpf(1.f + ex);
                const float lf = lg2((1.f + lbv * ex) * rden);
                run += ok ? lf : 0.f; bl[e] = run; qv[e] = ok ? q : 0.f; kk[e] = ok ? oml * ex * rden : 0.f; vv[e] = ok ? v : 0.f;
            }
#pragma unroll
            for (int e = 0; e < 8; ++e) vp[e] = cvt_pk(vv[2 * e], vv[2 * e + 1]);
        }
        tot[tg * 128 + k] = run;
        __syncthreads();
        {
            const float t0_ = tot[k], t1_ = tot[128 + k], t2_ = tot[256 + k], t3_ = tot[384 + k];
            const float off = (tg > 0 ? t0_ : 0.f) + (tg > 1 ? t1_ : 0.f) + (tg > 2 ? t2_ : 0.f);
            const float bmid = t0_ + t1_;
            if (tg == 0) { e1p[k] = ex2(bmid); gmp[k] = ex2(t2_ + t3_); }
            unsigned khp[8]; float khv[16];
#pragma unroll
            for (int e = 0; e < 16; ++e) { const float dq = off + bl[e] - bmid; const float qc = qv[e] * ex2(dq); khv[e] = kk[e] * ex2(-dq);
                const int i = tg * 16 + e;
                *(LAS bf16_t*)(lds + QC + i * 272 + k * 2) = (bf16_t)(cvt_pk(qc, qc) & 0xffffu);
                *(LAS bf16_t*)(lds + KH + i * 272 + k * 2) = (bf16_t)(cvt_pk(khv[e], khv[e]) & 0xffffu); }
#pragma unroll
            for (int e = 0; e < 8; ++e) khp[e] = cvt_pk(khv[2 * e], khv[2 * e + 1]);
            u32x4 w0, w1; w0.x = khp[0]; w0.y = khp[1]; w0.z = khp[2]; w0.w = khp[3]; w1.x = khp[4]; w1.y = khp[5]; w1.z = khp[6]; w1.w = khp[7];
            *(LAS u32x4*)(lds + KT + k * 144 + tg * 32) = w0; *(LAS u32x4*)(lds + KT + k * 144 + tg * 32 + 16) = w1;
            w0.x = vp[0]; w0.y = vp[1]; w0.z = vp[2]; w0.w = vp[3]; w1.x = vp[4]; w1.y = vp[5]; w1.z = vp[6]; w1.w = vp[7];
            *(LAS u32x4*)(lds + VT + k * 144 + tg * 32) = w0; *(LAS u32x4*)(lds + VT + k * 144 + tg * 32 + 16) = w1;
        }
        if (c + 1 < 33) HG_LOAD(c + 1);
        __syncthreads();
#pragma unroll
        for (int a = 0; a < 2; ++a) { const int kt = kt0 + a;
#pragma unroll
            for (int i = 0; i < 16; ++i) S[a][i] *= e1l[a * 32 + 8 * (i >> 2) + (i & 3)];
#pragma unroll
            for (int g4 = 0; g4 < 4; ++g4) { u32x2 w; w.x = cvt_pk(S[a][4 * g4], S[a][4 * g4 + 1]); w.y = cvt_pk(S[a][4 * g4 + 2], S[a][4 * g4 + 3]);
                *(LAS u32x2*)(lds + SL + (n * 32 + r32) * 272 + (kt * 32 + 8 * g4 + 4 * half) * 2) = w; } }
        if (wid < 4) { const int si = wid >> 1, tj = wid & 1;
            f32x16 acc = zero16();
            if (si <= tj) {
#pragma unroll
                for (int ks = 0; ks < 8; ++ks) { const bf16x8 a = *(LAS bf16x8*)(lds + KH + (si * 32 + r32) * 272 + ks * 32 + half * 16); const bf16x8 b = *(LAS bf16x8*)(lds + QC + (tj * 32 + r32) * 272 + ks * 32 + half * 16);
                    acc = MFMA32(a, b, acc); }
            }
            const int tt = tj * 32 + r32;
#pragma unroll
            for (int g4 = 0; g4 < 4; ++g4) { float v4[4];
#pragma unroll
                for (int q = 0; q < 4; ++q) { const int s = si * 32 + 8 * g4 + 4 * half + q; v4[q] = (s <= tt) ? acc[4 * g4 + q] : 0.f; }
                u32x2 w; w.x = cvt_pk(v4[0], v4[1]); w.y = cvt_pk(v4[2], v4[3]);
                *(LAS u32x2*)(lds + SC + tt * 144 + (si * 32 + 8 * g4 + 4 * half) * 2) = w; } }
        __syncthreads();
        { f32x16 acc = zero16();
#pragma unroll
          for (int ks = 0; ks < 8; ++ks) { const bf16x8 a = *(LAS bf16x8*)(lds + SL + (n * 32 + r32) * 272 + ks * 32 + half * 16); const bf16x8 b = *(LAS bf16x8*)(lds + QC + (ti * 32 + r32) * 272 + ks * 32 + half * 16);
              acc = MFMA32(a, b, acc); }
#pragma unroll
          for (int ss = 0; ss < 4; ++ss) { if (ss < 2 || ti == 1) { const bf16x8 a = *(LAS bf16x8*)(lds + VT + (n * 32 + r32) * 144 + ss * 32 + half * 16); const bf16x8 b = *(LAS bf16x8*)(lds + SC + (ti * 32 + r32) * 144 + ss * 32 + half * 16);
              acc = MFMA32(a, b, acc); } }
          const int P = 64 * c + ti * 32 + r32; const int pp = dir ? 2111 - P : P; const int t = pp - 48;
          if (t >= 0) { bf16_t* op = dst + (size_t)t * ldd + n * 32 + 4 * half;
#pragma unroll
              for (int g4 = 0; g4 < 4; ++g4) { u32x2 w; w.x = cvt_pk(acc[4 * g4], acc[4 * g4 + 1]); w.y = cvt_pk(acc[4 * g4 + 2], acc[4 * g4 + 3]); *(u32x2*)(op + 8 * g4) = w; } }
        }
#pragma unroll
        for (int a = 0; a < 2; ++a) { const int kt = kt0 + a;
#pragma unroll
            for (int ss = 0; ss < 4; ++ss) { const bf16x8 av = *(LAS bf16x8*)(lds + KT + (kt * 32 + r32) * 144 + ss * 32 + half * 16); const bf16x8 bv = *(LAS bf16x8*)(lds + VT + (n * 32 + r32) * 144 + ss * 32 + half * 16);
                S[a] = MFMA32(av, bv, S[a]); }
#pragma unroll
            for (int i = 0; i < 16; ++i) S[a][i] *= gml[a * 32 + 8 * (i >> 2) + (i & 3)]; }
    }
#undef HG_LOAD
    __syncthreads();
}

DI int xcd_unit(int i) { const int G = gridDim.x, c = blockIdx.x; return (G & 7) ? (i * G + c) : ((i * 8 + (c & 7)) * (G >> 3) + (c >> 3)); }


DI void fin_head(const Params& p, const int li, const int b, const int h, const int wave_s__) {
    const bf16_t* Z = (const bf16_t*)(p.ws + OFF_Z); bf16_t* MIX = (bf16_t*)(p.ws + OFF_MIX); const bf16_t* OF = (const bf16_t*)(p.ws + OFF_HN);
    const int lane = (int)__lane_id(), rr = lane >> 4, c8 = (lane & 15) * 8;
    const f32x4 g0 = *(const f32x4*)(p.hgrn_norm + li * 128 + c8), g1 = *(const f32x4*)(p.hgrn_norm + li * 128 + c8 + 4);
    for (int t0 = wave_s__ * 16; t0 < LL; t0 += 128) {
        u32x4 a[4], c[4], gt[4];
#pragma unroll
        for (int q = 0; q < 4; ++q) { const int t = t0 + q * 4 + rr; const size_t r = (size_t)b * LL + (t < LL ? t : LL - 1);
            a[q] = *(const u32x4*)(OF + r * DM + h * 128 + c8); c[q] = *(const u32x4*)(MIX + r * MIXW + h * 128 + c8); gt[q] = *(const u32x4*)(Z + r * EVEN_IN + 8192 + h * 128 + c8); }
#pragma unroll
        for (int q = 0; q < 4; ++q) { const int t = t0 + q * 4 + rr; float v[8]; float ss = 0.f;
#pragma unroll
            for (int w = 0; w < 4; ++w) { v[2 * w] = bflo(a[q][w]) + bflo(c[q][w]); v[2 * w + 1] = bfhi(a[q][w]) + bfhi(c[q][w]); ss += v[2 * w] * v[2 * w] + v[2 * w + 1] * v[2 * w + 1]; }
            ss += __shfl_xor(ss, 1); ss += __shfl_xor(ss, 2); ss += __shfl_xor(ss, 4); ss += __shfl_xor(ss, 8);
            const float rstd = rsqrtf(ss * (1.f / 128) + 1e-6f);
            u32x4 w4;
#pragma unroll
            for (int w = 0; w < 4; ++w) { const float ga = (w < 2) ? g0[2 * w] : g1[2 * w - 4], gb = (w < 2) ? g0[2 * w + 1] : g1[2 * w - 3];
                w4[w] = cvt_pk(v[2 * w] * rstd * ga * siluf(bflo(gt[q][w])), v[2 * w + 1] * rstd * gb * siluf(bfhi(gt[q][w]))); }
            if (t < LL) *(u32x4*)(MIX + ((size_t)b * LL + t) * MIXW + h * 128 + c8) = w4; }
    }
}

DI void mix_even(const Params& p, LAS unsigned char* lds, const int li, const int wave_s__) {
    const bf16_t* Z = (const bf16_t*)(p.ws + OFF_Z); bf16_t* MIX = (bf16_t*)(p.ws + OFF_MIX); bf16_t* HN = (bf16_t*)(p.ws + OFF_HN);
    const int k = ltid(wave_s__) & 127, wid = ltid(wave_s__) >> 6;
    for (int u = blockIdx.x; u < 256; u += gridDim.x) {
        const int b = u >> 5, h = (u >> 1) & 15, dir = u & 1;
        float lbv = 0.f;
        if (li == 1) { const float a0 = p.hgrn_lb[(size_t)(dir * 2 + 0) * 2048 + h * 128 + k], a1 = p.hgrn_lb[(size_t)(dir * 2 + 1) * 2048 + h * 128 + k]; lbv = 1.f / (1.f + __expf(a0 - a1)); }
        hgrn_seq(lds, Z + (size_t)b * LL * EVEN_IN, EVEN_IN, h, dir, lbv, dir ? (MIX + (size_t)b * LL * MIXW + h * 128) : (HN + (size_t)b * LL * DM + h * 128), dir ? MIXW : DM, wave_s__);
        unsigned* hf = (unsigned*)(p.ws + OFF_HFLAG) + li * 128 + b * 16 + h;
        if (wave_s__ == 0 && __lane_id() == 0) { __threadfence(); __hip_atomic_fetch_add(hf, 1u, __ATOMIC_RELEASE, __HIP_MEMORY_SCOPE_AGENT);
            if (dir) { while (__hip_atomic_load(hf, __ATOMIC_RELAXED, __HIP_MEMORY_SCOPE_AGENT) < 2u) __builtin_amdgcn_s_sleep(2);
                __builtin_amdgcn_fence(__ATOMIC_ACQUIRE, "agent"); } }
        if (dir) { __syncthreads(); fin_head(p, li, b, h, wave_s__); __syncthreads(); }
    }
    const int j = wid >> 2;
    for (int i = 0;; ++i) {
        const int u = xcd_unit(i); if (u >= 1088) break;
        const int qb = u % 17, r = u / 17, pair = r & 1, kvh = (r >> 1) & 3, b = r >> 3;
        const int hq = kvh * 4 + pair * 2 + j;
        const float slope = exp2f(-0.5f * (float)(hq + 1));
        const int t0 = qb * 128;
        const int lo = (t0 - 128) < 32 ? 1 : ((t0 - 128) >> 5);
        const int hi = ((t0 + 255) >> 5) > 64 ? 64 : ((t0 + 255) >> 5);
        attn_unit<4, 1, true>(lds, Z + (size_t)b * LL * EVEN_IN, EVEN_IN, 10240 + hq * 128, 12288 + kvh * 128, 0, 12800 + kvh * 128, 13312 + hq * 128, 2048 + hq * 128,
                              slope * LOG2E, p.sink[li * 16 + hq] * LOG2E, t0, lo, 2 + hi - lo, MIX + (size_t)b * LL * MIXW, 0.f, nullptr, 0.f, wave_s__);
    }
}

DI void fin_even(const Params& p, const int li, const int wave_s__) {
    const bf16_t* Z = (const bf16_t*)(p.ws + OFF_Z); bf16_t* MIX = (bf16_t*)(p.ws + OFF_MIX); const bf16_t* OF = (const bf16_t*)(p.ws + OFF_HN);
    const int wid = ltid(wave_s__) >> 6, lane = ltid(wave_s__) & 63;
    const float* ng = p.hgrn_norm + li * 128 + (lane & 3) * 32;
    for (int r = blockIdx.x * 8 + wid; r < MTOK; r += gridDim.x * 8) {
        const bf16_t* f = OF + (size_t)r * DM + lane * 32; bf16_t* mb = MIX + (size_t)r * MIXW + lane * 32; const bf16_t* gp = Z + (size_t)r * EVEN_IN + 8192 + lane * 32;
        float v[32]; float ss = 0.f;
#pragma unroll
        for (int q = 0; q < 4; ++q) { const u32x4 a = *(const u32x4*)(f + q * 8), c = *(const u32x4*)(mb + q * 8);
#pragma unroll
            for (int w = 0; w < 4; ++w) { v[q * 8 + 2 * w] = bflo(a[w]) + bflo(c[w]); v[q * 8 + 2 * w + 1] = bfhi(a[w]) + bfhi(c[w]); } }
#pragma unroll
        for (int e = 0; e < 32; ++e) ss += v[e] * v[e];
        ss += __shfl_xor(ss, 1); ss += __shfl_xor(ss, 2);
        const float rstd = rsqrtf(ss * (1.f / 128) + 1e-6f);
#pragma unroll
        for (int q = 0; q < 4; ++q) { const u32x4 g = *(const u32x4*)(gp + q * 8); u32x4 w;
#pragma unroll
            for (int w_ = 0; w_ < 4; ++w_) { const int e = q * 8 + 2 * w_;
                w[w_] = cvt_pk(v[e] * rstd * ng[e] * siluf(bflo(g[w_])), v[e + 1] * rstd * ng[e + 1] * siluf(bfhi(g[w_]))); }
            *(u32x4*)(mb + q * 8) = w; }
    }
}


DI void qk_norm_pass(const Params& p, const int li, const int wave_s__) {
    const bf16_t* Z = (const bf16_t*)(p.ws + OFF_Z); unsigned* nrm = (unsigned*)(p.ws + OFF_NRM) + li * 512;
    const int lane = (int)__lane_id();
    const int gw = blockIdx.x * 8 + wave_s__, nw = gridDim.x * 8;
    const int per = (MTOK + nw - 1) / nw; const int r0 = gw * per, r1 = (r0 + per) < MTOK ? (r0 + per) : MTOK;
    float mxv[16]; int curb = -1;
#pragma unroll
    for (int jx = 0; jx < 16; ++jx) mxv[jx] = 0.f;
    for (int r = r0; r < r1; ++r) {
        const int b = r / LL;
        if (b != curb) { if (curb >= 0) {
#pragma unroll
                for (int jx = 0; jx < 16; ++jx) { if ((lane & 15) == 0) atomicMax(nrm + curb * 64 + jx * 4 + (lane >> 4), __float_as_uint(mxv[jx])); mxv[jx] = 0.f; } }
            curb = b; }
        const bf16_t* row = Z + (size_t)r * ODD_LD;
#pragma unroll
        for (int jx = 0; jx < 16; ++jx) { const u32x4 v = *(const u32x4*)(row + (jx * 64 + lane) * 8); float ss = 0.f;
#pragma unroll
            for (int w = 0; w < 4; ++w) { const float a = bflo(v[w]), c = bfhi(v[w]); ss += a * a + c * c; }
            ss += __shfl_xor(ss, 1); ss += __shfl_xor(ss, 2); ss += __shfl_xor(ss, 4); ss += __shfl_xor(ss, 8);
            mxv[jx] = fmaxf(mxv[jx], ss); }
    }
    if (curb >= 0) {
#pragma unroll
        for (int jx = 0; jx < 16; ++jx) if ((lane & 15) == 0) atomicMax(nrm + curb * 64 + jx * 4 + (lane >> 4), __float_as_uint(mxv[jx]));
    }
}

DI void mix_odd(const Params& p, LAS unsigned char* lds, const int li, const int layer, const int wave_s__) {
    const bf16_t* Z = (const bf16_t*)(p.ws + OFF_Z); bf16_t* MIX = (bf16_t*)(p.ws + OFF_MIX);
    const int lane = ltid(wave_s__) & 63, wid = ltid(wave_s__) >> 6, j = wid >> 2;
    const float lam_init = 0.8f - 0.6f * expf(-0.3f * (float)layer);
    const float lam = ((const float*)(p.ws + OFF_MISC))[li];
    unsigned* qctr = (unsigned*)(p.ws + OFF_QCTR) + li * 8;
    volatile LAS unsigned* qw = (volatile LAS unsigned*)(lds + 131072);
    for (int sq = 0; sq < 8; ++sq) {
      const int b = ((int)blockIdx.x + sq) & 7;
      for (;;) {
        if (wid == 0 && lane == 0) qw[0] = atomicAdd(qctr + b, 1u);
        __syncthreads();
        const unsigned uq = qw[0];
        __syncthreads();
        if (uq >= 272u) break;
        const int h = 15 - (int)(uq / 17u), qb = (int)(uq % 17u);
        const float slope = exp2f(-0.5f * (float)(h + 1));
        const unsigned* nr = (const unsigned*)(p.ws + OFF_NRM) + li * 512 + b * 64;
        const float q0 = __uint_as_float(nr[h * 2]), q1 = __uint_as_float(nr[h * 2 + 1]), k0 = __uint_as_float(nr[32 + h * 2]), k1 = __uint_as_float(nr[32 + h * 2 + 1]);
        const float Bq = sqrtf(fmaxf(q0 * k0, q1 * k1)) * (0.08838834764831845f * LOG2E * 1.001f);
        const float Dmin = (40.f + 2.f * Bq) / (slope * LOG2E);
        const int t0 = qb * 128;
        int first = (int)floorf(((float)(t0 - 31) - Dmin) * (1.f / 32.f)) + 1; first = first < 0 ? 0 : first;
        int last = (int)ceilf(((float)(t0 + 127) + Dmin) * (1.f / 32.f)) - 1; last = last > 64 ? 64 : last;
        attn_unit<8, 2, false>(lds, Z + (size_t)b * LL * ODD_LD, ODD_LD, h * 256 + j * 128, 4096 + h * 256, 4096 + h * 256 + 128, 8192 + h * 256, 12288 + h * 256, h * 256,
                               slope * LOG2E, 0.f, t0, first, last - first + 1, MIX + (size_t)b * LL * MIXW, lam, p.dnorm + li * 256, 1.f - lam_init, wave_s__);
      }
    }
}


struct G2Order : pg8::StaticOrder {
    __device__ bool next(int i, pg8::Unit& u) const {
        const long L = (long)i * G + c;
        if (L < nwg) return pg8::StaticOrder::next(i, u);
        const int jx = (int)(L - nwg); if (jx >= 128) return false;
        u.pm = 64; u.pn = jx & 7; u.kt0 = (jx >> 3) * 4; u.nt = 4; return true;
    }
};
template <bool EVEN>
DI void run_g1(const Params& p, LAS unsigned char* lds, const int layer, const int wave_s__) {
    constexpr int nin = EVEN ? EVEN_IN : ODD_IN;
    pg8::Gemm g; g.A = (const bf16_t*)(p.ws + OFF_HN); g.Bt = (const bf16_t*)(p.ws + ((layer & 1) ? OFF_WIN2 : OFF_WIN)); g.M = MPAD; g.N = nin; g.K = DM;
    pg8::StaticOrder S; S.init(MPAD, nin, (int)gridDim.x, (int)blockIdx.x, DM);
    pg8::EpiBf16<0> E; E.O = (bf16_t*)(p.ws + OFF_Z); E.ldc = EVEN ? EVEN_IN : ODD_LD; E.bias = nullptr; E.split_cols = 0; E.split_stride = 0;
    pg8::gemm_phase<pg8::EpiBf16<0>, pg8::StaticOrder, false>(lds, g, S, E, nullptr, wave_s__);
    const int rem = ((MPAD / 256) * (nin / 256)) % (int)gridDim.x; const int first = (rem == 0 || 2 * rem > (int)gridDim.x) ? 0 : rem;
    const int li = layer >> 1;
    convert_T(lds, (EVEN ? p.w_out_a : p.w_out_c) + (size_t)li * MIXW * DM, (bf16_t*)(p.ws + OFF_WOUT), MIXW, DM, wave_s__, first);
    if (layer < 3) { bf16_t* wn = (bf16_t*)(p.ws + (((layer + 1) & 1) ? OFF_WIN2 : OFF_WIN));
        if (EVEN) convert_T(lds, p.w_in_c + (size_t)li * DM * ODD_IN, wn, DM, ODD_IN, wave_s__, first);
        else convert_T(lds, p.w_in_a + (size_t)(li + 1) * DM * EVEN_IN, wn, DM, EVEN_IN, wave_s__, first); }
}
DI void run_g2(const Params& p, LAS unsigned char* lds, const int layer, const int wave_s__) {
    pg8::Gemm g; g.A = (const bf16_t*)(p.ws + OFF_MIX); g.Bt = (const bf16_t*)(p.ws + OFF_WOUT); g.M = MPAD; g.N = DM; g.K = MIXW;
    G2Order S; S.init(16384, DM, (int)gridDim.x, (int)blockIdx.x, MIXW);
    EpiResAdd E; E.H = (float*)(p.ws + OFF_H); E.ldc = DM; E.P = (float*)(p.ws + OFF_PART); E.x0 = layer == 0 ? p.x : nullptr; E.meta0 = p.meta;
    pg8::gemm_phase<EpiResAdd, G2Order, false>(lds, g, S, E, nullptr, wave_s__);
}

#define PH_IN(k) (lo <= (k) && (k) < hi)
DI void grid_bar(unsigned* base, const unsigned epoch, const int wave_s__) {
    __syncthreads();
    if (wave_s__ == 0 && __lane_id() == 0) {
        const unsigned G = gridDim.x, x = blockIdx.x & 7u;
        const unsigned gsize = (G - x + 7u) >> 3, ngroups = G < 8u ? G : 8u;
        const unsigned old = __hip_atomic_fetch_add(base + 32u * (1u + x), 1u, __ATOMIC_ACQ_REL, __HIP_MEMORY_SCOPE_AGENT);
        if (old + 1u == gsize * epoch) __hip_atomic_fetch_add(base, 1u, __ATOMIC_ACQ_REL, __HIP_MEMORY_SCOPE_AGENT);
        while (__hip_atomic_load(base, __ATOMIC_RELAXED, __HIP_MEMORY_SCOPE_AGENT) < ngroups * epoch) __builtin_amdgcn_s_sleep(1);
        __builtin_amdgcn_fence(__ATOMIC_ACQUIRE, "agent");
    }
    __syncthreads();
}
#define PH_SYNC(k) do { if (PH_IN(k) && PH_IN((k) + 1)) { nbar += 1u; grid_bar(barcnt, nbar, wave_s__); } } while (0)
DI void layer_pair(const Params& p, LAS unsigned char* lds, unsigned* barcnt, unsigned& nbar, const int lo, const int hi, const int pr, const int wave_s__) {
    bf16_t* WIN = (bf16_t*)(p.ws + OFF_WIN); bf16_t* WOUT = (bf16_t*)(p.ws + OFF_WOUT);

        const int k0 = 1 + 9 * pr;
        if (PH_IN(k0 + 0)) run_g1<true>(p, lds, 2 * pr, wave_s__);
        PH_SYNC(k0 + 0);
        if (PH_IN(k0 + 1)) {
#pragma unroll 1
            for (int rep = 0; rep <= p.dup_e; ++rep) { mix_even(p, lds, pr, wave_s__); __syncthreads(); }

}
        PH_SYNC(k0 + 1);
        if (PH_IN(k0 + 3)) run_g2(p, lds, 2 * pr, wave_s__);
        PH_SYNC(k0 + 3);
        if (PH_IN(k0 + 4)) row_phase<1>(p, p.norm_c + (size_t)pr * DM, wave_s__);
        PH_SYNC(k0 + 4);
        if (PH_IN(k0 + 5)) run_g1<false>(p, lds, 2 * pr + 1, wave_s__);
        PH_SYNC(k0 + 5);
        if (PH_IN(k0 + 6)) {
            qk_norm_pass(p, pr, wave_s__);
            nbar += 1u; grid_bar(barcnt, nbar, wave_s__);
#pragma unroll 1
            for (int rep = 0; rep <= p.dup_o; ++rep) { mix_odd(p, lds, pr, 2 * pr + 1, wave_s__); __syncthreads(); }

}
        PH_SYNC(k0 + 6);
        if (PH_IN(k0 + 7)) run_g2(p, lds, 2 * pr + 1, wave_s__);
        PH_SYNC(k0 + 7);
        if (PH_IN(k0 + 8)) { if (pr == 1) row_phase<2>(p, p.fnorm, wave_s__); else row_phase<1>(p, p.norm_a + (size_t)DM, wave_s__); }
        PH_SYNC(k0 + 8);
}

__global__ void __launch_bounds__(512, 2) mega(Params p) {
    extern __shared__ __attribute__((aligned(16))) unsigned char lds_raw[];
    LAS unsigned char* lds = (LAS unsigned char*)lds_raw;
    cg::grid_group grid = cg::this_grid();
    const int lo = p.ph_lo, hi = p.ph_hi;
    const int wave_s__ = __builtin_amdgcn_readfirstlane((int)threadIdx.x >> 6);
    bf16_t* WIN = (bf16_t*)(p.ws + OFF_WIN); bf16_t* WOUT = (bf16_t*)(p.ws + OFF_WOUT);
    if (PH_IN(0)) {
        if (blockIdx.x == 0) { unsigned* cw = (unsigned*)(p.ws + OFF_MISC + 256); for (int i = ltid(wave_s__); i < (8192 - 256) / 4; i += 512) cw[i] = 0u; }
        if (blockIdx.x == 0 && wave_s__ < 2) {
            const int lane = (int)__lane_id(); const float* lv = p.dlam + wave_s__ * 512;
            const float d1 = wave_sum(lv[lane] * lv[128 + lane] + lv[64 + lane] * lv[192 + lane]);
            const float d2 = wave_sum(lv[256 + lane] * lv[384 + lane] + lv[320 + lane] * lv[448 + lane]);
            const float lam_init = 0.8f - 0.6f * expf(-0.3f * (float)(2 * wave_s__ + 1));
            if (lane == 0) ((float*)(p.ws + OFF_MISC))[wave_s__] = expf(d1) - expf(d2) + lam_init;
        }
        row_phase<0>(p, p.norm_a, wave_s__); convert_T(lds, p.w_in_a, WIN, DM, EVEN_IN, wave_s__); }
    unsigned* barcnt = (unsigned*)(p.ws + OFF_MISC + 5632); unsigned nbar = 0u;
    if (PH_IN(0) && PH_IN(1)) grid.sync();
    layer_pair(p, lds, barcnt, nbar, lo, hi, 0, wave_s__);
    layer_pair(p, lds, barcnt, nbar, lo, hi, 1, wave_s__);
}

constexpr int N_PHASES = 19;

extern "C" void kernel_launch(void* const* d_in, const int* in_sizes, int n_in, void* d_out, int out_size, void* d_ws, size_t ws_size, hipStream_t stream) {
    static int grid = 0;
    if (grid == 0) {
        if (n_in != 14 || ws_size < WS_END) { fprintf(stderr, "kernel_launch: need 14 inputs and %zu bytes of workspace; got %d, %zu\n", (size_t)WS_END, n_in, ws_size); grid = -1; return; }
        int dev = 0, cus = 0, per_cu = 0;
        hipGetDevice(&dev); hipDeviceGetAttribute(&cus, hipDeviceAttributeMultiprocessorCount, dev);
        if (hipFuncSetAttribute((const void*)mega, hipFuncAttributeMaxDynamicSharedMemorySize, LDS_BYTES) != hipSuccess) { fprintf(stderr, "kernel_launch: hipFuncSetAttribute failed\n"); grid = -1; return; }
        if (hipOccupancyMaxActiveBlocksPerMultiprocessor(&per_cu, (const void*)mega, 512, LDS_BYTES) != hipSuccess || per_cu < 1) { fprintf(stderr, "kernel_launch: occupancy query says %d\n", per_cu); per_cu = 1; }
        (void)hipGetLastError();
        grid = cus * 1;
    }
    if (grid < 0) return;
    Params p{};
    p.x = (const float*)d_in[0]; p.meta = (const float*)d_in[1]; p.norm_a = (const float*)d_in[2]; p.w_in_a = (const float*)d_in[3]; p.w_out_a = (const float*)d_in[4];
    p.hgrn_lb = (const float*)d_in[5]; p.hgrn_norm = (const float*)d_in[6]; p.sink = (const float*)d_in[7]; p.norm_c = (const float*)d_in[8]; p.w_in_c = (const float*)d_in[9];
    p.w_out_c = (const float*)d_in[10]; p.dlam = (const float*)d_in[11]; p.dnorm = (const float*)d_in[12]; p.fnorm = (const float*)d_in[13];
    p.out = (float*)d_out; p.ws = (unsigned char*)d_ws; p.ph_lo = 0; p.ph_hi = N_PHASES;
#ifdef DUP_ODD
    p.dup_o = 1;
#endif
#ifdef DUP_EVEN
    p.dup_e = 1;
#endif
    void* args[] = {&p};
    hipError_t e = hipLaunchCooperativeKernel((const void*)mega, dim3(grid), dim3(512), args, LDS_BYTES, stream);
    if (e != hipSuccess) fprintf(stderr, "kernel_launch: cooperative launch failed: %s (grid %d)\n", hipGetErrorString(e), grid);
}
```

```cpp
#include <hip/hip_runtime.h>
#include <hip/hip_cooperative_groups.h>
#include <cstdio>
namespace cg = cooperative_groups;
__device__ __forceinline__ int ltid(int wave_s__) { int t = wave_s__ * 64 + (int)__lane_id(); asm volatile("" : "+v"(t)); return t; }
namespace pg8 {
#define PG8_LAS __attribute__((address_space(3)))
typedef unsigned short bf16_t;
typedef short bf16x8 __attribute__((ext_vector_type(8)));
typedef float f32x4 __attribute__((ext_vector_type(4)));
typedef unsigned u32x4 __attribute__((ext_vector_type(4)));
constexpr int BM = 256, BK = 64, HALF = 128, HTB = HALF * BK * 2  , STAGE_BYTES = 8 * HTB, NXCD = 8, WGM = 4;

__host__ __device__ __forceinline__ int lds_byte(int r, int c) { const int st = (r >> 4) * 2 + (c >> 5), rr = r & 15, cc = c & 31, ob = rr * 64 + cc * 2; return st * 1024 + (ob ^ (((ob >> 9) & 1) << 5)); }
__host__ __device__ __forceinline__ void stage_rc(int b, int& R, int& C) { const int st = b / 1024, sb = b % 1024, swz = sb ^ (((sb >> 9) & 1) << 5); R = (st >> 1) * 16 + swz / 64; C = (st & 1) * 32 + (swz % 64) / 2; }
__host__ __device__ __forceinline__ int perm32(int rho) { const int n = rho >> 4, i = rho & 15; return 8 * (i >> 2) + 4 * n + (i & 3); }

struct Unit { int pm, pn, kt0, nt; };
struct Gemm { const bf16_t* A; const bf16_t* Bt; int M, N, K; };

struct StaticOrder {
    int nM, nN, nwg, G, c, KT;
    __host__ __device__ void init(int M, int N, int G_, int c_, int K_ = 0) { nM = M / BM; nN = N / BM; nwg = nM * nN; G = G_; c = c_; KT = K_ / BK; }
    __host__ __device__ bool next(int i, Unit& u) const {
        const long L = (long)i * G + c; if (L >= nwg) return false;
        int wgid = (int)L; { const int q = nwg / NXCD, r = nwg % NXCD, xcd = wgid % NXCD, off = wgid / NXCD; wgid = (xcd < r ? xcd * (q + 1) : r * (q + 1) + (xcd - r) * q) + off; }
        const int nig = WGM * nN, gid = wgid / nig, fm = gid * WGM, gsz = (nM - fm) < WGM ? (nM - fm) : WGM;
        u.pm = fm + ((wgid % nig) % gsz); u.pn = (wgid % nig) / gsz; u.kt0 = 0; u.nt = KT; return true;
    }
    __device__ __forceinline__ void a_ready(const Unit&) const {}
    __device__ __forceinline__ void done(const Unit&) const {}
};
struct CountedOrder : StaticOrder {
    const unsigned* ready; unsigned need; unsigned* tmo;
    __device__ __forceinline__ void a_ready(const Unit& u) const {
        if ((int)threadIdx.x < 64) {
            const unsigned long long t0 = __builtin_amdgcn_s_memrealtime(); unsigned polls = 0;
            while ((unsigned)__builtin_amdgcn_readfirstlane(__hip_atomic_load(ready + 64 * u.pm, __ATOMIC_RELAXED, __HIP_MEMORY_SCOPE_AGENT)) < need) {
                if ((++polls & 255u) == 0u && __builtin_amdgcn_readfirstlane(__hip_atomic_load(tmo, __ATOMIC_RELAXED, __HIP_MEMORY_SCOPE_AGENT)) != 0u) break;
                if (__builtin_amdgcn_s_memrealtime() - t0 > 2000000ull) {
                    if ((int)threadIdx.x == 0) { unsigned expect = 0u; __hip_atomic_compare_exchange_strong(tmo + 1, &expect, 0x600u | (unsigned)(u.pm & 0xff), __ATOMIC_RELAXED, __ATOMIC_RELAXED, __HIP_MEMORY_SCOPE_AGENT); __hip_atomic_store(tmo, 1u, __ATOMIC_RELAXED, __HIP_MEMORY_SCOPE_AGENT); }
                    break; }
                __builtin_amdgcn_s_sleep(2); }
            __builtin_amdgcn_fence(__ATOMIC_ACQUIRE, "agent");
            asm volatile("s_waitcnt vmcnt(0)" ::: "memory");
        }
#if !defined(BROKEN_HOOK_NO_BARRIER)
        asm volatile("" ::: "memory"); __builtin_amdgcn_s_barrier(); asm volatile("" ::: "memory");
#endif
    }
};

__device__ __forceinline__ unsigned cvt_pk_bf16(float lo, float hi) { unsigned r; asm volatile("v_cvt_pk_bf16_f32 %0, %1, %2" : "=v"(r) : "v"(lo), "v"(hi)); return r; }
typedef float f32x2 __attribute__((ext_vector_type(2)));
__device__ __forceinline__ f32x2 gelu_pk(f32x2 v) {
    const f32x2 av = __builtin_elementwise_abs(v), d = av * 0.2316418882f + 1.0f;
    f32x2 t; t.x = __builtin_amdgcn_rcpf(d.x); t.y = __builtin_amdgcn_rcpf(d.y);
    f32x2 q = t * 0.5307027145f + (-0.7265760135f); q = q * t + 0.7107068705f; q = q * t + (-0.142248368f); q = q * t + 0.127414796f; q = q * t;
    const f32x2 s = (v * v) * (-0.72134752044f);
    f32x2 e; e.x = __builtin_amdgcn_exp2f(s.x); e.y = __builtin_amdgcn_exp2f(s.y);
    const f32x2 m = v * (q * e), r = v - m;
    f32x2 o; o.x = v.x < 0.f ? m.x : r.x; o.y = v.y < 0.f ? m.y : r.y; return o;
}

struct EpiF32 {
    static constexpr bool PERM = false, AFTER_DRAIN = false;
    float* C; int ldc; const float* bias;
    __device__ __forceinline__ void operator()(const f32x4 (&acc)[2][2][4][2], const Unit& u, int wr, int wc, int fr, int fq) const {
        const int row0 = u.pm * BM + wr * 64 + fr, col0 = u.pn * BM + wc * 32 + 4 * fq;
        f32x4 bv[2][2];
#pragma unroll
        for (int bj = 0; bj < 2; ++bj)
#pragma unroll
            for (int n = 0; n < 2; ++n) bv[bj][n] = bias ? *(const f32x4*)(bias + col0 + bj * HALF + n * 16) : (f32x4){0.f, 0.f, 0.f, 0.f};
#pragma unroll
        for (int ai = 0; ai < 2; ++ai)
#pragma unroll
            for (int m = 0; m < 4; ++m) { float* rowp = C + (size_t)(row0 + ai * HALF + m * 16) * ldc + col0;
#pragma unroll
                for (int bj = 0; bj < 2; ++bj)
#pragma unroll
                    for (int n = 0; n < 2; ++n) *(f32x4*)(rowp + bj * HALF + n * 16) = acc[ai][bj][m][n] + bv[bj][n]; }
    }
};
template <int ACT  > struct EpiBf16 {
    static constexpr bool PERM = true, AFTER_DRAIN = false;
    bf16_t* O; int ldc; const float* bias; int split_cols; size_t split_stride;
    __device__ __forceinline__ void operator()(const f32x4 (&acc)[2][2][4][2], const Unit& u, int wr, int wc, int fr, int fq) const {
        const int row0 = u.pm * BM + wr * 64 + fr; int colt = u.pn * BM; bf16_t* base = O;
        if (split_cols) { const int t = colt / split_cols; base += (size_t)t * split_stride; colt -= t * split_cols; }
        const int col0 = colt + wc * 32 + 8 * fq, bcol0 = u.pn * BM + wc * 32 + 8 * fq;
        f32x4 bv[2][2];
#pragma unroll
        for (int bj = 0; bj < 2; ++bj)
#pragma unroll
            for (int n = 0; n < 2; ++n) bv[bj][n] = bias ? *(const f32x4*)(bias + bcol0 + bj * HALF + 4 * n) : (f32x4){0.f, 0.f, 0.f, 0.f};
#pragma unroll
        for (int ai = 0; ai < 2; ++ai)
#pragma unroll
            for (int m = 0; m < 4; ++m) { bf16_t* rowp = base + (size_t)(row0 + ai * HALF + m * 16) * ldc + col0;
#pragma unroll
                for (int bj = 0; bj < 2; ++bj) { f32x4 v0 = acc[ai][bj][m][0] + bv[bj][0], v1 = acc[ai][bj][m][1] + bv[bj][1];
                    if (ACT == 1) { f32x2 a = gelu_pk((f32x2){v0[0], v0[1]}), b = gelu_pk((f32x2){v0[2], v0[3]}), c = gelu_pk((f32x2){v1[0], v1[1]}), d = gelu_pk((f32x2){v1[2], v1[3]});
                        v0 = (f32x4){a.x, a.y, b.x, b.y}; v1 = (f32x4){c.x, c.y, d.x, d.y}; }
                    if (ACT == 2) {
#pragma unroll
                        for (int j = 0; j < 4; ++j) { v0[j] = 0.5f * v0[j] * (1.0f + erff(v0[j] * 0.70710678f)); v1[j] = 0.5f * v1[j] * (1.0f + erff(v1[j] * 0.70710678f)); } }
                    u32x4 w; w.x = cvt_pk_bf16(v0[0], v0[1]); w.y = cvt_pk_bf16(v0[2], v0[3]); w.z = cvt_pk_bf16(v1[0], v1[1]); w.w = cvt_pk_bf16(v1[2], v1[3]);
                    *(u32x4*)(rowp + bj * HALF) = w; } }
    }
};

template <class Epi, class Sched, bool STAMP = false>
__device__ __forceinline__ void gemm_phase(PG8_LAS unsigned char* lds, const Gemm g, const Sched& S, const Epi& E, unsigned long long* stamps, const int wave_s__) {
    const int tid = ltid(wave_s__), wid = __builtin_amdgcn_readfirstlane(tid >> 6), lane = tid & 63, wr = wid >> 2, wc = wid & 3, fr = lane & 15, fq = lane >> 4;
    const int K = g.K; int nt;
    int ts_lo = 0, ts_hi = 0, nts = 0; const unsigned long long rt_entry = STAMP ? (unsigned long long)wall_clock64() : 0ull;
#define PG8_STAMP() do { if (STAMP && wid == 0 && nts < 64) { const unsigned long long _c = (unsigned long long)clock64(); \
        ts_lo = (lane == nts) ? (int)(unsigned)_c : ts_lo; ts_hi = (lane == nts) ? (int)(unsigned)(_c >> 32) : ts_hi; ++nts; } } while (0)
    PG8_STAMP();
    unsigned voffA[2], voffB[2];
#pragma unroll
    for (int i = 0; i < 2; ++i) { int R, C; stage_rc(tid * 16 + i * 8192, R, C); const int Rb = Epi::PERM ? ((R & ~31) + perm32(R & 31)) : R;
        voffA[i] = (unsigned)(R * K + C) * 2u; voffB[i] = (unsigned)(Rb * K + C) * 2u; }
    const size_t kstep = (size_t)(BK * 2);
    const size_t hstep = (size_t)HALF * K * 2;
    const size_t tstep = 2 * hstep;
    const unsigned ldsw = (unsigned)wid * 1024u;
    const int aoff = lds_byte(wr * 64 + fr, fq * 8), boff = lds_byte(wc * 32 + fr, fq * 8);
#define PG8_SA(b, h) (((b) * 2 + (h)) * HTB)
#define PG8_SB(b, h) ((4 + (b) * 2 + (h)) * HTB)
#define PG8_STAGE(bufoff, gbase, voff) do { _Pragma("unroll") for (int _i = 0; _i < 2; ++_i) \
        __builtin_amdgcn_global_load_lds((const unsigned*)((const char*)(gbase) + (voff)[_i]), (PG8_LAS unsigned*)(lds + (bufoff) + ldsw + _i * 8192), 16, 0, 0); } while (0)
#define PG8_LDA(dst, b, h) do { _Pragma("unroll") for (int m = 0; m < 4; ++m) _Pragma("unroll") for (int k = 0; k < 2; ++k) dst[m][k] = *(const PG8_LAS bf16x8*)(lds + PG8_SA(b, h) + aoff + m * 2048 + k * 1024); } while (0)
#define PG8_LDB(dst, b, h) do { _Pragma("unroll") for (int n = 0; n < 2; ++n) _Pragma("unroll") for (int k = 0; k < 2; ++k) dst[n][k] = *(const PG8_LAS bf16x8*)(lds + PG8_SB(b, h) + boff + n * 2048 + k * 1024); } while (0)
#define PG8_MMA(ai, bj, At, Bt) do { __builtin_amdgcn_s_setprio(1); _Pragma("unroll") for (int m = 0; m < 4; ++m) _Pragma("unroll") for (int n = 0; n < 2; ++n) _Pragma("unroll") for (int k = 0; k < 2; ++k) \
        acc[ai][bj][m][n] = __builtin_amdgcn_mfma_f32_16x16x32_bf16(Bt[n][k], At[m][k], acc[ai][bj][m][n], 0, 0, 0); __builtin_amdgcn_s_setprio(0); } while (0)
#define PG8_WAIT_V(n) asm volatile("s_waitcnt vmcnt(" #n ")" ::: "memory")
#define PG8_WAIT_L(n) asm volatile("s_waitcnt lgkmcnt(" #n ")" ::: "memory")
#define PG8_BAR __builtin_amdgcn_s_barrier()
#define PG8_SCHED __builtin_amdgcn_sched_barrier(0)
    Unit cur, nxt; int ui = 0;
    if (!S.next(0, cur)) return;
    f32x4 acc[2][2][4][2];
#pragma unroll
    for (int a = 0; a < 2; ++a)
#pragma unroll
        for (int b = 0; b < 2; ++b)
#pragma unroll
            for (int m = 0; m < 4; ++m)
#pragma unroll
                for (int n = 0; n < 2; ++n) acc[a][b][m][n] = (f32x4){0.f, 0.f, 0.f, 0.f};
    bf16x8 At[4][2], B0[2][2], B1[2][2];
    nt = cur.nt;
    const char* cA = (const char*)g.A + (size_t)cur.pm * tstep + (size_t)cur.kt0 * kstep; const char* cB = (const char*)g.Bt + (size_t)cur.pn * tstep + (size_t)cur.kt0 * kstep;
    S.a_ready(cur);
    PG8_STAGE(PG8_SB(0, 0), cB, voffB); PG8_STAGE(PG8_SA(0, 0), cA, voffA); PG8_STAGE(PG8_SB(0, 1), cB + hstep, voffB); PG8_STAGE(PG8_SA(0, 1), cA + hstep, voffA);
    if (wr == 1) PG8_BAR;
    PG8_WAIT_V(4); PG8_BAR;
    PG8_STAGE(PG8_SB(1, 0), cB + kstep, voffB); PG8_STAGE(PG8_SA(1, 0), cA + kstep, voffA); PG8_STAGE(PG8_SB(1, 1), cB + hstep + kstep, voffB);
    PG8_WAIT_V(6); PG8_BAR;
    PG8_STAMP();
    for (;;) {
        const bool has_next = S.next(ui + 1, nxt);
        const char* nA = has_next ? (const char*)g.A + (size_t)nxt.pm * tstep + (size_t)nxt.kt0 * kstep : cA; const char* nB = has_next ? (const char*)g.Bt + (size_t)nxt.pn * tstep + (size_t)nxt.kt0 * kstep : cB;
        for (int t = 0; t < nt; t += 2) {
            const bool last = (t == nt - 2);
            const char* a1 = cA + (size_t)(t + 1) * kstep;
            const char* a2 = last ? nA : cA + (size_t)(t + 2) * kstep; const char* b2 = last ? nB : cB + (size_t)(t + 2) * kstep;
            const char* a3 = a2 + kstep; const char* b3 = b2 + kstep;
            if (last && has_next) S.a_ready(nxt);
            PG8_LDB(B0, 0, 0); PG8_SCHED; PG8_LDA(At, 0, 0); PG8_STAGE(PG8_SA(1, 1), a1 + hstep, voffA);
            PG8_WAIT_L(8); PG8_BAR; PG8_WAIT_L(0); PG8_MMA(0, 0, At, B0); PG8_BAR; PG8_SCHED;
            PG8_LDB(B1, 0, 1); PG8_STAGE(PG8_SB(0, 0), b2, voffB);
            PG8_BAR; PG8_WAIT_L(0); PG8_MMA(0, 1, At, B1); PG8_BAR;
            PG8_LDA(At, 0, 1); PG8_STAGE(PG8_SA(0, 0), a2, voffA);
            PG8_BAR; PG8_WAIT_L(0); PG8_MMA(1, 0, At, B0); PG8_BAR; PG8_SCHED;
            PG8_STAGE(PG8_SB(0, 1), b2 + hstep, voffB);
            PG8_WAIT_V(6); PG8_BAR; PG8_MMA(1, 1, At, B1); PG8_BAR;
            PG8_LDB(B0, 1, 0); PG8_SCHED; PG8_LDA(At, 1, 0); PG8_STAGE(PG8_SA(0, 1), a2 + hstep, voffA);
            PG8_WAIT_L(8); PG8_BAR; PG8_WAIT_L(0); PG8_MMA(0, 0, At, B0); PG8_BAR; PG8_SCHED;
            PG8_LDB(B1, 1, 1); PG8_STAGE(PG8_SB(1, 0), b3, voffB);
            PG8_BAR; PG8_WAIT_L(0); PG8_MMA(0, 1, At, B1); PG8_BAR;
            PG8_LDA(At, 1, 1); PG8_STAGE(PG8_SA(1, 0), a3, voffA);
            PG8_BAR; PG8_WAIT_L(0); PG8_MMA(1, 0, At, B0); PG8_BAR; PG8_SCHED;
            PG8_STAGE(PG8_SB(1, 1), b3 + hstep, voffB);
            PG8_WAIT_V(6); PG8_BAR; PG8_MMA(1, 1, At, B1); PG8_BAR;
        }
        PG8_STAMP();
        if constexpr (!Epi::AFTER_DRAIN) { E(acc, cur, wr, wc, fr, fq); S.done(cur); }
        PG8_STAMP();
        if (!has_next) break;
#pragma unroll
        for (int a = 0; a < 2; ++a)
#pragma unroll
            for (int b = 0; b < 2; ++b)
#pragma unroll
                for (int m = 0; m < 4; ++m)
#pragma unroll
                    for (int n = 0; n < 2; ++n) acc[a][b][m][n] = (f32x4){0.f, 0.f, 0.f, 0.f};
        cur = nxt; cA = nA; cB = nB; ++ui; nt = cur.nt;
    }
    PG8_WAIT_V(0);
    if (wr == 0) PG8_BAR;
    PG8_BAR;
    if constexpr (Epi::AFTER_DRAIN) { E.fused(acc, cur, wr, wc, fr, fq, lds, wid, lane); S.done(cur); }
    PG8_STAMP();
    if (STAMP && wid == 0) { stamps[lane] = lane < nts ? (((unsigned long long)(unsigned)ts_hi << 32) | (unsigned)ts_lo) : 0ull;
        if (lane == 62) stamps[62] = rt_entry; if (lane == 63) stamps[63] = (unsigned long long)wall_clock64(); }
#undef PG8_STAMP
#undef PG8_SA
#undef PG8_SB
#undef PG8_STAGE
#undef PG8_LDA
#undef PG8_LDB
#undef PG8_MMA
#undef PG8_WAIT_V
#undef PG8_WAIT_L
#undef PG8_BAR
#undef PG8_SCHED
}
}

using pg8::bf16_t; using pg8::bf16x8; using pg8::f32x4; using pg8::u32x4;
typedef short s16x4 __attribute__((ext_vector_type(4)));
typedef float f32x16 __attribute__((ext_vector_type(16)));
typedef unsigned u32x2 __attribute__((ext_vector_type(2)));
#define LAS __attribute__((address_space(3)))
#define DI __device__ __forceinline__
#define MFMA32(a, b, c) __builtin_amdgcn_mfma_f32_32x32x16_bf16((a), (b), (c), 0, 0, 0)

constexpr int NB = 8, LL = 2064, NMETA = 16, DM = 2048, MTOK = NB * LL, MPAD = 16640;
constexpr int EVEN_IN = 15360, ODD_IN = 16384, MIXW = 4096;
constexpr int ODD_LD = ODD_IN;
constexpr int LDS_BYTES = 131072 + 1024;
#ifndef PHM
#define PHM 255
#endif
constexpr float LOG2E = 1.4426950408889634f, LN2 = 0.6931471805599453f;

constexpr size_t OFF_H = 0;
constexpr size_t OFF_HN = OFF_H + (size_t)MPAD * DM * 4;
constexpr size_t OFF_Z = OFF_HN + (size_t)MPAD * DM * 2;
constexpr size_t OFF_MIX = OFF_Z + (size_t)MPAD * ODD_LD * 2;
constexpr size_t OFF_WIN = OFF_MIX + (size_t)MPAD * MIXW * 2;
constexpr size_t OFF_WOUT = OFF_WIN + (size_t)ODD_IN * DM * 2;
constexpr size_t OFF_WIN2 = OFF_WOUT + (size_t)DM * MIXW * 2;
constexpr size_t OFF_MISC = OFF_WIN2 + (size_t)ODD_IN * DM * 2;
constexpr size_t OFF_QCTR = OFF_MISC + 384;
constexpr size_t OFF_HFLAG = OFF_MISC + 4608;
constexpr size_t OFF_NRM = OFF_MISC + 512;
constexpr size_t OFF_PART = OFF_MISC + 8192;
constexpr size_t WS_END = OFF_PART + (size_t)16 * 128 * DM * 4;

struct Params {
    const float *x, *meta, *norm_a, *w_in_a, *w_out_a, *hgrn_lb, *hgrn_norm, *sink, *norm_c, *w_in_c, *w_out_c, *dlam, *dnorm, *fnorm;
    float* out; unsigned char* ws; int ph_lo, ph_hi, dup_e, dup_o;
};

DI unsigned cvt_pk(float lo, float hi) { unsigned r; asm("v_cvt_pk_bf16_f32 %0, %1, %2" : "=v"(r) : "v"(lo), "v"(hi)); return r; }
DI float bf2f(bf16_t x) { return __uint_as_float(((unsigned)x) << 16); }
DI float bflo(unsigned u) { return __uint_as_float(u << 16); }
DI float bfhi(unsigned u) { return __uint_as_float(u & 0xffff0000u); }
DI float ex2(float x) { return __builtin_amdgcn_exp2f(x); }
DI float lg2(float x) { return __builtin_amdgcn_logf(x); }
DI float rcpf(float x) { return __builtin_amdgcn_rcpf(x); }
DI float siluf(float x) { return x * rcpf(1.f + ex2(-x * LOG2E)); }
DI float wave_sum(float v) {
#pragma unroll
    for (int o = 32; o; o >>= 1) v += __shfl_xor(v, o);
    return v; }
DI float xhalf_max(float v) { const auto r = __builtin_amdgcn_permlane32_swap(__float_as_uint(v), __float_as_uint(v), false, false); return fmaxf(__uint_as_float(r[0]), __uint_as_float(r[1])); }
DI float xhalf_sum(float v) { const auto r = __builtin_amdgcn_permlane32_swap(__float_as_uint(v), __float_as_uint(v), false, false); return __uint_as_float(r[0]) + __uint_as_float(r[1]); }
DI int crow(int reg, int h) { return (reg & 3) + 8 * (reg >> 2) + 4 * h; }
DI f32x16 zero16() { f32x16 z;
#pragma unroll
    for (int i = 0; i < 16; ++i) z[i] = 0.f;
    return z; }

template <int MODE>
DI void row_phase(const Params& p, const float* __restrict__ g, const int wave_s__) {
    const int wid = ltid(wave_s__) >> 6, lane = ltid(wave_s__) & 63;
    float* H = (float*)(p.ws + OFF_H); bf16_t* HN = (bf16_t*)(p.ws + OFF_HN);
    for (int r = blockIdx.x * 8 + wid; r < MPAD; r += gridDim.x * 8) {
        if (r >= MTOK) {
            if (MODE == 0) {
#pragma unroll
                for (int j = 0; j < 8; ++j) { *(f32x4*)(H + (size_t)r * DM + (j * 64 + lane) * 4) = (f32x4){0.f, 0.f, 0.f, 0.f}; }
            }
            if (MODE != 2) {
#pragma unroll
                for (int j = 0; j < 8; ++j) { u32x2 zz; zz.x = 0u; zz.y = 0u; *(u32x2*)(HN + (size_t)r * DM + (j * 64 + lane) * 4) = zz; }
            }
            continue;
        }
        const int b = r / LL, t = r - b * LL;
        const float* src;
        if (MODE == 0) src = (t < NMETA) ? (p.meta + (size_t)t * DM) : (p.x + ((size_t)b * 2048 + (t - NMETA)) * DM);
        else src = H + (size_t)r * DM;
        f32x4 v[8]; float ss = 0.f;
#pragma unroll
        for (int j = 0; j < 8; ++j) v[j] = *(const f32x4*)(src + (j * 64 + lane) * 4);
        if (MODE != 0 && r >= 16384) {
            const float* pp = (const float*)(p.ws + OFF_PART) + (size_t)(r - 16384) * DM;
            for (int sp = 0; sp < 16; ++sp) {
#pragma unroll
                for (int j = 0; j < 8; ++j) v[j] = v[j] + *(const f32x4*)(pp + (size_t)sp * 128 * DM + (j * 64 + lane) * 4); }
            if (MODE == 1) {
#pragma unroll
                for (int j = 0; j < 8; ++j) *(f32x4*)(H + (size_t)r * DM + (j * 64 + lane) * 4) = v[j]; }
        }
#pragma unroll
        for (int j = 0; j < 8; ++j) ss += v[j][0] * v[j][0] + v[j][1] * v[j][1] + v[j][2] * v[j][2] + v[j][3] * v[j][3];
        ss = wave_sum(ss);
        const float rstd = rsqrtf(ss * (1.f / DM) + 1e-6f);
        if (MODE == 0 && r >= 16384) {
#pragma unroll
            for (int j = 0; j < 8; ++j) *(f32x4*)(H + (size_t)r * DM + (j * 64 + lane) * 4) = v[j];
        }
        if (MODE == 2) {
            if (t >= NMETA) { float* op = p.out + ((size_t)b * 2048 + (t - NMETA)) * DM;
#pragma unroll
                for (int j = 0; j < 8; ++j) { const f32x4 gg = *(const f32x4*)(g + (j * 64 + lane) * 4); f32x4 o; o[0] = v[j][0] * rstd * gg[0]; o[1] = v[j][1] * rstd * gg[1]; o[2] = v[j][2] * rstd * gg[2]; o[3] = v[j][3] * rstd * gg[3];
                    *(f32x4*)(op + (j * 64 + lane) * 4) = o; } }
        } else {
#pragma unroll
            for (int j = 0; j < 8; ++j) { const f32x4 gg = *(const f32x4*)(g + (j * 64 + lane) * 4); u32x2 w; w.x = cvt_pk(v[j][0] * rstd * gg[0], v[j][1] * rstd * gg[1]); w.y = cvt_pk(v[j][2] * rstd * gg[2], v[j][3] * rstd * gg[3]);
                *(u32x2*)(HN + (size_t)r * DM + (j * 64 + lane) * 4) = w; }
        }
    }
}

DI void convert_T(LAS unsigned char* lds, const float* __restrict__ W, bf16_t* __restrict__ Wt, const int K, const int N, const int wave_s__, const int first = 0) {
    LAS float* tile = (LAS float*)lds;
    const int tid = ltid(wave_s__), nk = K >> 6, ntile = nk * (N >> 8);
    const int tx = tid & 63, ty = tid >> 6, wn = tid >> 3, wk = (tid & 7) * 8;
    if ((int)blockIdx.x < first) return;
    for (int t = (int)blockIdx.x - first; t < ntile; t += (int)gridDim.x - first) {
        const int k0 = (t % nk) << 6, n0 = (t / nk) << 8;
        float r[4][8];
#pragma unroll
        for (int c = 0; c < 4; ++c)
#pragma unroll
            for (int i = 0; i < 8; ++i) r[c][i] = __builtin_nontemporal_load(W + (size_t)(k0 + ty * 8 + i) * N + n0 + c * 64 + tx);
#pragma unroll
        for (int c = 0; c < 4; ++c) {
#pragma unroll
            for (int i = 0; i < 8; ++i) tile[(ty * 8 + i) * 65 + tx] = r[c][i];
            __syncthreads();
            float e[8];
#pragma unroll
            for (int i = 0; i < 8; ++i) e[i] = tile[(wk + i) * 65 + wn];
            u32x4 w; w.x = cvt_pk(e[0], e[1]); w.y = cvt_pk(e[2], e[3]); w.z = cvt_pk(e[4], e[5]); w.w = cvt_pk(e[6], e[7]);
            *(u32x4*)(Wt + (size_t)(n0 + c * 64 + wn) * K + k0 + wk) = w;
            __syncthreads();
        }
    }
}

struct EpiResAdd {
    static constexpr bool PERM = false, AFTER_DRAIN = false;
    float* H; int ldc; float* P; const float* x0; const float* meta0;
    DI void operator()(const f32x4 (&acc)[2][2][4][2], const pg8::Unit& u, int wr, int wc, int fr, int fq) const {
        const int row0 = u.pm * pg8::BM + wr * 64 + fr, col0 = u.pn * pg8::BM + wc * 32 + 4 * fq;
        if (u.nt != MIXW / 64) {
            float* pb = P + ((size_t)(u.kt0 >> 2) * 128 + (row0 - 16384)) * DM + col0;
#pragma unroll
            for (int m = 0; m < 4; ++m)
#pragma unroll
                for (int bj = 0; bj < 2; ++bj)
#pragma unroll
                    for (int n = 0; n < 2; ++n) *(f32x4*)(pb + (size_t)(m * 16) * DM + bj * pg8::HALF + n * 16) = acc[0][bj][m][n];
            return;
        }
#pragma unroll
        for (int ai = 0; ai < 2; ++ai)
#pragma unroll
            for (int m = 0; m < 4; ++m) { const int row = row0 + ai * pg8::HALF + m * 16; float* rowp = H + (size_t)row * ldc + col0;
                const float* srcp = rowp;
                if (x0) { const int b = row / LL, t = row - b * LL; srcp = (t < NMETA ? meta0 + (size_t)t * DM : x0 + ((size_t)b * 2048 + (t - NMETA)) * DM) + col0; }
#pragma unroll
                for (int bj = 0; bj < 2; ++bj)
#pragma unroll
                    for (int n = 0; n < 2; ++n) { *(f32x4*)(rowp + bj * pg8::HALF + n * 16) = *(const f32x4*)(srcp + bj * pg8::HALF + n * 16) + acc[ai][bj][m][n]; } }
    }
};

template <int NDV, int NK, bool WINM>
DI void attn_unit(LAS unsigned char* lds, const bf16_t* __restrict__ zb, const int ldz, const int qcol, const int kcol0, const int kcol1, const int vcol,
                  const int gcol, const int ocol, const float c2, const float sink2, const int t0, const int lo, const int nt,
                  bf16_t* __restrict__ mixb, const float lam, const float* __restrict__ normg, const float oscale, const int wave_s__) {
    constexpr int DV = NDV * 32, ROWB = DV * 2, KBY = 8192, VBY = 32 * ROWB, BUFB = NK * KBY + VBY, NI = (NK * KBY + VBY) / 1024, NPW = NI / 8;
    static_assert(3 * BUFB <= LDS_BYTES && NI % 8 == 0, "attention tile buffers");
    const int tid = ltid(wave_s__), wid = tid >> 6, lane = tid & 63, r32 = lane & 31, half = lane >> 5, j = wid >> 2, wq = wid & 3;
    const int tq = t0 + wq * 32 + r32;
    const float c1 = 0.08838834764831845f * LOG2E;
    bf16x8 qf[8];
    { const bf16_t* qp = zb + (size_t)tq * ldz + qcol + half * 8;
#pragma unroll
      for (int ks = 0; ks < 8; ++ks) qf[ks] = *(const bf16x8*)(qp + ks * 16); }
    f32x16 o[NDV];
#pragma unroll
    for (int n = 0; n < NDV; ++n) o[n] = zero16();
    float m = -1e30f, l = 0.f;
    unsigned soff[NPW]; int ddst[NPW];
#pragma unroll
    for (int e = 0; e < NPW; ++e) { const int qi = wid * NPW + e;
        if (qi < NK * 8) { const int mp = qi >> 3, r4 = qi & 7; const int row = 4 * r4 + (lane >> 4), slot = (lane & 15) ^ (row & 15);
            soff[e] = (unsigned)(row * ldz + (mp ? kcol1 : kcol0) + slot * 8) * 2u; ddst[e] = mp * KBY + r4 * 1024; }
        else { const int qv = qi - NK * 8; constexpr int SPR = DV / 8, RPI = 1024 / ROWB; const int row = qv * RPI + lane / SPR, ps = lane % SPR; const int ls = (((ps >> 2) ^ (row & 3)) << 2) | (ps & 3);
            soff[e] = (unsigned)(row * ldz + vcol + ls * 8) * 2u; ddst[e] = NK * KBY + qv * 1024; } }
#define ATT_DMA(tile_, buf_) do { const char* tb_ = (const char*)(zb + (size_t)(32 * (tile_)) * ldz); \
        _Pragma("unroll") for (int e = 0; e < NPW; ++e) __builtin_amdgcn_global_load_lds((const unsigned*)(tb_ + soff[e]), (LAS unsigned*)(lds + (buf_) * BUFB + ddst[e]), 16, 0, 0); } while (0)
#define ATT_BAR() do { asm volatile("" ::: "memory"); __builtin_amdgcn_s_barrier(); asm volatile("" ::: "memory"); } while (0)
    const int td = t0 >> 5, ndiag = (65 - td) < 4 ? (65 - td) : 4, nleft = td - lo;
#define ATT_TILE(it_) (WINM ? ((it_) == 0 ? 0 : lo + (it_) - 1) : ((it_) < ndiag ? td + (it_) : ((it_) < ndiag + nleft ? td - 1 - ((it_) - ndiag) : td + (it_) - nleft)))
    const int kbase = (NK == 2 ? j * KBY : 0) + r32 * 256 + ((((r32 & 15) ^ half) & 1) << 4) + ((r32 & 14) << 4);
    const int q4 = (lane >> 2) & 3, p4 = lane & 3, blk = (lane >> 4) & 1;
    int vb[4];
#pragma unroll
    for (int c = 0; c < 4; ++c) vb[c] = NK * KBY + (4 * half + q4) * ROWB + ((c ^ q4) << 6) + blk * 32 + 8 * p4;
    ATT_DMA(ATT_TILE(0), 0);
    asm volatile("s_waitcnt vmcnt(0)" ::: "memory");
    ATT_BAR();
    f32x16 st = zero16();
    u32x4 pk0, pk1; pk0.x = pk0.y = pk0.z = pk0.w = 0u; pk1 = pk0;
    bool pv_act = false;
    for (int ph = 0; ph < 2 * nt + 2; ++ph) {
        if (((ph + j) & 1) == 0) {
            const int idx = (ph - j) >> 1;
            if (idx >= 1 && pv_act) {
                const int bo = ((idx - 1) % 3) * BUFB;
                const bf16x8 pb0 = __builtin_bit_cast(bf16x8, pk0), pb1 = __builtin_bit_cast(bf16x8, pk1);
                bf16x8 av[3];
#define ATT_VLD1(k_, dst_) do { const int s2_ = (k_) / NDV, n_ = (k_) % NDV; LAS unsigned char* vp_ = lds + bo + vb[n_ & 3] + (n_ >> 2) * 256 + (16 * s2_) * ROWB; \
                        const s16x4 lo4_ = __builtin_amdgcn_ds_read_tr16_b64_v4i16((LAS s16x4*)vp_); const s16x4 hi4_ = __builtin_amdgcn_ds_read_tr16_b64_v4i16((LAS s16x4*)(vp_ + 8 * ROWB)); \
                        dst_ = __builtin_shufflevector(lo4_, hi4_, 0, 1, 2, 3, 4, 5, 6, 7); } while (0)
                ATT_VLD1(0, av[0]); ATT_VLD1(1, av[1]);
#pragma unroll
                for (int k = 0; k < 2 * NDV; ++k) {
                    if (k + 2 < 2 * NDV) ATT_VLD1(k + 2, av[(k + 2) % 3]);
                    __builtin_amdgcn_sched_barrier(0);
                    o[k % NDV] = MFMA32(av[k % 3], (k / NDV) ? pb1 : pb0, o[k % NDV]);
                    __builtin_amdgcn_sched_barrier(0);
                }
#undef ATT_VLD1
            }
            if (idx < nt) {
                const int ka = (idx % 3) * BUFB + kbase;
                st = zero16();
                bf16x8 ak[3];
                ak[0] = *(LAS bf16x8*)(lds + ka); ak[1] = *(LAS bf16x8*)(lds + (ka ^ 32));
#pragma unroll
                for (int ks = 0; ks < 8; ++ks) { if (ks + 2 < 8) ak[(ks + 2) % 3] = *(LAS bf16x8*)(lds + (ka ^ ((ks + 2) << 5)));
                    __builtin_amdgcn_sched_barrier(0);
                    st = MFMA32(ak[ks % 3], qf[ks], st);
                    __builtin_amdgcn_sched_barrier(0); }
            }
        } else {
            const int idx = (ph - j - 1) >> 1;
            { const int ti = idx + 1 + j; if (ti < nt) ATT_DMA(ATT_TILE(ti), ti % 3); }
            if (idx >= 0 && idx < nt) {
                const int key0 = 32 * ATT_TILE(idx);
                const float basef = (float)(tq - key0 - 4 * half);
                const bool tail = (key0 + 32 > LL);
                float x[16]; float mx = -INFINITY;
                if (WINM || tail) {
#pragma unroll
                    for (int i = 0; i < 16; ++i) { const int off = 8 * (i >> 2) + (i & 3); float d = fabsf(basef - (float)off); bool valid;
                        const int s = key0 + 4 * half + off;
                        if (WINM) { const bool meta = s < NMETA; valid = meta || (d <= 128.f && s < LL); d = meta ? fminf(d, 128.f) : d; }
                        else valid = (s < LL);
                        float xv = fmaf(st[i], c1, -c2 * d); xv = valid ? xv : -INFINITY; x[i] = xv; mx = fmaxf(mx, xv); }
                } else if (key0 + 31 < t0 + wq * 32 || key0 > t0 + wq * 32 + 31) {
                    const bool left = key0 + 31 < t0 + wq * 32; const float cs = left ? c2 : -c2, cbs = (left ? -c2 : c2) * basef;
#pragma unroll
                    for (int i = 0; i < 16; ++i) { const int off = 8 * (i >> 2) + (i & 3);
                        float kb = fmaf((float)off, cs, cbs); asm volatile("" : "+v"(kb)); float sv = st[i]; asm volatile("" : "+v"(sv));
                        float xv = fmaf(sv, c1, kb); asm volatile("" : "+v"(xv)); x[i] = xv; mx = fmaxf(mx, xv); }
                } else {
#pragma unroll
                    for (int i = 0; i < 16; ++i) { const int off = 8 * (i >> 2) + (i & 3); float d = basef - (float)off; asm volatile("" : "+v"(d)); float sv = st[i]; asm volatile("" : "+v"(sv));
                        float kb = -c2 * fabsf(d); asm volatile("" : "+v"(kb)); float xv = fmaf(sv, c1, kb); asm volatile("" : "+v"(xv)); x[i] = xv; mx = fmaxf(mx, xv); }
                }
                mx = xhalf_max(mx);
                pv_act = __any(mx > m - 40.f) != 0;
                if (pv_act) {
                    const bool need = mx > m + 8.f;
                    if (__any(need)) {
                        const float mn = need ? mx : m; const float al = ex2(m - mn);
                        l *= al;
#pragma unroll
                        for (int n = 0; n < NDV; ++n)
#pragma unroll
                            for (int i = 0; i < 16; ++i) o[n][i] *= al;
                        m = mn;
                    }
                    float ps = 0.f;
#pragma unroll
                    for (int i = 0; i < 16; ++i) { float dm = x[i] - m; asm volatile("" : "+v"(dm)); x[i] = ex2(dm); ps += x[i]; }
                    l += ps;
                    pk0.x = cvt_pk(x[0], x[1]); pk0.y = cvt_pk(x[2], x[3]); pk0.z = cvt_pk(x[4], x[5]); pk0.w = cvt_pk(x[6], x[7]);
                    pk1.x = cvt_pk(x[8], x[9]); pk1.y = cvt_pk(x[10], x[11]); pk1.z = cvt_pk(x[12], x[13]); pk1.w = cvt_pk(x[14], x[15]);
                }
            }
        }
        if (ph & 1) { asm volatile("s_waitcnt vmcnt(0)" ::: "memory"); ATT_BAR(); }
    }
    __syncthreads();
#undef ATT_DMA
#undef ATT_BAR
#undef ATT_TILE
    float lt = xhalf_sum(l);
    if (WINM) lt += ex2(sink2 - m);
    const float inv = 1.f / lt;
    const bool tval = tq < LL;
    if (WINM) {
        { const bf16_t* gp = zb + (size_t)tq * ldz + gcol + 4 * half; bf16_t* op16 = mixb + (size_t)tq * MIXW + ocol + 8 * half;
#pragma unroll
            for (int n = 0; n < NDV; ++n)
#pragma unroll
                for (int g2 = 0; g2 < 2; ++g2) { u32x2 w[2];
#pragma unroll
                    for (int e = 0; e < 2; ++e) { const int g4 = 2 * g2 + e; const int dv = n * 32 + 8 * g4; const u32x2 gg = *(const u32x2*)(gp + dv);
                        w[e].x = cvt_pk(o[n][4 * g4] * inv * siluf(bflo(gg.x)), o[n][4 * g4 + 1] * inv * siluf(bfhi(gg.x)));
                        w[e].y = cvt_pk(o[n][4 * g4 + 2] * inv * siluf(bflo(gg.y)), o[n][4 * g4 + 3] * inv * siluf(bfhi(gg.y))); }
                    const auto rx = __builtin_amdgcn_permlane32_swap(w[0].x, w[1].x, false, false); const auto ry = __builtin_amdgcn_permlane32_swap(w[0].y, w[1].y, false, false);
                    u32x4 o16; o16.x = rx[0]; o16.y = ry[0]; o16.z = rx[1]; o16.w = ry[1];
                    if (tval) *(u32x4*)(op16 + n * 32 + 16 * g2) = o16; } }
    } else {
        LAS float* xb = (LAS float*)lds + wq * (DV * 32) + 128 * half + r32;
        if (j == 1) { const float sc = inv * lam;
#pragma unroll
            for (int n = 0; n < NDV; ++n)
#pragma unroll
                for (int i = 0; i < 16; ++i) xb[(n * 32 + 8 * (i >> 2) + (i & 3)) * 32] = o[n][i] * sc; }
        __syncthreads();
        if (j == 0) { float ss = 0.f;
#pragma unroll
            for (int n = 0; n < NDV; ++n)
#pragma unroll
                for (int i = 0; i < 16; ++i) { const float v = o[n][i] * inv - xb[(n * 32 + 8 * (i >> 2) + (i & 3)) * 32]; o[n][i] = v; ss += v * v; }
            ss = xhalf_sum(ss);
            const float rstd = rsqrtf(ss * (1.f / DV) + 1e-6f) * oscale;
            const float* ngp = normg; asm volatile("" : "+s"(ngp)); ngp += 4 * half;
            { const bf16_t* gp = zb + (size_t)tq * ldz + gcol + 4 * half; bf16_t* op16 = mixb + (size_t)tq * MIXW + ocol + 8 * half;
#pragma unroll
                for (int n = 0; n < NDV; ++n)
#pragma unroll
                    for (int g2 = 0; g2 < 2; ++g2) { u32x2 w[2];
#pragma unroll
                        for (int e = 0; e < 2; ++e) { const int g4 = 2 * g2 + e; const int dv = n * 32 + 8 * g4; const u32x2 gg = *(const u32x2*)(gp + dv); const f32x4 ng = *(const f32x4*)(ngp + dv);
                            w[e].x = cvt_pk(o[n][4 * g4] * rstd * ng[0] * siluf(bflo(gg.x)), o[n][4 * g4 + 1] * rstd * ng[1] * siluf(bfhi(gg.x)));
                            w[e].y = cvt_pk(o[n][4 * g4 + 2] * rstd * ng[2] * siluf(bflo(gg.y)), o[n][4 * g4 + 3] * rstd * ng[3] * siluf(bfhi(gg.y))); }
                        const auto rx = __builtin_amdgcn_permlane32_swap(w[0].x, w[1].x, false, false); const auto ry = __builtin_amdgcn_permlane32_swap(w[0].y, w[1].y, false, false);
                        u32x4 o16; o16.x = rx[0]; o16.y = ry[0]; o16.z = rx[1]; o16.w = ry[1];
                        if (tval) *(u32x4*)(op16 + n * 32 + 16 * g2) = o16; } }
        }
        __syncthreads();
    }
}

DI void hgrn_seq(LAS unsigned char* lds, const bf16_t* __restrict__ zb, const int ldz, const int h, const int dir, const float lbv, bf16_t* __restrict__ dst, const int ldd, const int wave_s__) {
    constexpr int QC = 0, KH = 17408, KT = 34816, VT = 53248, SL = 71680, SC = 106496, TOT = 115712, E1 = 117760, GM = 118272;
    const int tid = ltid(wave_s__), wid = tid >> 6, lane = tid & 63, r32 = lane & 31, half = lane >> 5;
    const int k = tid & 127, tg = tid >> 7;
    const int fcol = dir ? 4096 : 2048;
    const int n = wid & 3, kt0 = 2 * (wid >> 2), ti = wid >> 2;
    LAS float* tot = (LAS float*)(lds + TOT); LAS float* e1p = (LAS float*)(lds + E1); LAS float* gmp = (LAS float*)(lds + GM);
    LAS float* e1l = e1p + kt0 * 32 + 4 * half; LAS float* gml = gmp + kt0 * 32 + 4 * half;
    f32x16 S[2]; S[0] = zero16(); S[1] = zero16();
    const float oml = 1.f - lbv;
    bf16_t rq[16], rf[16], rv[16];
#define HG_LOAD(c_) do { _Pragma("unroll") for (int e = 0; e < 16; ++e) { const int P_ = 64 * (c_) + tg * 16 + e; const int pp_ = dir ? 2111 - P_ : P_; const int t_ = pp_ - 48; const int tt_ = t_ < 0 ? 0 : t_; \
            const bf16_t* row_ = zb + (size_t)tt_ * ldz + h * 128 + k; rq[e] = row_[0]; rf[e] = row_[fcol]; rv[e] = row_[6144]; } } while (0)
    HG_LOAD(0);
    for (int c = 0; c < 33; ++c) {
        float qv[16], kk[16], bl[16]; unsigned vp[8]; float run = 0.f;
        {
            float vv[16];
#pragma unroll
            for (int e = 0; e < 16; ++e) {
                const int P = 64 * c + tg * 16 + e; const int pp = dir ? 2111 - P : P; const int t = pp - 48; const bool ok = t >= 0;
                const float q = bf2f(rq[e]), zf = bf2f(rf[e]), v = bf2f(rv[e]);
                const float ex = ex2(-zf * LOG2E), rden = rcpf(1.f + ex);
                const float lf = lg2((1.f + lbv * ex) * rden);
                run += ok ? lf : 0.f; bl[e] = run; qv[e] = ok ? q : 0.f; kk[e] = ok ? oml * ex * rden : 0.f; vv[e] = ok ? v : 0.f;
            }
#pragma unroll
            for (int e = 0; e < 8; ++e) vp[e] = cvt_pk(vv[2 * e], vv[2 * e + 1]);
        }
        tot[tg * 128 + k] = run;
        __syncthreads();
        {
            const float t0_ = tot[k], t1_ = tot[128 + k], t2_ = tot[256 + k], t3_ = tot[384 + k];
            const float off = (tg > 0 ? t0_ : 0.f) + (tg > 1 ? t1_ : 0.f) + (tg > 2 ? t2_ : 0.f);
            const float bmid = t0_ + t1_;
            if (tg == 0) { e1p[k] = ex2(bmid); gmp[k] = ex2(t2_ + t3_); }
            unsigned khp[8]; float khv[16];
#pragma unroll
            for (int e = 0; e < 16; ++e) { const float dq = off + bl[e] - bmid; const float qc = qv[e] * ex2(dq); khv[e] = kk[e] * ex2(-dq);
                const int i = tg * 16 + e;
                *(LAS bf16_t*)(lds + QC + i * 272 + k * 2) = (bf16_t)(cvt_pk(qc, qc) & 0xffffu);
                *(LAS bf16_t*)(lds + KH + i * 272 + k * 2) = (bf16_t)(cvt_pk(khv[e], khv[e]) & 0xffffu); }
#pragma unroll
            for (int e = 0; e < 8; ++e) khp[e] = cvt_pk(khv[2 * e], khv[2 * e + 1]);
            u32x4 w0, w1; w0.x = khp[0]; w0.y = khp[1]; w0.z = khp[2]; w0.w = khp[3]; w1.x = khp[4]; w1.y = khp[5]; w1.z = khp[6]; w1.w = khp[7];
            *(LAS u32x4*)(lds + KT + k * 144 + tg * 32) = w0; *(LAS u32x4*)(lds + KT + k * 144 + tg * 32 + 16) = w1;
            w0.x = vp[0]; w0.y = vp[1]; w0.z = vp[2]; w0.w = vp[3]; w1.x = vp[4]; w1.y = vp[5]; w1.z = vp[6]; w1.w = vp[7];
            *(LAS u32x4*)(lds + VT + k * 144 + tg * 32) = w0; *(LAS u32x4*)(lds + VT + k * 144 + tg * 32 + 16) = w1;
        }
        if (c + 1 < 33) HG_LOAD(c + 1);
        __syncthreads();
#pragma unroll
        for (int a = 0; a < 2; ++a) { const int kt = kt0 + a;
#pragma unroll
            for (int i = 0; i < 16; ++i) S[a][i] *= e1l[a * 32 + 8 * (i >> 2) + (i & 3)];
#pragma unroll
            for (int g4 = 0; g4 < 4; ++g4) { u32x2 w; w.x = cvt_pk(S[a][4 * g4], S[a][4 * g4 + 1]); w.y = cvt_pk(S[a][4 * g4 + 2], S[a][4 * g4 + 3]);
                *(LAS u32x2*)(lds + SL + (n * 32 + r32) * 272 + (kt * 32 + 8 * g4 + 4 * half) * 2) = w; } }
        if (wid < 4) { const int si = wid >> 1, tj = wid & 1;
            f32x16 acc = zero16();
            if (si <= tj) {
#pragma unroll
                for (int ks = 0; ks < 8; ++ks) { const bf16x8 a = *(LAS bf16x8*)(lds + KH + (si * 32 + r32) * 272 + ks * 32 + half * 16); const bf16x8 b = *(LAS bf16x8*)(lds + QC + (tj * 32 + r32) * 272 + ks * 32 + half * 16);
                    acc = MFMA32(a, b, acc); }
            }
            const int tt = tj * 32 + r32;
#pragma unroll
            for (int g4 = 0; g4 < 4; ++g4) { float v4[4];
#pragma unroll
                for (int q = 0; q < 4; ++q) { const int s = si * 32 + 8 * g4 + 4 * half + q; v4[q] = (s <= tt) ? acc[4 * g4 + q] : 0.f; }
                u32x2 w; w.x = cvt_pk(v4[0], v4[1]); w.y = cvt_pk(v4[2], v4[3]);
                *(LAS u32x2*)(lds + SC + tt * 144 + (si * 32 + 8 * g4 + 4 * half) * 2) = w; } }
        __syncthreads();
        { f32x16 acc = zero16();
#pragma unroll
          for (int ks = 0; ks < 8; ++ks) { const bf16x8 a = *(LAS bf16x8*)(lds + SL + (n * 32 + r32) * 272 + ks * 32 + half * 16); const bf16x8 b = *(LAS bf16x8*)(lds + QC + (ti * 32 + r32) * 272 + ks * 32 + half * 16);
              acc = MFMA32(a, b, acc); }
#pragma unroll
          for (int ss = 0; ss < 4; ++ss) { if (ss < 2 || ti == 1) { const bf16x8 a = *(LAS bf16x8*)(lds + VT + (n * 32 + r32) * 144 + ss * 32 + half * 16); const bf16x8 b = *(LAS bf16x8*)(lds + SC + (ti * 32 + r32) * 144 + ss * 32 + half * 16);
              acc = MFMA32(a, b, acc); } }
          const int P = 64 * c + ti * 32 + r32; const int pp = dir ? 2111 - P : P; const int t = pp - 48;
          if (t >= 0) { bf16_t* op = dst + (size_t)t * ldd + n * 32 + 4 * half;
#pragma unroll
              for (int g4 = 0; g4 < 4; ++g4) { u32x2 w; w.x = cvt_pk(acc[4 * g4], acc[4 * g4 + 1]); w.y = cvt_pk(acc[4 * g4 + 2], acc[4 * g4 + 3]); *(u32x2*)(op + 8 * g4) = w; } }
        }
#pragma unroll
        for (int a = 0; a < 2; ++a) { const int kt = kt0 + a;
#pragma unroll
            for (int ss = 0; ss < 4; ++ss) { const bf16x8 av = *(LAS bf16x8*)(lds + KT + (kt * 32 + r32) * 144 + ss * 32 + half * 16); const bf16x8 bv = *(LAS bf16x8*)(lds + VT + (n * 32 + r32) * 144 + ss * 32 + half * 16);
                S[a] = MFMA32(av, bv, S[a]); }
#pragma unroll
            for (int i = 0; i < 16; ++i) S[a][i] *= gml[a * 32 + 8 * (i >> 2) + (i & 3)]; }
    }
#undef HG_LOAD
    __syncthreads();
}

DI int xcd_unit(int i) { const int G = gridDim.x, c = blockIdx.x; return (G & 7) ? (i * G + c) : ((i * 8 + (c & 7)) * (G >> 3) + (c >> 3)); }


DI void fin_head(const Params& p, const int li, const int b, const int h, const int wave_s__) {
    const bf16_t* Z = (const bf16_t*)(p.ws + OFF_Z); bf16_t* MIX = (bf16_t*)(p.ws + OFF_MIX); const bf16_t* OF = (const bf16_t*)(p.ws + OFF_HN);
    const int lane = (int)__lane_id(), rr = lane >> 4, c8 = (lane & 15) * 8;
    const f32x4 g0 = *(const f32x4*)(p.hgrn_norm + li * 128 + c8), g1 = *(const f32x4*)(p.hgrn_norm + li * 128 + c8 + 4);
    for (int t0 = wave_s__ * 16; t0 < LL; t0 += 128) {
        u32x4 a[4], c[4], gt[4];
#pragma unroll
        for (int q = 0; q < 4; ++q) { const int t = t0 + q * 4 + rr; const size_t r = (size_t)b * LL + (t < LL ? t : LL - 1);
            a[q] = *(const u32x4*)(OF + r * DM + h * 128 + c8); c[q] = *(const u32x4*)(MIX + r * MIXW + h * 128 + c8); gt[q] = *(const u32x4*)(Z + r * EVEN_IN + 8192 + h * 128 + c8); }
#pragma unroll
        for (int q = 0; q < 4; ++q) { const int t = t0 + q * 4 + rr; float v[8]; float ss = 0.f;
#pragma unroll
            for (int w = 0; w < 4; ++w) { v[2 * w] = bflo(a[q][w]) + bflo(c[q][w]); v[2 * w + 1] = bfhi(a[q][w]) + bfhi(c[q][w]); ss += v[2 * w] * v[2 * w] + v[2 * w + 1] * v[2 * w + 1]; }
            ss += __shfl_xor(ss, 1); ss += __shfl_xor(ss, 2); ss += __shfl_xor(ss, 4); ss += __shfl_xor(ss, 8);
            const float rstd = rsqrtf(ss * (1.f / 128) + 1e-6f);
            u32x4 w4;
#pragma unroll
            for (int w = 0; w < 4; ++w) { const float ga = (w < 2) ? g0[2 * w] : g1[2 * w - 4], gb = (w < 2) ? g0[2 * w + 1] : g1[2 * w - 3];
                w4[w] = cvt_pk(v[2 * w] * rstd * ga * siluf(bflo(gt[q][w])), v[2 * w + 1] * rstd * gb * siluf(bfhi(gt[q][w]))); }
            if (t < LL) *(u32x4*)(MIX + ((size_t)b * LL + t) * MIXW + h * 128 + c8) = w4; }
    }
}

DI void mix_even(const Params& p, LAS unsigned char* lds, const int li, const int wave_s__) {
    const bf16_t* Z = (const bf16_t*)(p.ws + OFF_Z); bf16_t* MIX = (bf16_t*)(p.ws + OFF_MIX); bf16_t* HN = (bf16_t*)(p.ws + OFF_HN);
    const int k = ltid(wave_s__) & 127, wid = ltid(wave_s__) >> 6;
    for (int u = blockIdx.x; u < 256; u += gridDim.x) {
        const int b = u >> 5, h = (u >> 1) & 15, dir = u & 1;
        float lbv = 0.f;
        if (li == 1) { const float a0 = p.hgrn_lb[(size_t)(dir * 2 + 0) * 2048 + h * 128 + k], a1 = p.hgrn_lb[(size_t)(dir * 2 + 1) * 2048 + h * 128 + k]; lbv = 1.f / (1.f + __expf(a0 - a1)); }
        hgrn_seq(lds, Z + (size_t)b * LL * EVEN_IN, EVEN_IN, h, dir, lbv, dir ? (MIX + (size_t)b * LL * MIXW + h * 128) : (HN + (size_t)b * LL * DM + h * 128), dir ? MIXW : DM, wave_s__);
        unsigned* hf = (unsigned*)(p.ws + OFF_HFLAG) + li * 128 + b * 16 + h;
        if (wave_s__ == 0 && __lane_id() == 0) { __threadfence(); __hip_atomic_fetch_add(hf, 1u, __ATOMIC_RELEASE, __HIP_MEMORY_SCOPE_AGENT);
            if (dir) { while (__hip_atomic_load(hf, __ATOMIC_RELAXED, __HIP_MEMORY_SCOPE_AGENT) < 2u) __builtin_amdgcn_s_sleep(2);
                __builtin_amdgcn_fence(__ATOMIC_ACQUIRE, "agent"); } }
        if (dir) { __syncthreads(); fin_head(p, li, b, h, wave_s__); __syncthreads(); }
    }
    const int j = wid >> 2;
    for (int i = 0;; ++i) {
        const int u = xcd_unit(i); if (u >= 1088) break;
        const int qb = u % 17, r = u / 17, pair = r & 1, kvh = (r >> 1) & 3, b = r >> 3;
        const int hq = kvh * 4 + pair * 2 + j;
        const float slope = exp2f(-0.5f * (float)(hq + 1));
        const int t0 = qb * 128;
        const int lo = (t0 - 128) < 32 ? 1 : ((t0 - 128) >> 5);
        const int hi = ((t0 + 255) >> 5) > 64 ? 64 : ((t0 + 255) >> 5);
        attn_unit<4, 1, true>(lds, Z + (size_t)b * LL * EVEN_IN, EVEN_IN, 10240 + hq * 128, 12288 + kvh * 128, 0, 12800 + kvh * 128, 13312 + hq * 128, 2048 + hq * 128,
                              slope * LOG2E, p.sink[li * 16 + hq] * LOG2E, t0, lo, 2 + hi - lo, MIX + (size_t)b * LL * MIXW, 0.f, nullptr, 0.f, wave_s__);
    }
}

DI void fin_even(const Params& p, const int li, const int wave_s__) {
    const bf16_t* Z = (const bf16_t*)(p.ws + OFF_Z); bf16_t* MIX = (bf16_t*)(p.ws + OFF_MIX); const bf16_t* OF = (const bf16_t*)(p.ws + OFF_HN);
    const int wid = ltid(wave_s__) >> 6, lane = ltid(wave_s__) & 63;
    const float* ng = p.hgrn_norm + li * 128 + (lane & 3) * 32;
    for (int r = blockIdx.x * 8 + wid; r < MTOK; r += gridDim.x * 8) {
        const bf16_t* f = OF + (size_t)r * DM + lane * 32; bf16_t* mb = MIX + (size_t)r * MIXW + lane * 32; const bf16_t* gp = Z + (size_t)r * EVEN_IN + 8192 + lane * 32;
        float v[32]; float ss = 0.f;
#pragma unroll
        for (int q = 0; q < 4; ++q) { const u32x4 a = *(const u32x4*)(f + q * 8), c = *(const u32x4*)(mb + q * 8);
#pragma unroll
            for (int w = 0; w < 4; ++w) { v[q * 8 + 2 * w] = bflo(a[w]) + bflo(c[w]); v[q * 8 + 2 * w + 1] = bfhi(a[w]) + bfhi(c[w]); } }
#pragma unroll
        for (int e = 0; e < 32; ++e) ss += v[e] * v[e];
        ss += __shfl_xor(ss, 1); ss += __shfl_xor(ss, 2);
        const float rstd = rsqrtf(ss * (1.f / 128) + 1e-6f);
#pragma unroll
        for (int q = 0; q < 4; ++q) { const u32x4 g = *(const u32x4*)(gp + q * 8); u32x4 w;
#pragma unroll
            for (int w_ = 0; w_ < 4; ++w_) { const int e = q * 8 + 2 * w_;
                w[w_] = cvt_pk(v[e] * rstd * ng[e] * siluf(bflo(g[w_])), v[e + 1] * rstd * ng[e + 1] * siluf(bfhi(g[w_]))); }
            *(u32x4*)(mb + q * 8) = w; }
    }
}


DI void qk_norm_pass(const Params& p, const int li, const int wave_s__) {
    const bf16_t* Z = (const bf16_t*)(p.ws + OFF_Z); unsigned* nrm = (unsigned*)(p.ws + OFF_NRM) + li * 512;
    const int lane = (int)__lane_id();
    const int gw = blockIdx.x * 8 + wave_s__, nw = gridDim.x * 8;
    const int per = (MTOK + nw - 1) / nw; const int r0 = gw * per, r1 = (r0 + per) < MTOK ? (r0 + per) : MTOK;
    float mxv[16]; int curb = -1;
#pragma unroll
    for (int jx = 0; jx < 16; ++jx) mxv[jx] = 0.f;
    for (int r = r0; r < r1; ++r) {
        const int b = r / LL;
        if (b != curb) { if (curb >= 0) {
#pragma unroll
                for (int jx = 0; jx < 16; ++jx) { if ((lane & 15) == 0) atomicMax(nrm + curb * 64 + jx * 4 + (lane >> 4), __float_as_uint(mxv[jx])); mxv[jx] = 0.f; } }
            curb = b; }
        const bf16_t* row = Z + (size_t)r * ODD_LD;
#pragma unroll
        for (int jx = 0; jx < 16; ++jx) { const u32x4 v = *(const u32x4*)(row + (jx * 64 + lane) * 8); float ss = 0.f;
#pragma unroll
            for (int w = 0; w < 4; ++w) { const float a = bflo(v[w]), c = bfhi(v[w]); ss += a * a + c * c; }
            ss += __shfl_xor(ss, 1); ss += __shfl_xor(ss, 2); ss += __shfl_xor(ss, 4); ss += __shfl_xor(ss, 8);
            mxv[jx] = fmaxf(mxv[jx], ss); }
    }
    if (curb >= 0) {
#pragma unroll
        for (int jx = 0; jx < 16; ++jx) if ((lane & 15) == 0) atomicMax(nrm + curb * 64 + jx * 4 + (lane >> 4), __float_as_uint(mxv[jx]));
    }
}

DI void mix_odd(const Params& p, LAS unsigned char* lds, const int li, const int layer, const int wave_s__) {
    const bf16_t* Z = (const bf16_t*)(p.ws + OFF_Z); bf16_t* MIX = (bf16_t*)(p.ws + OFF_MIX);
    const int lane = ltid(wave_s__) & 63, wid = ltid(wave_s__) >> 6, j = wid >> 2;
    const float lam_init = 0.8f - 0.6f * expf(-0.3f * (float)layer);
    const float lam = ((const float*)(p.ws + OFF_MISC))[li];
    unsigned* qctr = (unsigned*)(p.ws + OFF_QCTR) + li * 8;
    volatile LAS unsigned* qw = (volatile LAS unsigned*)(lds + 131072);
    for (int sq = 0; sq < 8; ++sq) {
      const int b = ((int)blockIdx.x + sq) & 7;
      for (;;) {
        if (wid == 0 && lane == 0) qw[0] = atomicAdd(qctr + b, 1u);
        __syncthreads();
        const unsigned uq = qw[0];
        __syncthreads();
        if (uq >= 272u) break;
        const int h = 15 - (int)(uq / 17u), qb = (int)(uq % 17u);
        const float slope = exp2f(-0.5f * (float)(h + 1));
        const unsigned* nr = (const unsigned*)(p.ws + OFF_NRM) + li * 512 + b * 64;
        const float q0 = __uint_as_float(nr[h * 2]), q1 = __uint_as_float(nr[h * 2 + 1]), k0 = __uint_as_float(nr[32 + h * 2]), k1 = __uint_as_float(nr[32 + h * 2 + 1]);
        const float Bq = sqrtf(fmaxf(q0 * k0, q1 * k1)) * (0.08838834764831845f * LOG2E * 1.001f);
        const float Dmin = (40.f + 2.f * Bq) / (slope * LOG2E);
        const int t0 = qb * 128;
        int first = (int)floorf(((float)(t0 - 31) - Dmin) * (1.f / 32.f)) + 1; first = first < 0 ? 0 : first;
        int last = (int)ceilf(((float)(t0 + 127) + Dmin) * (1.f / 32.f)) - 1; last = last > 64 ? 64 : last;
        attn_unit<8, 2, false>(lds, Z + (size_t)b * LL * ODD_LD, ODD_LD, h * 256 + j * 128, 4096 + h * 256, 4096 + h * 256 + 128, 8192 + h * 256, 12288 + h * 256, h * 256,
                               slope * LOG2E, 0.f, t0, first, last - first + 1, MIX + (size_t)b * LL * MIXW, lam, p.dnorm + li * 256, 1.f - lam_init, wave_s__);
      }
    }
}


struct G2Order : pg8::StaticOrder {
    __device__ bool next(int i, pg8::Unit& u) const {
        const long L = (long)i * G + c;
        if (L < nwg) return pg8::StaticOrder::next(i, u);
        const int jx = (int)(L - nwg); if (jx >= 128) return false;
        u.pm = 64; u.pn = jx & 7; u.kt0 = (jx >> 3) * 4; u.nt = 4; return true;
    }
};
template <bool EVEN>
DI void run_g1(const Params& p, LAS unsigned char* lds, const int layer, const int wave_s__) {
    constexpr int nin = EVEN ? EVEN_IN : ODD_IN;
    pg8::Gemm g; g.A = (const bf16_t*)(p.ws + OFF_HN); g.Bt = (const bf16_t*)(p.ws + ((layer & 1) ? OFF_WIN2 : OFF_WIN)); g.M = MPAD; g.N = nin; g.K = DM;
    pg8::StaticOrder S; S.init(MPAD, nin, (int)gridDim.x, (int)blockIdx.x, DM);
    pg8::EpiBf16<0> E; E.O = (bf16_t*)(p.ws + OFF_Z); E.ldc = EVEN ? EVEN_IN : ODD_LD; E.bias = nullptr; E.split_cols = 0; E.split_stride = 0;
    pg8::gemm_phase<pg8::EpiBf16<0>, pg8::StaticOrder, false>(lds, g, S, E, nullptr, wave_s__);
    const int rem = ((MPAD / 256) * (nin / 256)) % (int)gridDim.x; const int first = (rem == 0 || 2 * rem > (int)gridDim.x) ? 0 : rem;
    const int li = layer >> 1;
    convert_T(lds, (EVEN ? p.w_out_a : p.w_out_c) + (size_t)li * MIXW * DM, (bf16_t*)(p.ws + OFF_WOUT), MIXW, DM, wave_s__, first);
    if (layer < 3) { bf16_t* wn = (bf16_t*)(p.ws + (((layer + 1) & 1) ? OFF_WIN2 : OFF_WIN));
        if (EVEN) convert_T(lds, p.w_in_c + (size_t)li * DM * ODD_IN, wn, DM, ODD_IN, wave_s__, first);
        else convert_T(lds, p.w_in_a + (size_t)(li + 1) * DM * EVEN_IN, wn, DM, EVEN_IN, wave_s__, first); }
}
DI void run_g2(const Params& p, LAS unsigned char* lds, const int layer, const int wave_s__) {
    pg8::Gemm g; g.A = (const bf16_t*)(p.ws + OFF_MIX); g.Bt = (const bf16_t*)(p.ws + OFF_WOUT); g.M = MPAD; g.N = DM; g.K = MIXW;
    G2Order S; S.init(16384, DM, (int)gridDim.x, (int)blockIdx.x, MIXW);
    EpiResAdd E; E.H = (float*)(p.ws + OFF_H); E.ldc = DM; E.P = (float*)(p.ws + OFF_PART); E.x0 = layer == 0 ? p.x : nullptr; E.meta0 = p.meta;
    pg8::gemm_phase<EpiResAdd, G2Order, false>(lds, g, S, E, nullptr, wave_s__);
}

#define PH_IN(k) (lo <= (k) && (k) < hi)
DI void grid_bar(unsigned* base, const unsigned epoch, const int wave_s__) {
    __syncthreads();
    if (wave_s__ == 0 && __lane_id() == 0) {
        const unsigned G = gridDim.x, x = blockIdx.x & 7u;
        const unsigned gsize = (G - x + 7u) >> 3, ngroups = G < 8u ? G : 8u;
        const unsigned old = __hip_atomic_fetch_add(base + 32u * (1u + x), 1u, __ATOMIC_ACQ_REL, __HIP_MEMORY_SCOPE_AGENT);
        if (old + 1u == gsize * epoch) __hip_atomic_fetch_add(base, 1u, __ATOMIC_ACQ_REL, __HIP_MEMORY_SCOPE_AGENT);
        while (__hip_atomic_load(base, __ATOMIC_RELAXED, __HIP_MEMORY_SCOPE_AGENT) < ngroups * epoch) __builtin_amdgcn_s_sleep(1);
        __builtin_amdgcn_fence(__ATOMIC_ACQUIRE, "agent");
    }
    __syncthreads();
}
#define PH_SYNC(k) do { if (PH_IN(k) && PH_IN((k) + 1)) { nbar += 1u; grid_bar(barcnt, nbar, wave_s__); } } while (0)
DI void layer_pair(const Params& p, LAS unsigned char* lds, unsigned* barcnt, unsigned& nbar, const int lo, const int hi, const int pr, const int wave_s__) {
    bf16_t* WIN = (bf16_t*)(p.ws + OFF_WIN); bf16_t* WOUT = (bf16_t*)(p.ws + OFF_WOUT);

        const int k0 = 1 + 9 * pr;
        if (PH_IN(k0 + 0)) run_g1<true>(p, lds, 2 * pr, wave_s__);
        PH_SYNC(k0 + 0);
        if (PH_IN(k0 + 1)) {
#pragma unroll 1
            for (int rep = 0; rep <= p.dup_e; ++rep) { mix_even(p, lds, pr, wave_s__); __syncthreads(); }

}
        PH_SYNC(k0 + 1);
        if (PH_IN(k0 + 3)) run_g2(p, lds, 2 * pr, wave_s__);
        PH_SYNC(k0 + 3);
        if (PH_IN(k0 + 4)) row_phase<1>(p, p.norm_c + (size_t)pr * DM, wave_s__);
        PH_SYNC(k0 + 4);
        if (PH_IN(k0 + 5)) run_g1<false>(p, lds, 2 * pr + 1, wave_s__);
        PH_SYNC(k0 + 5);
        if (PH_IN(k0 + 6)) {
            qk_norm_pass(p, pr, wave_s__);
            nbar += 1u; grid_bar(barcnt, nbar, wave_s__);
#pragma unroll 1
            for (int rep = 0; rep <= p.dup_o; ++rep) { mix_odd(p, lds, pr, 2 * pr + 1, wave_s__); __syncthreads(); }

}
        PH_SYNC(k0 + 6);
        if (PH_IN(k0 + 7)) run_g2(p, lds, 2 * pr + 1, wave_s__);
        PH_SYNC(k0 + 7);
        if (PH_IN(k0 + 8)) { if (pr == 1) row_phase<2>(p, p.fnorm, wave_s__); else row_phase<1>(p, p.norm_a + (size_t)DM, wave_s__); }
        PH_SYNC(k0 + 8);
}

__global__ void __launch_bounds__(512, 2) mega(Params p) {
    extern __shared__ __attribute__((aligned(16))) unsigned char lds_raw[];
    LAS unsigned char* lds = (LAS unsigned char*)lds_raw;
    cg::grid_group grid = cg::this_grid();
    const int lo = p.ph_lo, hi = p.ph_hi;
    const int wave_s__ = __builtin_amdgcn_readfirstlane((int)threadIdx.x >> 6);
    bf16_t* WIN = (bf16_t*)(p.ws + OFF_WIN); bf16_t* WOUT = (bf16_t*)(p.ws + OFF_WOUT);
    if (PH_IN(0)) {
        if (blockIdx.x == 0) { unsigned* cw = (unsigned*)(p.ws + OFF_MISC + 256); for (int i = ltid(wave_s__); i < (8192 - 256) / 4; i += 512) cw[i] = 0u; }
        if (blockIdx.x == 0 && wave_s__ < 2) {
            const int lane = (int)__lane_id(); const float* lv = p.dlam + wave_s__ * 512;
            const float d1 = wave_sum(lv[lane] * lv[128 + lane] + lv[64 + lane] * lv[192 + lane]);
            const float d2 = wave_sum(lv[256 + lane] * lv[384 + lane] + lv[320 + lane] * lv[448 + lane]);
            const float lam_init = 0.8f - 0.6f * expf(-0.3f * (float)(2 * wave_s__ + 1));
            if (lane == 0) ((float*)(p.ws + OFF_MISC))[wave_s__] = expf(d1) - expf(d2) + lam_init;
        }
        row_phase<0>(p, p.norm_a, wave_s__); convert_T(lds, p.w_in_a, WIN, DM, EVEN_IN, wave_s__); }
    unsigned* barcnt = (unsigned*)(p.ws + OFF_MISC + 5632); unsigned nbar = 0u;
    if (PH_IN(0) && PH_IN(1)) grid.sync();
    layer_pair(p, lds, barcnt, nbar, lo, hi, 0, wave_s__);
    layer_pair(p, lds, barcnt, nbar, lo, hi, 1, wave_s__);
}

constexpr int N_PHASES = 19;

extern "C" void kernel_launch(void* const* d_in, const int* in_sizes, int n_in, void* d_out, int out_size, void* d_ws, size_t ws_size, hipStream_t stream) {
    static int grid = 0;
    if (grid == 0) {
        if (n_in != 14 || ws_size < WS_END) { fprintf(stderr, "kernel_launch: need 14 inputs and %zu bytes of workspace; got %d, %zu\n", (size_t)WS_END, n_in, ws_size); grid = -1; return; }
        int dev = 0, cus = 0, per_cu = 0;
        hipGetDevice(&dev); hipDeviceGetAttribute(&cus, hipDeviceAttributeMultiprocessorCount, dev);
        if (hipFuncSetAttribute((const void*)mega, hipFuncAttributeMaxDynamicSharedMemorySize, LDS_BYTES) != hipSuccess) { fprintf(stderr, "kernel_launch: hipFuncSetAttribute failed\n"); grid = -1; return; }
        if (hipOccupancyMaxActiveBlocksPerMultiprocessor(&per_cu, (const void*)mega, 512, LDS_BYTES) != hipSuccess || per_cu < 1) { fprintf(stderr, "kernel_launch: occupancy query says %d\n", per_cu); per_cu = 1; }
        (void)hipGetLastError();
        grid = cus * 1;
    }
    if (grid < 0) return;
    Params p{};
    p.x = (const float*)d_in[0]; p.meta = (const float*)d_in[1]; p.norm_a = (const float*)d_in[2]; p.w_in_a = (const float*)d_in[3]; p.w_out_a = (const float*)d_in[4];
    p.hgrn_lb = (const float*)d_in[5]; p.hgrn_norm = (const float*)d_in[6]; p.sink = (const float*)d_in[7]; p.norm_c = (const float*)d_in[8]; p.w_in_c = (const float*)d_in[9];
    p.w_out_c = (const float*)d_in[10]; p.dlam = (const float*)d_in[11]; p.dnorm = (const float*)d_in[12]; p.fnorm = (const float*)d_in[13];
    p.out = (float*)d_out; p.ws = (unsigned char*)d_ws; p.ph_lo = 0; p.ph_hi = N_PHASES;
#ifdef DUP_ODD
    p.dup_o = 1;
#endif
#ifdef DUP_EVEN
    p.dup_e = 1;
#endif
    void* args[] = {&p};
    hipError_t e = hipLaunchCooperativeKernel((const void*)mega, dim3(grid), dim3(512), args, LDS_BYTES, stream);
    if (e != hipSuccess) fprintf(stderr, "kernel_launch: cooperative launch failed: %s (grid %d)\n", hipGetErrorString(e), grid);
}
```

```cpp
#include <hip/hip_runtime.h>
#include <hip/hip_cooperative_groups.h>
#include <cstdio>
namespace cg = cooperative_groups;
__device__ __forceinline__ int ltid(int wave_s__) { int t = wave_s__ * 64 + (int)__lane_id(); asm volatile("" : "+v"(t)); return t; }
namespace pg8 {
#define PG8_LAS __attribute__((address_space(3)))
typedef unsigned short bf16_t;
typedef short bf16x8 __attribute__((ext_vector_type(8)));
typedef float f32x4 __attribute__((ext_vector_type(4)));
typedef unsigned u32x4 __attribute__((ext_vector_type(4)));
constexpr int BM = 256, BK = 64, HALF = 128, HTB = HALF * BK * 2  , STAGE_BYTES = 8 * HTB, NXCD = 8, WGM = 4;

__host__ __device__ __forceinline__ int lds_byte(int r, int c) { const int st = (r >> 4) * 2 + (c >> 5), rr = r & 15, cc = c & 31, ob = rr * 64 + cc * 2; return st * 1024 + (ob ^ (((ob >> 9) & 1) << 5)); }
__host__ __device__ __forceinline__ void stage_rc(int b, int& R, int& C) { const int st = b / 1024, sb = b % 1024, swz = sb ^ (((sb >> 9) & 1) << 5); R = (st >> 1) * 16 + swz / 64; C = (st & 1) * 32 + (swz % 64) / 2; }
__host__ __device__ __forceinline__ int perm32(int rho) { const int n = rho >> 4, i = rho & 15; return 8 * (i >> 2) + 4 * n + (i & 3); }

struct Unit { int pm, pn, kt0, nt; };
struct Gemm { const bf16_t* A; const bf16_t* Bt; int M, N, K; };

struct StaticOrder {
    int nM, nN, nwg, G, c, KT;
    __host__ __device__ void init(int M, int N, int G_, int c_, int K_ = 0) { nM = M / BM; nN = N / BM; nwg = nM * nN; G = G_; c = c_; KT = K_ / BK; }
    __host__ __device__ bool next(int i, Unit& u) const {
        const long L = (long)i * G + c; if (L >= nwg) return false;
        int wgid = (int)L; { const int q = nwg / NXCD, r = nwg % NXCD, xcd = wgid % NXCD, off = wgid / NXCD; wgid = (xcd < r ? xcd * (q + 1) : r * (q + 1) + (xcd - r) * q) + off; }
        const int nig = WGM * nN, gid = wgid / nig, fm = gid * WGM, gsz = (nM - fm) < WGM ? (nM - fm) : WGM;
        u.pm = fm + ((wgid % nig) % gsz); u.pn = (wgid % nig) / gsz; u.kt0 = 0; u.nt = KT; return true;
    }
    __device__ __forceinline__ void a_ready(const Unit&) const {}
    __device__ __forceinline__ void done(const Unit&) const {}
};
struct CountedOrder : StaticOrder {
    const unsigned* ready; unsigned need; unsigned* tmo;
    __device__ __forceinline__ void a_ready(const Unit& u) const {
        if ((int)threadIdx.x < 64) {
            const unsigned long long t0 = __builtin_amdgcn_s_memrealtime(); unsigned polls = 0;
            while ((unsigned)__builtin_amdgcn_readfirstlane(__hip_atomic_load(ready + 64 * u.pm, __ATOMIC_RELAXED, __HIP_MEMORY_SCOPE_AGENT)) < need) {
                if ((++polls & 255u) == 0u && __builtin_amdgcn_readfirstlane(__hip_atomic_load(tmo, __ATOMIC_RELAXED, __HIP_MEMORY_SCOPE_AGENT)) != 0u) break;
                if (__builtin_amdgcn_s_memrealtime() - t0 > 2000000ull) {
                    if ((int)threadIdx.x == 0) { unsigned expect = 0u; __hip_atomic_compare_exchange_strong(tmo + 1, &expect, 0x600u | (unsigned)(u.pm & 0xff), __ATOMIC_RELAXED, __ATOMIC_RELAXED, __HIP_MEMORY_SCOPE_AGENT); __hip_atomic_store(tmo, 1u, __ATOMIC_RELAXED, __HIP_MEMORY_SCOPE_AGENT); }
                    break; }
                __builtin_amdgcn_s_sleep(2); }
            __builtin_amdgcn_fence(__ATOMIC_ACQUIRE, "agent");
            asm volatile("s_waitcnt vmcnt(0)" ::: "memory");
        }
#if !defined(BROKEN_HOOK_NO_BARRIER)
        asm volatile("" ::: "memory"); __builtin_amdgcn_s_barrier(); asm volatile("" ::: "memory");
#endif
    }
};

__device__ __forceinline__ unsigned cvt_pk_bf16(float lo, float hi) { unsigned r; asm volatile("v_cvt_pk_bf16_f32 %0, %1, %2" : "=v"(r) : "v"(lo), "v"(hi)); return r; }
typedef float f32x2 __attribute__((ext_vector_type(2)));
__device__ __forceinline__ f32x2 gelu_pk(f32x2 v) {
    const f32x2 av = __builtin_elementwise_abs(v), d = av * 0.2316418882f + 1.0f;
    f32x2 t; t.x = __builtin_amdgcn_rcpf(d.x); t.y = __builtin_amdgcn_rcpf(d.y);
    f32x2 q = t * 0.5307027145f + (-0.7265760135f); q = q * t + 0.7107068705f; q = q * t + (-0.142248368f); q = q * t + 0.127414796f; q = q * t;
    const f32x2 s = (v * v) * (-0.72134752044f);
    f32x2 e; e.x = __builtin_amdgcn_exp2f(s.x); e.y = __builtin_amdgcn_exp2f(s.y);
    const f32x2 m = v * (q * e), r = v - m;
    f32x2 o; o.x = v.x < 0.f ? m.x : r.x; o.y = v.y < 0.f ? m.y : r.y; return o;
}

struct EpiF32 {
    static constexpr bool PERM = false, AFTER_DRAIN = false;
    float* C; int ldc; const float* bias;
    __device__ __forceinline__ void operator()(const f32x4 (&acc)[2][2][4][2], const Unit& u, int wr, int wc, int fr, int fq) const {
        const int row0 = u.pm * BM + wr * 64 + fr, col0 = u.pn * BM + wc * 32 + 4 * fq;
        f32x4 bv[2][2];
#pragma unroll
        for (int bj = 0; bj < 2; ++bj)
#pragma unroll
            for (int n = 0; n < 2; ++n) bv[bj][n] = bias ? *(const f32x4*)(bias + col0 + bj * HALF + n * 16) : (f32x4){0.f, 0.f, 0.f, 0.f};
#pragma unroll
        for (int ai = 0; ai < 2; ++ai)
#pragma unroll
            for (int m = 0; m < 4; ++m) { float* rowp = C + (size_t)(row0 + ai * HALF + m * 16) * ldc + col0;
#pragma unroll
                for (int bj = 0; bj < 2; ++bj)
#pragma unroll
                    for (int n = 0; n < 2; ++n) *(f32x4*)(rowp + bj * HALF + n * 16) = acc[ai][bj][m][n] + bv[bj][n]; }
    }
};
template <int ACT  > struct EpiBf16 {
    static constexpr bool PERM = true, AFTER_DRAIN = false;
    bf16_t* O; int ldc; const float* bias; int split_cols; size_t split_stride;
    __device__ __forceinline__ void operator()(const f32x4 (&acc)[2][2][4][2], const Unit& u, int wr, int wc, int fr, int fq) const {
        const int row0 = u.pm * BM + wr * 64 + fr; int colt = u.pn * BM; bf16_t* base = O;
        if (split_cols) { const int t = colt / split_cols; base += (size_t)t * split_stride; colt -= t * split_cols; }
        const int col0 = colt + wc * 32 + 8 * fq, bcol0 = u.pn * BM + wc * 32 + 8 * fq;
        f32x4 bv[2][2];
#pragma unroll
        for (int bj = 0; bj < 2; ++bj)
#pragma unroll
            for (int n = 0; n < 2; ++n) bv[bj][n] = bias ? *(const f32x4*)(bias + bcol0 + bj * HALF + 4 * n) : (f32x4){0.f, 0.f, 0.f, 0.f};
#pragma unroll
        for (int ai = 0; ai < 2; ++ai)
#pragma unroll
            for (int m = 0; m < 4; ++m) { bf16_t* rowp = base + (size_t)(row0 + ai * HALF + m * 16) * ldc + col0;
#pragma unroll
                for (int bj = 0; bj < 2; ++bj) { f32x4 v0 = acc[ai][bj][m][0] + bv[bj][0], v1 = acc[ai][bj][m][1] + bv[bj][1];
                    if (ACT == 1) { f32x2 a = gelu_pk((f32x2){v0[0], v0[1]}), b = gelu_pk((f32x2){v0[2], v0[3]}), c = gelu_pk((f32x2){v1[0], v1[1]}), d = gelu_pk((f32x2){v1[2], v1[3]});
                        v0 = (f32x4){a.x, a.y, b.x, b.y}; v1 = (f32x4){c.x, c.y, d.x, d.y}; }
                    if (ACT == 2) {
#pragma unroll
                        for (int j = 0; j < 4; ++j) { v0[j] = 0.5f * v0[j] * (1.0f + erff(v0[j] * 0.70710678f)); v1[j] = 0.5f * v1[j] * (1.0f + erff(v1[j] * 0.70710678f)); } }
                    u32x4 w; w.x = cvt_pk_bf16(v0[0], v0[1]); w.y = cvt_pk_bf16(v0[2], v0[3]); w.z = cvt_pk_bf16(v1[0], v1[1]); w.w = cvt_pk_bf16(v1[2], v1[3]);
                    *(u32x4*)(rowp + bj * HALF) = w; } }
    }
};

template <class Epi, class Sched, bool STAMP = false>
__device__ __forceinline__ void gemm_phase(PG8_LAS unsigned char* lds, const Gemm g, const Sched& S, const Epi& E, unsigned long long* stamps, const int wave_s__) {
    const int tid = ltid(wave_s__), wid = __builtin_amdgcn_readfirstlane(tid >> 6), lane = tid & 63, wr = wid >> 2, wc = wid & 3, fr = lane & 15, fq = lane >> 4;
    const int K = g.K; int nt;
    int ts_lo = 0, ts_hi = 0, nts = 0; const unsigned long long rt_entry = STAMP ? (unsigned long long)wall_clock64() : 0ull;
#define PG8_STAMP() do { if (STAMP && wid == 0 && nts < 64) { const unsigned long long _c = (unsigned long long)clock64(); \
        ts_lo = (lane == nts) ? (int)(unsigned)_c : ts_lo; ts_hi = (lane == nts) ? (int)(unsigned)(_c >> 32) : ts_hi; ++nts; } } while (0)
    PG8_STAMP();
    unsigned voffA[2], voffB[2];
#pragma unroll
    for (int i = 0; i < 2; ++i) { int R, C; stage_rc(tid * 16 + i * 8192, R, C); const int Rb = Epi::PERM ? ((R & ~31) + perm32(R & 31)) : R;
        voffA[i] = (unsigned)(R * K + C) * 2u; voffB[i] = (unsigned)(Rb * K + C) * 2u; }
    const size_t kstep = (size_t)(BK * 2);
    const size_t hstep = (size_t)HALF * K * 2;
    const size_t tstep = 2 * hstep;
    const unsigned ldsw = (unsigned)wid * 1024u;
    const int aoff = lds_byte(wr * 64 + fr, fq * 8), boff = lds_byte(wc * 32 + fr, fq * 8);
#define PG8_SA(b, h) (((b) * 2 + (h)) * HTB)
#define PG8_SB(b, h) ((4 + (b) * 2 + (h)) * HTB)
#define PG8_STAGE(bufoff, gbase, voff) do { _Pragma("unroll") for (int _i = 0; _i < 2; ++_i) \
        __builtin_amdgcn_global_load_lds((const unsigned*)((const char*)(gbase) + (voff)[_i]), (PG8_LAS unsigned*)(lds + (bufoff) + ldsw + _i * 8192), 16, 0, 0); } while (0)
#define PG8_LDA(dst, b, h) do { _Pragma("unroll") for (int m = 0; m < 4; ++m) _Pragma("unroll") for (int k = 0; k < 2; ++k) dst[m][k] = *(const PG8_LAS bf16x8*)(lds + PG8_SA(b, h) + aoff + m * 2048 + k * 1024); } while (0)
#define PG8_LDB(dst, b, h) do { _Pragma("unroll") for (int n = 0; n < 2; ++n) _Pragma("unroll") for (int k = 0; k < 2; ++k) dst[n][k] = *(const PG8_LAS bf16x8*)(lds + PG8_SB(b, h) + boff + n * 2048 + k * 1024); } while (0)
#define PG8_MMA(ai, bj, At, Bt) do { __builtin_amdgcn_s_setprio(1); _Pragma("unroll") for (int m = 0; m < 4; ++m) _Pragma("unroll") for (int n = 0; n < 2; ++n) _Pragma("unroll") for (int k = 0; k < 2; ++k) \
        acc[ai][bj][m][n] = __builtin_amdgcn_mfma_f32_16x16x32_bf16(Bt[n][k], At[m][k], acc[ai][bj][m][n], 0, 0, 0); __builtin_amdgcn_s_setprio(0); } while (0)
#define PG8_WAIT_V(n) asm volatile("s_waitcnt vmcnt(" #n ")" ::: "memory")
#define PG8_WAIT_L(n) asm volatile("s_waitcnt lgkmcnt(" #n ")" ::: "memory")
#define PG8_BAR __builtin_amdgcn_s_barrier()
#define PG8_SCHED __builtin_amdgcn_sched_barrier(0)
    Unit cur, nxt; int ui = 0;
    if (!S.next(0, cur)) return;
    f32x4 acc[2][2][4][2];
#pragma unroll
    for (int a = 0; a < 2; ++a)
#pragma unroll
        for (int b = 0; b < 2; ++b)
#pragma unroll
            for (int m = 0; m < 4; ++m)
#pragma unroll
                for (int n = 0; n < 2; ++n) acc[a][b][m][n] = (f32x4){0.f, 0.f, 0.f, 0.f};
    bf16x8 At[4][2], B0[2][2], B1[2][2];
    nt = cur.nt;
    const char* cA = (const char*)g.A + (size_t)cur.pm * tstep + (size_t)cur.kt0 * kstep; const char* cB = (const char*)g.Bt + (size_t)cur.pn * tstep + (size_t)cur.kt0 * kstep;
    S.a_ready(cur);
    PG8_STAGE(PG8_SB(0, 0), cB, voffB); PG8_STAGE(PG8_SA(0, 0), cA, voffA); PG8_STAGE(PG8_SB(0, 1), cB + hstep, voffB); PG8_STAGE(PG8_SA(0, 1), cA + hstep, voffA);
    if (wr == 1) PG8_BAR;
    PG8_WAIT_V(4); PG8_BAR;
    PG8_STAGE(PG8_SB(1, 0), cB + kstep, voffB); PG8_STAGE(PG8_SA(1, 0), cA + kstep, voffA); PG8_STAGE(PG8_SB(1, 1), cB + hstep + kstep, voffB);
    PG8_WAIT_V(6); PG8_BAR;
    PG8_STAMP();
    for (;;) {
        const bool has_next = S.next(ui + 1, nxt);
        const char* nA = has_next ? (const char*)g.A + (size_t)nxt.pm * tstep + (size_t)nxt.kt0 * kstep : cA; const char* nB = has_next ? (const char*)g.Bt + (size_t)nxt.pn * tstep + (size_t)nxt.kt0 * kstep : cB;
        for (int t = 0; t < nt; t += 2) {
            const bool last = (t == nt - 2);
            const char* a1 = cA + (size_t)(t + 1) * kstep;
            const char* a2 = last ? nA : cA + (size_t)(t + 2) * kstep; const char* b2 = last ? nB : cB + (size_t)(t + 2) * kstep;
            const char* a3 = a2 + kstep; const char* b3 = b2 + kstep;
            if (last && has_next) S.a_ready(nxt);
            PG8_LDB(B0, 0, 0); PG8_SCHED; PG8_LDA(At, 0, 0); PG8_STAGE(PG8_SA(1, 1), a1 + hstep, voffA);
            PG8_WAIT_L(8); PG8_BAR; PG8_WAIT_L(0); PG8_MMA(0, 0, At, B0); PG8_BAR; PG8_SCHED;
            PG8_LDB(B1, 0, 1); PG8_STAGE(PG8_SB(0, 0), b2, voffB);
            PG8_BAR; PG8_WAIT_L(0); PG8_MMA(0, 1, At, B1); PG8_BAR;
            PG8_LDA(At, 0, 1); PG8_STAGE(PG8_SA(0, 0), a2, voffA);
            PG8_BAR; PG8_WAIT_L(0); PG8_MMA(1, 0, At, B0); PG8_BAR; PG8_SCHED;
            PG8_STAGE(PG8_SB(0, 1), b2 + hstep, voffB);
            PG8_WAIT_V(6); PG8_BAR; PG8_MMA(1, 1, At, B1); PG8_BAR;
            PG8_LDB(B0, 1, 0); PG8_SCHED; PG8_LDA(At, 1, 0); PG8_STAGE(PG8_SA(0, 1), a2 + hstep, voffA);
            PG8_WAIT_L(8); PG8_BAR; PG8_WAIT_L(0); PG8_MMA(0, 0, At, B0); PG8_BAR; PG8_SCHED;
            PG8_LDB(B1, 1, 1); PG8_STAGE(PG8_SB(1, 0), b3, voffB);
            PG8_BAR; PG8_WAIT_L(0); PG8_MMA(0, 1, At, B1); PG8_BAR;
            PG8_LDA(At, 1, 1); PG8_STAGE(PG8_SA(1, 0), a3, voffA);
            PG8_BAR; PG8_WAIT_L(0); PG8_MMA(1, 0, At, B0); PG8_BAR; PG8_SCHED;
            PG8_STAGE(PG8_SB(1, 1), b3 + hstep, voffB);
            PG8_WAIT_V(6); PG8_BAR; PG8_MMA(1, 1, At, B1); PG8_BAR;
        }
        PG8_STAMP();
        if constexpr (!Epi::AFTER_DRAIN) { E(acc, cur, wr, wc, fr, fq); S.done(cur); }
        PG8_STAMP();
        if (!has_next) break;
#pragma unroll
        for (int a = 0; a < 2; ++a)
#pragma unroll
            for (int b = 0; b < 2; ++b)
#pragma unroll
                for (int m = 0; m < 4; ++m)
#pragma unroll
                    for (int n = 0; n < 2; ++n) acc[a][b][m][n] = (f32x4){0.f, 0.f, 0.f, 0.f};
        cur = nxt; cA = nA; cB = nB; ++ui; nt = cur.nt;
    }
    PG8_WAIT_V(0);
    if (wr == 0) PG8_BAR;
    PG8_BAR;
    if constexpr (Epi::AFTER_DRAIN) { E.fused(acc, cur, wr, wc, fr, fq, lds, wid, lane); S.done(cur); }
    PG8_STAMP();
    if (STAMP && wid == 0) { stamps[lane] = lane < nts ? (((unsigned long long)(unsigned)ts_hi << 32) | (unsigned)ts_lo) : 0ull;
        if (lane == 62) stamps[62] = rt_entry; if (lane == 63) stamps[63] = (unsigned long long)wall_clock64(); }
#undef PG8_STAMP
#undef PG8_SA
#undef PG8_SB
#undef PG8_STAGE
#undef PG8_LDA
#undef PG8_LDB
#undef PG8_MMA
#undef PG8_WAIT_V
#undef PG8_WAIT_L
#undef PG8_BAR
#undef PG8_SCHED
}
}

using pg8::bf16_t; using pg8::bf16x8; using pg8::f32x4; using pg8::u32x4;
typedef short s16x4 __attribute__((ext_vector_type(4)));
typedef float f32x16 __attribute__((ext_vector_type(16)));
typedef unsigned u32x2 __attribute__((ext_vector_type(2)));
#define LAS __attribute__((address_space(3)))
#define DI __device__ __forceinline__
#define MFMA32(a, b, c) __builtin_amdgcn_mfma_f32_32x32x16_bf16((a), (b), (c), 0, 0, 0)

constexpr int NB = 8, LL = 2064, NMETA = 16, DM = 2048, MTOK = NB * LL, MPAD = 16640;
constexpr int EVEN_IN = 15360, ODD_IN = 16384, MIXW = 4096;
constexpr int ODD_LD = ODD_IN;
constexpr int LDS_BYTES = 131072 + 1024;
#ifndef PHM
#define PHM 255
#endif
constexpr float LOG2E = 1.4426950408889634f, LN2 = 0.6931471805599453f;

constexpr size_t OFF_H = 0;
constexpr size_t OFF_HN = OFF_H + (size_t)MPAD * DM * 4;
constexpr size_t OFF_Z = OFF_HN + (size_t)MPAD * DM * 2;
constexpr size_t OFF_MIX = OFF_Z + (size_t)MPAD * ODD_LD * 2;
constexpr size_t OFF_WIN = OFF_MIX + (size_t)MPAD * MIXW * 2;
constexpr size_t OFF_WOUT = OFF_WIN + (size_t)ODD_IN * DM * 2;
constexpr size_t OFF_WIN2 = OFF_WOUT + (size_t)DM * MIXW * 2;
constexpr size_t OFF_MISC = OFF_WIN2 + (size_t)ODD_IN * DM * 2;
constexpr size_t OFF_QCTR = OFF_MISC + 384;
constexpr size_t OFF_HFLAG = OFF_MISC + 4608;
constexpr size_t OFF_NRM = OFF_MISC + 512;
constexpr size_t OFF_PART = OFF_MISC + 8192;
constexpr size_t WS_END = OFF_PART + (size_t)16 * 128 * DM * 4;

struct Params {
    const float *x, *meta, *norm_a, *w_in_a, *w_out_a, *hgrn_lb, *hgrn_norm, *sink, *norm_c, *w_in_c, *w_out_c, *dlam, *dnorm, *fnorm;
    float* out; unsigned char* ws; int ph_lo, ph_hi, dup_e, dup_o;
};

DI unsigned cvt_pk(float lo, float hi) { unsigned r; asm("v_cvt_pk_bf16_f32 %0, %1, %2" : "=v"(r) : "v"(lo), "v"(hi)); return r; }
DI float bf2f(bf16_t x) { return __uint_as_float(((unsigned)x) << 16); }
DI float bflo(unsigned u) { return __uint_as_float(u << 16); }
DI float bfhi(unsigned u) { return __uint_as_float(u & 0xffff0000u); }
DI float ex2(float x) { return __builtin_amdgcn_exp2f(x); }
DI float lg2(float x) { return __builtin_amdgcn_logf(x); }
DI float rcpf(float x) { return __builtin_amdgcn_rcpf(x); }
DI float siluf(float x) { return x * rcpf(1.f + ex2(-x * LOG2E)); }
DI float wave_sum(float v) {
#pragma unroll
    for (int o = 32; o; o >>= 1) v += __shfl_xor(v, o);
    return v; }
DI float xhalf_max(float v) { const auto r = __builtin_amdgcn_permlane32_swap(__float_as_uint(v), __float_as_uint(v), false, false); return fmaxf(__uint_as_float(r[0]), __uint_as_float(r[1])); }
DI float xhalf_sum(float v) { const auto r = __builtin_amdgcn_permlane32_swap(__float_as_uint(v), __float_as_uint(v), false, false); return __uint_as_float(r[0]) + __uint_as_float(r[1]); }
DI int crow(int reg, int h) { return (reg & 3) + 8 * (reg >> 2) + 4 * h; }
DI f32x16 zero16() { f32x16 z;
#pragma unroll
    for (int i = 0; i < 16; ++i) z[i] = 0.f;
    return z; }

template <int MODE>
DI void row_phase(const Params& p, const float* __restrict__ g, const int wave_s__) {
    const int wid = ltid(wave_s__) >> 6, lane = ltid(wave_s__) & 63;
    float* H = (float*)(p.ws + OFF_H); bf16_t* HN = (bf16_t*)(p.ws + OFF_HN);
    for (int r = blockIdx.x * 8 + wid; r < MPAD; r += gridDim.x * 8) {
        if (r >= MTOK) {
            if (MODE == 0) {
#pragma unroll
                for (int j = 0; j < 8; ++j) { *(f32x4*)(H + (size_t)r * DM + (j * 64 + lane) * 4) = (f32x4){0.f, 0.f, 0.f, 0.f}; }
            }
            if (MODE != 2) {
#pragma unroll
                for (int j = 0; j < 8; ++j) { u32x2 zz; zz.x = 0u; zz.y = 0u; *(u32x2*)(HN + (size_t)r * DM + (j * 64 + lane) * 4) = zz; }
            }
            continue;
        }
        const int b = r / LL, t = r - b * LL;
        const float* src;
        if (MODE == 0) src = (t < NMETA) ? (p.meta + (size_t)t * DM) : (p.x + ((size_t)b * 2048 + (t - NMETA)) * DM);
        else src = H + (size_t)r * DM;
        f32x4 v[8]; float ss = 0.f;
#pragma unroll
        for (int j = 0; j < 8; ++j) v[j] = *(const f32x4*)(src + (j * 64 + lane) * 4);
        if (MODE != 0 && r >= 16384) {
            const float* pp = (const float*)(p.ws + OFF_PART) + (size_t)(r - 16384) * DM;
            for (int sp = 0; sp < 16; ++sp) {
#pragma unroll
                for (int j = 0; j < 8; ++j) v[j] = v[j] + *(const f32x4*)(pp + (size_t)sp * 128 * DM + (j * 64 + lane) * 4); }
            if (MODE == 1) {
#pragma unroll
                for (int j = 0; j < 8; ++j) *(f32x4*)(H + (size_t)r * DM + (j * 64 + lane) * 4) = v[j]; }
        }
#pragma unroll
        for (int j = 0; j < 8; ++j) ss += v[j][0] * v[j][0] + v[j][1] * v[j][1] + v[j][2] * v[j][2] + v[j][3] * v[j][3];
        ss = wave_sum(ss);
        const float rstd = rsqrtf(ss * (1.f / DM) + 1e-6f);
        if (MODE == 0 && r >= 16384) {
#pragma unroll
            for (int j = 0; j < 8; ++j) *(f32x4*)(H + (size_t)r * DM + (j * 64 + lane) * 4) = v[j];
        }
        if (MODE == 2) {
            if (t >= NMETA) { float* op = p.out + ((size_t)b * 2048 + (t - NMETA)) * DM;
#pragma unroll
                for (int j = 0; j < 8; ++j) { const f32x4 gg = *(const f32x4*)(g + (j * 64 + lane) * 4); f32x4 o; o[0] = v[j][0] * rstd * gg[0]; o[1] = v[j][1] * rstd * gg[1]; o[2] = v[j][2] * rstd * gg[2]; o[3] = v[j][3] * rstd * gg[3];
                    *(f32x4*)(op + (j * 64 + lane) * 4) = o; } }
        } else {
#pragma unroll
            for (int j = 0; j < 8; ++j) { const f32x4 gg = *(const f32x4*)(g + (j * 64 + lane) * 4); u32x2 w; w.x = cvt_pk(v[j][0] * rstd * gg[0], v[j][1] * rstd * gg[1]); w.y = cvt_pk(v[j][2] * rstd * gg[2], v[j][3] * rstd * gg[3]);
                *(u32x2*)(HN + (size_t)r * DM + (j * 64 + lane) * 4) = w; }
        }
    }
}

DI void convert_T(LAS unsigned char* lds, const float* __restrict__ W, bf16_t* __restrict__ Wt, const int K, const int N, const int wave_s__, const int first = 0) {
    LAS float* tile = (LAS float*)lds;
    const int tid = ltid(wave_s__), nk = K >> 6, ntile = nk * (N >> 8);
    const int tx = tid & 63, ty = tid >> 6, wn = tid >> 3, wk = (tid & 7) * 8;
    if ((int)blockIdx.x < first) return;
    for (int t = (int)blockIdx.x - first; t < ntile; t += (int)gridDim.x - first) {
        const int k0 = (t % nk) << 6, n0 = (t / nk) << 8;
        float r[4][8];
#pragma unroll
        for (int c = 0; c < 4; ++c)
#pragma unroll
            for (int i = 0; i < 8; ++i) r[c][i] = __builtin_nontemporal_load(W + (size_t)(k0 + ty * 8 + i) * N + n0 + c * 64 + tx);
#pragma unroll
        for (int c = 0; c < 4; ++c) {
#pragma unroll
            for (int i = 0; i < 8; ++i) tile[(ty * 8 + i) * 65 + tx] = r[c][i];
            __syncthreads();
            float e[8];
#pragma unroll
            for (int i = 0; i < 8; ++i) e[i] = tile[(wk + i) * 65 + wn];
            u32x4 w; w.x = cvt_pk(e[0], e[1]); w.y = cvt_pk(e[2], e[3]); w.z = cvt_pk(e[4], e[5]); w.w = cvt_pk(e[6], e[7]);
            *(u32x4*)(Wt + (size_t)(n0 + c * 64 + wn) * K + k0 + wk) = w;
            __syncthreads();
        }
    }
}

struct EpiResAdd {
    static constexpr bool PERM = false, AFTER_DRAIN = false;
    float* H; int ldc; float* P; const float* x0; const float* meta0;
    DI void operator()(const f32x4 (&acc)[2][2][4][2], const pg8::Unit& u, int wr, int wc, int fr, int fq) const {
        const int row0 = u.pm * pg8::BM + wr * 64 + fr, col0 = u.pn * pg8::BM + wc * 32 + 4 * fq;
        if (u.nt != MIXW / 64) {
            float* pb = P + ((size_t)(u.kt0 >> 2) * 128 + (row0 - 16384)) * DM + col0;
#pragma unroll
            for (int m = 0; m < 4; ++m)
#pragma unroll
                for (int bj = 0; bj < 2; ++bj)
#pragma unroll
                    for (int n = 0; n < 2; ++n) *(f32x4*)(pb + (size_t)(m * 16) * DM + bj * pg8::HALF + n * 16) = acc[0][bj][m][n];
            return;
        }
#pragma unroll
        for (int ai = 0; ai < 2; ++ai)
#pragma unroll
            for (int m = 0; m < 4; ++m) { const int row = row0 + ai * pg8::HALF + m * 16; float* rowp = H + (size_t)row * ldc + col0;
                const float* srcp = rowp;
                if (x0) { const int b = row / LL, t = row - b * LL; srcp = (t < NMETA ? meta0 + (size_t)t * DM : x0 + ((size_t)b * 2048 + (t - NMETA)) * DM) + col0; }
#pragma unroll
                for (int bj = 0; bj < 2; ++bj)
#pragma unroll
                    for (int n = 0; n < 2; ++n) { *(f32x4*)(rowp + bj * pg8::HALF + n * 16) = *(const f32x4*)(srcp + bj * pg8::HALF + n * 16) + acc[ai][bj][m][n]; } }
    }
};

template <int NDV, int NK, bool WINM>
DI void attn_unit(LAS unsigned char* lds, const bf16_t* __restrict__ zb, const int ldz, const int qcol, const int kcol0, const int kcol1, const int vcol,
                  const int gcol, const int ocol, const float c2, const float sink2, const int t0, const int lo, const int nt,
                  bf16_t* __restrict__ mixb, const float lam, const float* __restrict__ normg, const float oscale, const int wave_s__) {
    constexpr int DV = NDV * 32, ROWB = DV * 2, KBY = 8192, VBY = 32 * ROWB, BUFB = NK * KBY + VBY, NI = (NK * KBY + VBY) / 1024, NPW = NI / 8;
    static_assert(3 * BUFB <= LDS_BYTES && NI % 8 == 0, "attention tile buffers");
    const int tid = ltid(wave_s__), wid = tid >> 6, lane = tid & 63, r32 = lane & 31, half = lane >> 5, j = wid >> 2, wq = wid & 3;
    const int tq = t0 + wq * 32 + r32;
    const float c1 = 0.08838834764831845f * LOG2E;
    bf16x8 qf[8];
    { const bf16_t* qp = zb + (size_t)tq * ldz + qcol + half * 8;
#pragma unroll
      for (int ks = 0; ks < 8; ++ks) qf[ks] = *(const bf16x8*)(qp + ks * 16); }
    f32x16 o[NDV];
#pragma unroll
    for (int n = 0; n < NDV; ++n) o[n] = zero16();
    float m = -1e30f, l = 0.f;
    unsigned soff[NPW]; int ddst[NPW];
#pragma unroll
    for (int e = 0; e < NPW; ++e) { const int qi = wid * NPW + e;
        if (qi < NK * 8) { const int mp = qi >> 3, r4 = qi & 7; const int row = 4 * r4 + (lane >> 4), slot = (lane & 15) ^ (row & 15);
            soff[e] = (unsigned)(row * ldz + (mp ? kcol1 : kcol0) + slot * 8) * 2u; ddst[e] = mp * KBY + r4 * 1024; }
        else { const int qv = qi - NK * 8; constexpr int SPR = DV / 8, RPI = 1024 / ROWB; const int row = qv * RPI + lane / SPR, ps = lane % SPR; const int ls = (((ps >> 2) ^ (row & 3)) << 2) | (ps & 3);
            soff[e] = (unsigned)(row * ldz + vcol + ls * 8) * 2u; ddst[e] = NK * KBY + qv * 1024; } }
#define ATT_DMA(tile_, buf_) do { const char* tb_ = (const char*)(zb + (size_t)(32 * (tile_)) * ldz); \
        _Pragma("unroll") for (int e = 0; e < NPW; ++e) __builtin_amdgcn_global_load_lds((const unsigned*)(tb_ + soff[e]), (LAS unsigned*)(lds + (buf_) * BUFB + ddst[e]), 16, 0, 0); } while (0)
#define ATT_BAR() do { asm volatile("" ::: "memory"); __builtin_amdgcn_s_barrier(); asm volatile("" ::: "memory"); } while (0)
    const int td = t0 >> 5, ndiag = (65 - td) < 4 ? (65 - td) : 4, nleft = td - lo;
#define ATT_TILE(it_) (WINM ? ((it_) == 0 ? 0 : lo + (it_) - 1) : ((it_) < ndiag ? td + (it_) : ((it_) < ndiag + nleft ? td - 1 - ((it_) - ndiag) : td + (it_) - nleft)))
    const int kbase = (NK == 2 ? j * KBY : 0) + r32 * 256 + ((((r32 & 15) ^ half) & 1) << 4) + ((r32 & 14) << 4);
    const int q4 = (lane >> 2) & 3, p4 = lane & 3, blk = (lane >> 4) & 1;
    int vb[4];
#pragma unroll
    for (int c = 0; c < 4; ++c) vb[c] = NK * KBY + (4 * half + q4) * ROWB + ((c ^ q4) << 6) + blk * 32 + 8 * p4;
    ATT_DMA(ATT_TILE(0), 0);
    asm volatile("s_waitcnt vmcnt(0)" ::: "memory");
    ATT_BAR();
    f32x16 st = zero16();
    u32x4 pk0, pk1; pk0.x = pk0.y = pk0.z = pk0.w = 0u; pk1 = pk0;
    bool pv_act = false;
    for (int ph = 0; ph < 2 * nt + 2; ++ph) {
        if (((ph + j) & 1) == 0) {
            const int idx = (ph - j) >> 1;
            if (idx >= 1 && pv_act) {
                const int bo = ((idx - 1) % 3) * BUFB;
                const bf16x8 pb0 = __builtin_bit_cast(bf16x8, pk0), pb1 = __builtin_bit_cast(bf16x8, pk1);
                bf16x8 av[3];
#define ATT_VLD1(k_, dst_) do { const int s2_ = (k_) / NDV, n_ = (k_) % NDV; LAS unsigned char* vp_ = lds + bo + vb[n_ & 3] + (n_ >> 2) * 256 + (16 * s2_) * ROWB; \
                        const s16x4 lo4_ = __builtin_amdgcn_ds_read_tr16_b64_v4i16((LAS s16x4*)vp_); const s16x4 hi4_ = __builtin_amdgcn_ds_read_tr16_b64_v4i16((LAS s16x4*)(vp_ + 8 * ROWB)); \
                        dst_ = __builtin_shufflevector(lo4_, hi4_, 0, 1, 2, 3, 4, 5, 6, 7); } while (0)
                ATT_VLD1(0, av[0]); ATT_VLD1(1, av[1]);
#pragma unroll
                for (int k = 0; k < 2 * NDV; ++k) {
                    if (k + 2 < 2 * NDV) ATT_VLD1(k + 2, av[(k + 2) % 3]);
                    __builtin_amdgcn_sched_barrier(0);
                    o[k % NDV] = MFMA32(av[k % 3], (k / NDV) ? pb1 : pb0, o[k % NDV]);
                    __builtin_amdgcn_sched_barrier(0);
                }
#undef ATT_VLD1
            }
            if (idx < nt) {
                const int ka = (idx % 3) * BUFB + kbase;
                st = zero16();
                bf16x8 ak[3];
                ak[0] = *(LAS bf16x8*)(lds + ka); ak[1] = *(LAS bf16x8*)(lds + (ka ^ 32));
#pragma unroll
                for (int ks = 0; ks < 8; ++ks) { if (ks + 2 < 8) ak[(ks + 2) % 3] = *(LAS bf16x8*)(lds + (ka ^ ((ks + 2) << 5)));
                    __builtin_amdgcn_sched_barrier(0);
                    st = MFMA32(ak[ks % 3], qf[ks], st);
                    __builtin_amdgcn_sched_barrier(0); }
            }
        } else {
            const int idx = (ph - j - 1) >> 1;
            { const int ti = idx + 1 + j; if (ti < nt) ATT_DMA(ATT_TILE(ti), ti % 3); }
            if (idx >= 0 && idx < nt) {
                const int key0 = 32 * ATT_TILE(idx);
                const float basef = (float)(tq - key0 - 4 * half);
                const bool tail = (key0 + 32 > LL);
                float x[16]; float mx = -INFINITY;
                if (WINM || tail) {
#pragma unroll
                    for (int i = 0; i < 16; ++i) { const int off = 8 * (i >> 2) + (i & 3); float d = fabsf(basef - (float)off); bool valid;
                        const int s = key0 + 4 * half + off;
                        if (WINM) { const bool meta = s < NMETA; valid = meta || (d <= 128.f && s < LL); d = meta ? fminf(d, 128.f) : d; }
                        else valid = (s < LL);
                        float xv = fmaf(st[i], c1, -c2 * d); xv = valid ? xv : -INFINITY; x[i] = xv; mx = fmaxf(mx, xv); }
                } else if (key0 + 31 < t0 + wq * 32 || key0 > t0 + wq * 32 + 31) {
                    const bool left = key0 + 31 < t0 + wq * 32; const float cs = left ? c2 : -c2, cbs = (left ? -c2 : c2) * basef;
#pragma unroll
                    for (int i = 0; i < 16; ++i) { const int off = 8 * (i >> 2) + (i & 3);
                        float kb = fmaf((float)off, cs, cbs); asm volatile("" : "+v"(kb)); float sv = st[i]; asm volatile("" : "+v"(sv));
                        float xv = fmaf(sv, c1, kb); asm volatile("" : "+v"(xv)); x[i] = xv; mx = fmaxf(mx, xv); }
                } else {
#pragma unroll
                    for (int i = 0; i < 16; ++i) { const int off = 8 * (i >> 2) + (i & 3); float d = basef - (float)off; asm volatile("" : "+v"(d)); float sv = st[i]; asm volatile("" : "+v"(sv));
                        float kb = -c2 * fabsf(d); asm volatile("" : "+v"(kb)); float xv = fmaf(sv, c1, kb); asm volatile("" : "+v"(xv)); x[i] = xv; mx = fmaxf(mx, xv); }
                }
                mx = xhalf_max(mx);
                pv_act = __any(mx > m - 40.f) != 0;
                if (pv_act) {
                    const bool need = mx > m + 8.f;
                    if (__any(need)) {
                        const float mn = need ? mx : m; const float al = ex2(m - mn);
                        l *= al;
#pragma unroll
                        for (int n = 0; n < NDV; ++n)
#pragma unroll
                            for (int i = 0; i < 16; ++i) o[n][i] *= al;
                        m = mn;
                    }
                    float ps = 0.f;
#pragma unroll
                    for (int i = 0; i < 16; ++i) { float dm = x[i] - m; asm volatile("" : "+v"(dm)); x[i] = ex2(dm); ps += x[i]; }
                    l += ps;
                    pk0.x = cvt_pk(x[0], x[1]); pk0.y = cvt_pk(x[2], x[3]); pk0.z = cvt_pk(x[4], x[5]); pk0.w = cvt_pk(x[6], x[7]);
                    pk1.x = cvt_pk(x[8], x[9]); pk1.y = cvt_pk(x[10], x[11]); pk1.z = cvt_pk(x[12], x[13]); pk1.w = cvt_pk(x[14], x[15]);
                }
            }
        }
        if (ph & 1) { asm volatile("s_waitcnt vmcnt(0)" ::: "memory"); ATT_BAR(); }
    }
    __syncthreads();
#undef ATT_DMA
#undef ATT_BAR
#undef ATT_TILE
    float lt = xhalf_sum(l);
    if (WINM) lt += ex2(sink2 - m);
    const float inv = 1.f / lt;
    const bool tval = tq < LL;
    if (WINM) {
        { const bf16_t* gp = zb + (size_t)tq * ldz + gcol + 4 * half; bf16_t* op16 = mixb + (size_t)tq * MIXW + ocol + 8 * half;
#pragma unroll
            for (int n = 0; n < NDV; ++n)
#pragma unroll
                for (int g2 = 0; g2 < 2; ++g2) { u32x2 w[2];
#pragma unroll
                    for (int e = 0; e < 2; ++e) { const int g4 = 2 * g2 + e; const int dv = n * 32 + 8 * g4; const u32x2 gg = *(const u32x2*)(gp + dv);
                        w[e].x = cvt_pk(o[n][4 * g4] * inv * siluf(bflo(gg.x)), o[n][4 * g4 + 1] * inv * siluf(bfhi(gg.x)));
                        w[e].y = cvt_pk(o[n][4 * g4 + 2] * inv * siluf(bflo(gg.y)), o[n][4 * g4 + 3] * inv * siluf(bfhi(gg.y))); }
                    const auto rx = __builtin_amdgcn_permlane32_swap(w[0].x, w[1].x, false, false); const auto ry = __builtin_amdgcn_permlane32_swap(w[0].y, w[1].y, false, false);
                    u32x4 o16; o16.x = rx[0]; o16.y = ry[0]; o16.z = rx[1]; o16.w = ry[1];
                    if (tval) *(u32x4*)(op16 + n * 32 + 16 * g2) = o16; } }
    } else {
        LAS float* xb = (LAS float*)lds + wq * (DV * 32) + 128 * half + r32;
        if (j == 1) { const float sc = inv * lam;
#pragma unroll
            for (int n = 0; n < NDV; ++n)
#pragma unroll
                for (int i = 0; i < 16; ++i) xb[(n * 32 + 8 * (i >> 2) + (i & 3)) * 32] = o[n][i] * sc; }
        __syncthreads();
        if (j == 0) { float ss = 0.f;
#pragma unroll
            for (int n = 0; n < NDV; ++n)
#pragma unroll
                for (int i = 0; i < 16; ++i) { const float v = o[n][i] * inv - xb[(n * 32 + 8 * (i >> 2) + (i & 3)) * 32]; o[n][i] = v; ss += v * v; }
            ss = xhalf_sum(ss);
            const float rstd = rsqrtf(ss * (1.f / DV) + 1e-6f) * oscale;
            const float* ngp = normg; asm volatile("" : "+s"(ngp)); ngp += 4 * half;
            { const bf16_t* gp = zb + (size_t)tq * ldz + gcol + 4 * half; bf16_t* op16 = mixb + (size_t)tq * MIXW + ocol + 8 * half;
#pragma unroll
                for (int n = 0; n < NDV; ++n)
#pragma unroll
                    for (int g2 = 0; g2 < 2; ++g2) { u32x2 w[2];
#pragma unroll
                        for (int e = 0; e < 2; ++e) { const int g4 = 2 * g2 + e; const int dv = n * 32 + 8 * g4; const u32x2 gg = *(const u32x2*)(gp + dv); const f32x4 ng = *(const f32x4*)(ngp + dv);
                            w[e].x = cvt_pk(o[n][4 * g4] * rstd * ng[0] * siluf(bflo(gg.x)), o[n][4 * g4 + 1] * rstd * ng[1] * siluf(bfhi(gg.x)));
                            w[e].y = cvt_pk(o[n][4 * g4 + 2] * rstd * ng[2] * siluf(bflo(gg.y)), o[n][4 * g4 + 3] * rstd * ng[3] * siluf(bfhi(gg.y))); }
                        const auto rx = __builtin_amdgcn_permlane32_swap(w[0].x, w[1].x, false, false); const auto ry = __builtin_amdgcn_permlane32_swap(w[0].y, w[1].y, false, false);
                        u32x4 o16; o16.x = rx[0]; o16.y = ry[0]; o16.z = rx[1]; o16.w = ry[1];
                        if (tval) *(u32x4*)(op16 + n * 32 + 16 * g2) = o16; } }
        }
        __syncthreads();
    }
}

DI void hgrn_seq(LAS unsigned char* lds, const bf16_t* __restrict__ zb, const int ldz, const int h, const int dir, const float lbv, bf16_t* __restrict__ dst, const int ldd, const int wave_s__) {
    constexpr int QC = 0, KH = 17408, KT = 34816, VT = 53248, SL = 71680, SC = 106496, TOT = 115712, E1 = 117760, GM = 118272;
    const int tid = ltid(wave_s__), wid = tid >> 6, lane = tid & 63, r32 = lane & 31, half = lane >> 5;
    const int k = tid & 127, tg = tid >> 7;
    const int fcol = dir ? 4096 : 2048;
    const int n = wid & 3, kt0 = 2 * (wid >> 2), ti = wid >> 2;
    LAS float* tot = (LAS float*)(lds + TOT); LAS float* e1p = (LAS float*)(lds + E1); LAS float* gmp = (LAS float*)(lds + GM);
    LAS float* e1l = e1p + kt0 * 32 + 4 * half; LAS float* gml = gmp + kt0 * 32 + 4 * half;
    f32x16 S[2]; S[0] = zero16(); S[1] = zero16();
    const float oml = 1.f - lbv;
    bf16_t rq[16], rf[16], rv[16];
    const int padc = dir ? 32 : 0;
#define HG_LOAD(c_) do { _Pragma("unroll") for (int e = 0; e < 16; ++e) { const int P_ = 64 * (c_) + tg * 16 + e; const int pp_ = dir ? 2111 - P_ : P_; const int t_ = pp_ - 48; const int tt_ = t_ < 0 ? 0 : t_; \
            const bf16_t* row_ = zb + (size_t)tt_ * ldz + h * 128 + k; rq[e] = row_[0]; rf[e] = row_[fcol]; rv[e] = row_[6144]; } } while (0)
    HG_LOAD(0);
    for (int c = 0; c < 33; ++c) {
        float qv[16], kk[16], bl[16]; unsigned vp[8]; float run = 0.f;
        {
            float vv[16];
            if (c == padc) {
#pragma unroll
            for (int e = 0; e < 16; ++e) {
                const int P = 64 * c + tg * 16 + e; const int pp = dir ? 2111 - P : P; const int t = pp - 48; const bool ok = t >= 0;
                const float q = bf2f(rq[e]), zf = bf2f(rf[e]), v = bf2f(rv[e]);
                const float ex = ex2(-zf * LOG2E), rden = rcpf(1.f + ex);
                const float lf = lg2((1.f + lbv * ex) * rden);
                run += ok ? lf : 0.f; bl[e] = run; qv[e] = ok ? q : 0.f; kk[e] = ok ? oml * ex * rden : 0.f; vv[e] = ok ? v : 0.f;
            }
            } else {
#pragma unroll
            for (int e = 0; e < 16; ++e) {
                const float q = bf2f(rq[e]), zf = bf2f(rf[e]), v = bf2f(rv[e]);
                const float ex = ex2(-zf * LOG2E), rden = rcpf(1.f + ex);
                const float lf = lg2((1.f + lbv * ex) * rden);
                run += lf; bl[e] = run; qv[e] = q; kk[e] = oml * ex * rden; vv[e] = v;
            }
            }
#pragma unroll
            for (int e = 0; e < 8; ++e) vp[e] = cvt_pk(vv[2 * e], vv[2 * e + 1]);
        }
        tot[tg * 128 + k] = run;
        __syncthreads();
        {
            const float t0_ = tot[k], t1_ = tot[128 + k], t2_ = tot[256 + k], t3_ = tot[384 + k];
            const float off = (tg > 0 ? t0_ : 0.f) + (tg > 1 ? t1_ : 0.f) + (tg > 2 ? t2_ : 0.f);
            const float bmid = t0_ + t1_;
            if (tg == 0) { e1p[k] = ex2(bmid); gmp[k] = ex2(t2_ + t3_); }
            unsigned khp[8]; float khv[16];
#pragma unroll
            for (int e = 0; e < 16; ++e) { const float dq = off + bl[e] - bmid; const float qc = qv[e] * ex2(dq); khv[e] = kk[e] * ex2(-dq);
                const int i = tg * 16 + e;
                *(LAS bf16_t*)(lds + QC + i * 272 + k * 2) = (bf16_t)(cvt_pk(qc, qc) & 0xffffu);
                *(LAS bf16_t*)(lds + KH + i * 272 + k * 2) = (bf16_t)(cvt_pk(khv[e], khv[e]) & 0xffffu); }
#pragma unroll
            for (int e = 0; e < 8; ++e) khp[e] = cvt_pk(khv[2 * e], khv[2 * e + 1]);
            u32x4 w0, w1; w0.x = khp[0]; w0.y = khp[1]; w0.z = khp[2]; w0.w = khp[3]; w1.x = khp[4]; w1.y = khp[5]; w1.z = khp[6]; w1.w = khp[7];
            *(LAS u32x4*)(lds + KT + k * 144 + tg * 32) = w0; *(LAS u32x4*)(lds + KT + k * 144 + tg * 32 + 16) = w1;
            w0.x = vp[0]; w0.y = vp[1]; w0.z = vp[2]; w0.w = vp[3]; w1.x = vp[4]; w1.y = vp[5]; w1.z = vp[6]; w1.w = vp[7];
            *(LAS u32x4*)(lds + VT + k * 144 + tg * 32) = w0; *(LAS u32x4*)(lds + VT + k * 144 + tg * 32 + 16) = w1;
        }
        if (c + 1 < 33) HG_LOAD(c + 1);
        __syncthreads();
#pragma unroll
        for (int a = 0; a < 2; ++a) { const int kt = kt0 + a;
#pragma unroll
            for (int i = 0; i < 16; ++i) S[a][i] *= e1l[a * 32 + 8 * (i >> 2) + (i & 3)];
#pragma unroll
            for (int g4 = 0; g4 < 4; ++g4) { u32x2 w; w.x = cvt_pk(S[a][4 * g4], S[a][4 * g4 + 1]); w.y = cvt_pk(S[a][4 * g4 + 2], S[a][4 * g4 + 3]);
                *(LAS u32x2*)(lds + SL + (n * 32 + r32) * 272 + (kt * 32 + 8 * g4 + 4 * half) * 2) = w; } }
        if (wid < 4) { const int si = wid >> 1, tj = wid & 1;
            f32x16 acc = zero16();
            if (si <= tj) {
#pragma unroll
                for (int ks = 0; ks < 8; ++ks) { const bf16x8 a = *(LAS bf16x8*)(lds + KH + (si * 32 + r32) * 272 + ks * 32 + half * 16); const bf16x8 b = *(LAS bf16x8*)(lds + QC + (tj * 32 + r32) * 272 + ks * 32 + half * 16);
                    acc = MFMA32(a, b, acc); }
            }
            const int tt = tj * 32 + r32;
#pragma unroll
            for (int g4 = 0; g4 < 4; ++g4) { float v4[4];
#pragma unroll
                for (int q = 0; q < 4; ++q) { const int s = si * 32 + 8 * g4 + 4 * half + q; v4[q] = (s <= tt) ? acc[4 * g4 + q] : 0.f; }
                u32x2 w; w.x = cvt_pk(v4[0], v4[1]); w.y = cvt_pk(v4[2], v4[3]);
                *(LAS u32x2*)(lds + SC + tt * 144 + (si * 32 + 8 * g4 + 4 * half) * 2) = w; } }
        __syncthreads();
        { f32x16 acc = zero16();
#pragma unroll
          for (int ks = 0; ks < 8; ++ks) { const bf16x8 a = *(LAS bf16x8*)(lds + SL + (n * 32 + r32) * 272 + ks * 32 + half * 16); const bf16x8 b = *(LAS bf16x8*)(lds + QC + (ti * 32 + r32) * 272 + ks * 32 + half * 16);
              acc = MFMA32(a, b, acc); }
#pragma unroll
          for (int ss = 0; ss < 4; ++ss) { if (ss < 2 || ti == 1) { const bf16x8 a = *(LAS bf16x8*)(lds + VT + (n * 32 + r32) * 144 + ss * 32 + half * 16); const bf16x8 b = *(LAS bf16x8*)(lds + SC + (ti * 32 + r32) * 144 + ss * 32 + half * 16);
              acc = MFMA32(a, b, acc); } }
          const int P = 64 * c + ti * 32 + r32; const int pp = dir ? 2111 - P : P; const int t = pp - 48;
          if (t >= 0) { bf16_t* op = dst + (size_t)t * ldd + n * 32 + 4 * half;
#pragma unroll
              for (int g4 = 0; g4 < 4; ++g4) { u32x2 w; w.x = cvt_pk(acc[4 * g4], acc[4 * g4 + 1]); w.y = cvt_pk(acc[4 * g4 + 2], acc[4 * g4 + 3]); *(u32x2*)(op + 8 * g4) = w; } }
        }
#pragma unroll
        for (int a = 0; a < 2; ++a) { const int kt = kt0 + a;
#pragma unroll
            for (int ss = 0; ss < 4; ++ss) { const bf16x8 av = *(LAS bf16x8*)(lds + KT + (kt * 32 + r32) * 144 + ss * 32 + half * 16); const bf16x8 bv = *(LAS bf16x8*)(lds + VT + (n * 32 + r32) * 144 + ss * 32 + half * 16);
                S[a] = MFMA32(av, bv, S[a]); }
#pragma unroll
            for (int i = 0; i < 16; ++i) S[a][i] *= gml[a * 32 + 8 * (i >> 2) + (i & 3)]; }
    }
#undef HG_LOAD
    __syncthreads();
}

DI int xcd_unit(int i) { const int G = gridDim.x, c = blockIdx.x; return (G & 7) ? (i * G + c) : ((i * 8 + (c & 7)) * (G >> 3) + (c >> 3)); }


DI void fin_head(const Params& p, const int li, const int b, const int h, const int wave_s__) {
    const bf16_t* Z = (const bf16_t*)(p.ws + OFF_Z); bf16_t* MIX = (bf16_t*)(p.ws + OFF_MIX); const bf16_t* OF = (const bf16_t*)(p.ws + OFF_HN);
    const int lane = (int)__lane_id(), rr = lane >> 4, c8 = (lane & 15) * 8;
    const f32x4 g0 = *(const f32x4*)(p.hgrn_norm + li * 128 + c8), g1 = *(const f32x4*)(p.hgrn_norm + li * 128 + c8 + 4);
    for (int t0 = wave_s__ * 16; t0 < LL; t0 += 128) {
        u32x4 a[4], c[4], gt[4];
#pragma unroll
        for (int q = 0; q < 4; ++q) { const int t = t0 + q * 4 + rr; const size_t r = (size_t)b * LL + (t < LL ? t : LL - 1);
            a[q] = *(const u32x4*)(OF + r * DM + h * 128 + c8); c[q] = *(const u32x4*)(MIX + r * MIXW + h * 128 + c8); gt[q] = *(const u32x4*)(Z + r * EVEN_IN + 8192 + h * 128 + c8); }
#pragma unroll
        for (int q = 0; q < 4; ++q) { const int t = t0 + q * 4 + rr; float v[8]; float ss = 0.f;
#pragma unroll
            for (int w = 0; w < 4; ++w) { v[2 * w] = bflo(a[q][w]) + bflo(c[q][w]); v[2 * w + 1] = bfhi(a[q][w]) + bfhi(c[q][w]); ss += v[2 * w] * v[2 * w] + v[2 * w + 1] * v[2 * w + 1]; }
            ss += __shfl_xor(ss, 1); ss += __shfl_xor(ss, 2); ss += __shfl_xor(ss, 4); ss += __shfl_xor(ss, 8);
            const float rstd = rsqrtf(ss * (1.f / 128) + 1e-6f);
            u32x4 w4;
#pragma unroll
            for (int w = 0; w < 4; ++w) { const float ga = (w < 2) ? g0[2 * w] : g1[2 * w - 4], gb = (w < 2) ? g0[2 * w + 1] : g1[2 * w - 3];
                w4[w] = cvt_pk(v[2 * w] * rstd * ga * siluf(bflo(gt[q][w])), v[2 * w + 1] * rstd * gb * siluf(bfhi(gt[q][w]))); }
            if (t < LL) *(u32x4*)(MIX + ((size_t)b * LL + t) * MIXW + h * 128 + c8) = w4; }
    }
}

DI void mix_even(const Params& p, LAS unsigned char* lds, const int li, const int wave_s__) {
    const bf16_t* Z = (const bf16_t*)(p.ws + OFF_Z); bf16_t* MIX = (bf16_t*)(p.ws + OFF_MIX); bf16_t* HN = (bf16_t*)(p.ws + OFF_HN);
    const int k = ltid(wave_s__) & 127, wid = ltid(wave_s__) >> 6;
    for (int u = blockIdx.x; u < 256; u += gridDim.x) {
        const int b = u >> 5, h = (u >> 1) & 15, dir = u & 1;
        float lbv = 0.f;
        if (li == 1) { const float a0 = p.hgrn_lb[(size_t)(dir * 2 + 0) * 2048 + h * 128 + k], a1 = p.hgrn_lb[(size_t)(dir * 2 + 1) * 2048 + h * 128 + k]; lbv = 1.f / (1.f + __expf(a0 - a1)); }
        hgrn_seq(lds, Z + (size_t)b * LL * EVEN_IN, EVEN_IN, h, dir, lbv, dir ? (MIX + (size_t)b * LL * MIXW + h * 128) : (HN + (size_t)b * LL * DM + h * 128), dir ? MIXW : DM, wave_s__);
        unsigned* hf = (unsigned*)(p.ws + OFF_HFLAG) + li * 128 + b * 16 + h;
        if (wave_s__ == 0 && __lane_id() == 0) { __threadfence(); __hip_atomic_fetch_add(hf, 1u, __ATOMIC_RELEASE, __HIP_MEMORY_SCOPE_AGENT);
            if (dir) { while (__hip_atomic_load(hf, __ATOMIC_RELAXED, __HIP_MEMORY_SCOPE_AGENT) < 2u) __builtin_amdgcn_s_sleep(2);
                __builtin_amdgcn_fence(__ATOMIC_ACQUIRE, "agent"); } }
        if (dir) { __syncthreads(); fin_head(p, li, b, h, wave_s__); __syncthreads(); }
    }
    const int j = wid >> 2;
    for (int i = 0;; ++i) {
        const int u = xcd_unit(i); if (u >= 1088) break;
        const int qb = u % 17, r = u / 17, pair = r & 1, kvh = (r >> 1) & 3, b = r >> 3;
        const int hq = kvh * 4 + pair * 2 + j;
        const float slope = exp2f(-0.5f * (float)(hq + 1));
        const int t0 = qb * 128;
        const int lo = (t0 - 128) < 32 ? 1 : ((t0 - 128) >> 5);
        const int hi = ((t0 + 255) >> 5) > 64 ? 64 : ((t0 + 255) >> 5);
        attn_unit<4, 1, true>(lds, Z + (size_t)b * LL * EVEN_IN, EVEN_IN, 10240 + hq * 128, 12288 + kvh * 128, 0, 12800 + kvh * 128, 13312 + hq * 128, 2048 + hq * 128,
                              slope * LOG2E, p.sink[li * 16 + hq] * LOG2E, t0, lo, 2 + hi - lo, MIX + (size_t)b * LL * MIXW, 0.f, nullptr, 0.f, wave_s__);
    }
}

DI void fin_even(const Params& p, const int li, const int wave_s__) {
    const bf16_t* Z = (const bf16_t*)(p.ws + OFF_Z); bf16_t* MIX = (bf16_t*)(p.ws + OFF_MIX); const bf16_t* OF = (const bf16_t*)(p.ws + OFF_HN);
    const int wid = ltid(wave_s__) >> 6, lane = ltid(wave_s__) & 63;
    const float* ng = p.hgrn_norm + li * 128 + (lane & 3) * 32;
    for (int r = blockIdx.x * 8 + wid; r < MTOK; r += gridDim.x * 8) {
        const bf16_t* f = OF + (size_t)r * DM + lane * 32; bf16_t* mb = MIX + (size_t)r * MIXW + lane * 32; const bf16_t* gp = Z + (size_t)r * EVEN_IN + 8192 + lane * 32;
        float v[32]; float ss = 0.f;
#pragma unroll
        for (int q = 0; q < 4; ++q) { const u32x4 a = *(const u32x4*)(f + q * 8), c = *(const u32x4*)(mb + q * 8);
#pragma unroll
            for (int w = 0; w < 4; ++w) { v[q * 8 + 2 * w] = bflo(a[w]) + bflo(c[w]); v[q * 8 + 2 * w + 1] = bfhi(a[w]) + bfhi(c[w]); } }
#pragma unroll
        for (int e = 0; e < 32; ++e) ss += v[e] * v[e];
        ss += __shfl_xor(ss, 1); ss += __shfl_xor(ss, 2);
        const float rstd = rsqrtf(ss * (1.f / 128) + 1e-6f);
#pragma unroll
        for (int q = 0; q < 4; ++q) { const u32x4 g = *(const u32x4*)(gp + q * 8); u32x4 w;
#pragma unroll
            for (int w_ = 0; w_ < 4; ++w_) { const int e = q * 8 + 2 * w_;
                w[w_] = cvt_pk(v[e] * rstd * ng[e] * siluf(bflo(g[w_])), v[e + 1] * rstd * ng[e + 1] * siluf(bfhi(g[w_]))); }
            *(u32x4*)(mb + q * 8) = w; }
    }
}


DI void qk_norm_pass(const Params& p, const int li, const int wave_s__) {
    const bf16_t* Z = (const bf16_t*)(p.ws + OFF_Z); unsigned* nrm = (unsigned*)(p.ws + OFF_NRM) + li * 512;
    const int lane = (int)__lane_id();
    const int gw = blockIdx.x * 8 + wave_s__, nw = gridDim.x * 8;
    const int per = (MTOK + nw - 1) / nw; const int r0 = gw * per, r1 = (r0 + per) < MTOK ? (r0 + per) : MTOK;
    float mxv[16]; int curb = -1;
#pragma unroll
    for (int jx = 0; jx < 16; ++jx) mxv[jx] = 0.f;
    for (int r = r0; r < r1; ++r) {
        const int b = r / LL;
        if (b != curb) { if (curb >= 0) {
#pragma unroll
                for (int jx = 0; jx < 16; ++jx) { if ((lane & 15) == 0) atomicMax(nrm + curb * 64 + jx * 4 + (lane >> 4), __float_as_uint(mxv[jx])); mxv[jx] = 0.f; } }
            curb = b; }
        const bf16_t* row = Z + (size_t)r * ODD_LD;
#pragma unroll
        for (int jx = 0; jx < 16; ++jx) { const u32x4 v = *(const u32x4*)(row + (jx * 64 + lane) * 8); float ss = 0.f;
#pragma unroll
            for (int w = 0; w < 4; ++w) { const float a = bflo(v[w]), c = bfhi(v[w]); ss += a * a + c * c; }
            ss += __shfl_xor(ss, 1); ss += __shfl_xor(ss, 2); ss += __shfl_xor(ss, 4); ss += __shfl_xor(ss, 8);
            mxv[jx] = fmaxf(mxv[jx], ss); }
    }
    if (curb >= 0) {
#pragma unroll
        for (int jx = 0; jx < 16; ++jx) if ((lane & 15) == 0) atomicMax(nrm + curb * 64 + jx * 4 + (lane >> 4), __float_as_uint(mxv[jx]));
    }
}

DI void mix_odd(const Params& p, LAS unsigned char* lds, const int li, const int layer, const int wave_s__) {
    const bf16_t* Z = (const bf16_t*)(p.ws + OFF_Z); bf16_t* MIX = (bf16_t*)(p.ws + OFF_MIX);
    const int lane = ltid(wave_s__) & 63, wid = ltid(wave_s__) >> 6, j = wid >> 2;
    const float lam_init = 0.8f - 0.6f * expf(-0.3f * (float)layer);
    const float lam = ((const float*)(p.ws + OFF_MISC))[li];
    unsigned* qctr = (unsigned*)(p.ws + OFF_QCTR) + li * 8;
    volatile LAS unsigned* qw = (volatile LAS unsigned*)(lds + 131072);
    for (int sq = 0; sq < 8; ++sq) {
      const int b = ((int)blockIdx.x + sq) & 7;
      for (;;) {
        if (wid == 0 && lane == 0) qw[0] = atomicAdd(qctr + b, 1u);
        __syncthreads();
        const unsigned uq = qw[0];
        __syncthreads();
        if (uq >= 272u) break;
        const int h = 15 - (int)(uq / 17u), qb = (int)(uq % 17u);
        const float slope = exp2f(-0.5f * (float)(h + 1));
        const unsigned* nr = (const unsigned*)(p.ws + OFF_NRM) + li * 512 + b * 64;
        const float q0 = __uint_as_float(nr[h * 2]), q1 = __uint_as_float(nr[h * 2 + 1]), k0 = __uint_as_float(nr[32 + h * 2]), k1 = __uint_as_float(nr[32 + h * 2 + 1]);
        const float Bq = sqrtf(fmaxf(q0 * k0, q1 * k1)) * (0.08838834764831845f * LOG2E * 1.001f);
        const float Dmin = (40.f + 2.f * Bq) / (slope * LOG2E);
        const int t0 = qb * 128;
        int first = (int)floorf(((float)(t0 - 31) - Dmin) * (1.f / 32.f)) + 1; first = first < 0 ? 0 : first;
        int last = (int)ceilf(((float)(t0 + 127) + Dmin) * (1.f / 32.f)) - 1; last = last > 64 ? 64 : last;
        attn_unit<8, 2, false>(lds, Z + (size_t)b * LL * ODD_LD, ODD_LD, h * 256 + j * 128, 4096 + h * 256, 4096 + h * 256 + 128, 8192 + h * 256, 12288 + h * 256, h * 256,
                               slope * LOG2E, 0.f, t0, first, last - first + 1, MIX + (size_t)b * LL * MIXW, lam, p.dnorm + li * 256, 1.f - lam_init, wave_s__);
      }
    }
}


struct G2Order : pg8::StaticOrder {
    __device__ bool next(int i, pg8::Unit& u) const {
        const long L = (long)i * G + c;
        if (L < nwg) return pg8::StaticOrder::next(i, u);
        const int jx = (int)(L - nwg); if (jx >= 128) return false;
        u.pm = 64; u.pn = jx & 7; u.kt0 = (jx >> 3) * 4; u.nt = 4; return true;
    }
};
template <bool EVEN>
DI void run_g1(const Params& p, LAS unsigned char* lds, const int layer, const int wave_s__) {
    constexpr int nin = EVEN ? EVEN_IN : ODD_IN;
    pg8::Gemm g; g.A = (const bf16_t*)(p.ws + OFF_HN); g.Bt = (const bf16_t*)(p.ws + ((layer & 1) ? OFF_WIN2 : OFF_WIN)); g.M = MPAD; g.N = nin; g.K = DM;
    pg8::StaticOrder S; S.init(MPAD, nin, (int)gridDim.x, (int)blockIdx.x, DM);
    pg8::EpiBf16<0> E; E.O = (bf16_t*)(p.ws + OFF_Z); E.ldc = EVEN ? EVEN_IN : ODD_LD; E.bias = nullptr; E.split_cols = 0; E.split_stride = 0;
    pg8::gemm_phase<pg8::EpiBf16<0>, pg8::StaticOrder, false>(lds, g, S, E, nullptr, wave_s__);
    const int rem = ((MPAD / 256) * (nin / 256)) % (int)gridDim.x; const int first = (rem == 0 || 2 * rem > (int)gridDim.x) ? 0 : rem;
    const int li = layer >> 1;
    convert_T(lds, (EVEN ? p.w_out_a : p.w_out_c) + (size_t)li * MIXW * DM, (bf16_t*)(p.ws + OFF_WOUT), MIXW, DM, wave_s__, first);
    if (layer < 3) { bf16_t* wn = (bf16_t*)(p.ws + (((layer + 1) & 1) ? OFF_WIN2 : OFF_WIN));
        if (EVEN) convert_T(lds, p.w_in_c + (size_t)li * DM * ODD_IN, wn, DM, ODD_IN, wave_s__, first);
        else convert_T(lds, p.w_in_a + (size_t)(li + 1) * DM * EVEN_IN, wn, DM, EVEN_IN, wave_s__, first); }
}
DI void run_g2(const Params& p, LAS unsigned char* lds, const int layer, const int wave_s__) {
    pg8::Gemm g; g.A = (const bf16_t*)(p.ws + OFF_MIX); g.Bt = (const bf16_t*)(p.ws + OFF_WOUT); g.M = MPAD; g.N = DM; g.K = MIXW;
    G2Order S; S.init(16384, DM, (int)gridDim.x, (int)blockIdx.x, MIXW);
    EpiResAdd E; E.H = (float*)(p.ws + OFF_H); E.ldc = DM; E.P = (float*)(p.ws + OFF_PART); E.x0 = layer == 0 ? p.x : nullptr; E.meta0 = p.meta;
    pg8::gemm_phase<EpiResAdd, G2Order, false>(lds, g, S, E, nullptr, wave_s__);
}

#define PH_IN(k) (lo <= (k) && (k) < hi)
DI void grid_bar(unsigned* base, const unsigned epoch, const int wave_s__) {
    __syncthreads();
    if (wave_s__ == 0 && __lane_id() == 0) {
        const unsigned G = gridDim.x, x = blockIdx.x & 7u;
        const unsigned gsize = (G - x + 7u) >> 3, ngroups = G < 8u ? G : 8u;
        const unsigned old = __hip_atomic_fetch_add(base + 32u * (1u + x), 1u, __ATOMIC_ACQ_REL, __HIP_MEMORY_SCOPE_AGENT);
        if (old + 1u == gsize * epoch) __hip_atomic_fetch_add(base, 1u, __ATOMIC_ACQ_REL, __HIP_MEMORY_SCOPE_AGENT);
        while (__hip_atomic_load(base, __ATOMIC_RELAXED, __HIP_MEMORY_SCOPE_AGENT) < ngroups * epoch) __builtin_amdgcn_s_sleep(1);
        __builtin_amdgcn_fence(__ATOMIC_ACQUIRE, "agent");
    }
    __syncthreads();
}
#define PH_SYNC(k) do { if (PH_IN(k) && PH_IN((k) + 1)) { nbar += 1u; grid_bar(barcnt, nbar, wave_s__); } } while (0)
DI void layer_pair(const Params& p, LAS unsigned char* lds, unsigned* barcnt, unsigned& nbar, const int lo, const int hi, const int pr, const int wave_s__) {
    bf16_t* WIN = (bf16_t*)(p.ws + OFF_WIN); bf16_t* WOUT = (bf16_t*)(p.ws + OFF_WOUT);

        const int k0 = 1 + 9 * pr;
        if (PH_IN(k0 + 0)) run_g1<true>(p, lds, 2 * pr, wave_s__);
        PH_SYNC(k0 + 0);
        if (PH_IN(k0 + 1)) {
#pragma unroll 1
            for (int rep = 0; rep <= p.dup_e; ++rep) { mix_even(p, lds, pr, wave_s__); __syncthreads(); }

}
        PH_SYNC(k0 + 1);
        if (PH_IN(k0 + 3)) run_g2(p, lds, 2 * pr, wave_s__);
        PH_SYNC(k0 + 3);
        if (PH_IN(k0 + 4)) row_phase<1>(p, p.norm_c + (size_t)pr * DM, wave_s__);
        PH_SYNC(k0 + 4);
        if (PH_IN(k0 + 5)) run_g1<false>(p, lds, 2 * pr + 1, wave_s__);
        PH_SYNC(k0 + 5);
        if (PH_IN(k0 + 6)) {
            qk_norm_pass(p, pr, wave_s__);
            nbar += 1u; grid_bar(barcnt, nbar, wave_s__);
#pragma unroll 1
            for (int rep = 0; rep <= p.dup_o; ++rep) { mix_odd(p, lds, pr, 2 * pr + 1, wave_s__); __syncthreads(); }

}
        PH_SYNC(k0 + 6);
        if (PH_IN(k0 + 7)) run_g2(p, lds, 2 * pr + 1, wave_s__);
        PH_SYNC(k0 + 7);
        if (PH_IN(k0 + 8)) { if (pr == 1) row_phase<2>(p, p.fnorm, wave_s__); else row_phase<1>(p, p.norm_a + (size_t)DM, wave_s__); }
        PH_SYNC(k0 + 8);
}

__global__ void __launch_bounds__(512, 2) mega(Params p) {
    extern __shared__ __attribute__((aligned(16))) unsigned char lds_raw[];
    LAS unsigned char* lds = (LAS unsigned char*)lds_raw;
    cg::grid_group grid = cg::this_grid();
    const int lo = p.ph_lo, hi = p.ph_hi;
    const int wave_s__ = __builtin_amdgcn_readfirstlane((int)threadIdx.x >> 6);
    bf16_t* WIN = (bf16_t*)(p.ws + OFF_WIN); bf16_t* WOUT = (bf16_t*)(p.ws + OFF_WOUT);
    if (PH_IN(0)) {
        if (blockIdx.x == 0) { unsigned* cw = (unsigned*)(p.ws + OFF_MISC + 256); for (int i = ltid(wave_s__); i < (8192 - 256) / 4; i += 512) cw[i] = 0u; }
        if (blockIdx.x == 0 && wave_s__ < 2) {
            const int lane = (int)__lane_id(); const float* lv = p.dlam + wave_s__ * 512;
            const float d1 = wave_sum(lv[lane] * lv[128 + lane] + lv[64 + lane] * lv[192 + lane]);
            const float d2 = wave_sum(lv[256 + lane] * lv[384 + lane] + lv[320 + lane] * lv[448 + lane]);
            const float lam_init = 0.8f - 0.6f * expf(-0.3f * (float)(2 * wave_s__ + 1));
            if (lane == 0) ((float*)(p.ws + OFF_MISC))[wave_s__] = expf(d1) - expf(d2) + lam_init;
        }
        row_phase<0>(p, p.norm_a, wave_s__); convert_T(lds, p.w_in_a, WIN, DM, EVEN_IN, wave_s__); }
    unsigned* barcnt = (unsigned*)(p.ws + OFF_MISC + 5632); unsigned nbar = 0u;
    if (PH_IN(0) && PH_IN(1)) grid.sync();
    layer_pair(p, lds, barcnt, nbar, lo, hi, 0, wave_s__);
    layer_pair(p, lds, barcnt, nbar, lo, hi, 1, wave_s__);
}

constexpr int N_PHASES = 19;

extern "C" void kernel_launch(void* const* d_in, const int* in_sizes, int n_in, void* d_out, int out_size, void* d_ws, size_t ws_size, hipStream_t stream) {
    static int grid = 0;
    if (grid == 0) {
        if (n_in != 14 || ws_size < WS_END) { fprintf(stderr, "kernel_launch: need 14 inputs and %zu bytes of workspace; got %d, %zu\n", (size_t)WS_END, n_in, ws_size); grid = -1; return; }
        int dev = 0, cus = 0, per_cu = 0;
        hipGetDevice(&dev); hipDeviceGetAttribute(&cus, hipDeviceAttributeMultiprocessorCount, dev);
        if (hipFuncSetAttribute((const void*)mega, hipFuncAttributeMaxDynamicSharedMemorySize, LDS_BYTES) != hipSuccess) { fprintf(stderr, "kernel_launch: hipFuncSetAttribute failed\n"); grid = -1; return; }
        if (hipOccupancyMaxActiveBlocksPerMultiprocessor(&per_cu, (const void*)mega, 512, LDS_BYTES) != hipSuccess || per_cu < 1) { fprintf(stderr, "kernel_launch: occupancy query says %d\n", per_cu); per_cu = 1; }
        (void)hipGetLastError();
        grid = cus * 1;
    }
    if (grid < 0) return;
    Params p{};
    p.x = (const float*)d_in[0]; p.meta = (const float*)d_in[1]; p.norm_a = (const float*)d_in[2]; p.w_in_a = (const float*)d_in[3]; p.w_out_a = (const float*)d_in[4];
    p.hgrn_lb = (const float*)d_in[5]; p.hgrn_norm = (const float*)d_in[6]; p.sink = (const float*)d_in[7]; p.norm_c = (const float*)d_in[8]; p.w_in_c = (const float*)d_in[9];
    p.w_out_c = (const float*)d_in[10]; p.dlam = (const float*)d_in[11]; p.dnorm = (const float*)d_in[12]; p.fnorm = (const float*)d_in[13];
    p.out = (float*)d_out; p.ws = (unsigned char*)d_ws; p.ph_lo = 0; p.ph_hi = N_PHASES;
#ifdef DUP_ODD
    p.dup_o = 1;
#endif
#ifdef DUP_EVEN
    p.dup_e = 1;
#endif
    void* args[] = {&p};
    hipError_t e = hipLaunchCooperativeKernel((const void*)mega, dim3(grid), dim3(512), args, LDS_BYTES, stream);
    if (e != hipSuccess) fprintf(stderr, "kernel_launch: cooperative launch failed: %s (grid %d)\n", hipGetErrorString(e), grid);
}
```
